# Optimizing an MI355X kernel written in HIP

```python
import math
import jax, jax.numpy as jnp
from jax import lax
import numpy as np

D_MODEL = 1024
BATCH = 8
SEQ = 2048
DEPTH = 1
DEC_BATCH = 128
DEC_SEQ = 8
PAST_LEN = 16384
PAGE_SIZE = 128

SSM_INNER = D_MODEL
SSM_HEAD_DIM = 64
SSM_HEADS = SSM_INNER // SSM_HEAD_DIM
SSM_GROUPS = 2
SSM_STATE = 128
SSM_CONV = 4
SSM_CHUNK = 64
SSM_CONV_DIM = SSM_INNER + 2 * SSM_GROUPS * SSM_STATE
ML_HEADS = 4
ML_V_DIM = D_MODEL // ML_HEADS
ML_QK_DIM = ML_V_DIM // 2
ML_INNER = ML_HEADS * ML_V_DIM
ML_QK_WIDTH = ML_HEADS * ML_QK_DIM
ML_CHUNK = 64
MIX_WIDTH = SSM_INNER + ML_INNER
IN_WIDTH = SSM_INNER + SSM_CONV_DIM + SSM_HEADS + 2 * ML_QK_WIDTH + ML_INNER + 2 * ML_HEADS + ML_INNER
N_MEM = 256
X_HEADS = 4
X_HEAD_DIM = D_MODEL // X_HEADS
X_WIDTH = X_HEADS * X_HEAD_DIM
FFN_HIDDEN = ((8 * D_MODEL + 3 * 256 - 1) // (3 * 256)) * 256
EPS = 1e-6

kernel_name = 'hymba_ssd_mlstm_memxattn_step'


def _rms(x):
    xf = x.astype(jnp.float32)
    return (xf * lax.rsqrt(jnp.mean(xf * xf, axis=-1, keepdims=True) + EPS)).astype(x.dtype)


def _chunk_len(length, chunk):
    return chunk if length % chunk == 0 else length


def _to_chunks(t, n_chunks, q):
    return jnp.moveaxis(t.reshape(t.shape[0], n_chunks, q, *t.shape[2:]), 1, 0)


def causal_conv(x, buf, w, b):
    k_w = w.shape[0]
    length = x.shape[1]
    xp = jnp.concatenate([buf.astype(x.dtype), x], axis=1)
    y = b
    for j in range(k_w):
        y = y + xp[:, j:j + length] * w[j]
    return y, xp[:, length:]


def ssd_scan(x, dt, a, bm, cm, h0):
    bsz, length, n_heads, p_dim = x.shape
    g, n_st = bm.shape[2], bm.shape[3]
    hg = n_heads // g
    q = _chunk_len(length, SSM_CHUNK)
    nc = length // q
    f32 = jnp.float32
    xf = x.astype(f32).reshape(bsz, length, g, hg, p_dim)
    dtf = dt.astype(f32).reshape(bsz, length, g, hg)
    la = dtf * a.astype(f32).reshape(g, hg)
    xs = (_to_chunks(xf, nc, q), _to_chunks(dtf, nc, q), _to_chunks(la, nc, q),
          _to_chunks(bm.astype(f32), nc, q), _to_chunks(cm.astype(f32), nc, q))
    causal = jnp.tril(jnp.ones((q, q), dtype=bool))

    def step(h, inp):
        xc, dtc, lac, bc, cc = inp
        cum = jnp.cumsum(lac, axis=1)
        seg = cum[:, :, None] - cum[:, None, :]
        lmat = jnp.exp(jnp.where(causal[None, :, :, None, None], seg, -jnp.inf))
        cb = jnp.einsum('btgn,bsgn->btsg', cc, bc)
        wts = cb[..., None] * lmat * dtc[:, None]
        y_intra = jnp.einsum('btsgj,bsgjp->btgjp', wts, xc)
        y_inter = jnp.einsum('btgn,bgjpn->btgjp', cc, h) * jnp.exp(cum)[..., None]
        to_end = jnp.exp(cum[:, -1:] - cum) * dtc
        h_new = h * jnp.exp(cum[:, -1])[..., None, None] + jnp.einsum('bsgj,bsgjp,bsgn->bgjpn', to_end, xc, bc)
        return h_new, y_intra + y_inter

    h_end, ys = lax.scan(step, h0.astype(f32).reshape(bsz, g, hg, p_dim, n_st), xs)
    y = jnp.moveaxis(ys, 0, 1).reshape(bsz, length, n_heads, p_dim)
    return y.astype(x.dtype), h_end.reshape(bsz, n_heads, p_dim, n_st).astype(h0.dtype)


def mlstm_scan(q, k, v, ig, logf, c0, n0, m0):
    bsz, length, n_heads, _ = q.shape
    ql = _chunk_len(length, ML_CHUNK)
    nc = length // ql
    f32 = jnp.float32
    xs = tuple(_to_chunks(t.astype(f32), nc, ql) for t in (q, k, v, ig, logf))
    causal = jnp.tril(jnp.ones((ql, ql), dtype=bool))

    def step(carry, inp):
        c_st, n_st, m_st = carry
        qc, kc, vc, ic, fc = inp
        b = jnp.cumsum(fc, axis=1)
        log_d = jnp.where(causal[None, :, :, None], b[:, :, None] - b[:, None] + ic[:, None], -jnp.inf)
        inter = b + m_st[:, None]
        m_t = jnp.maximum(jnp.max(log_d, axis=2), inter)
        dmat = jnp.exp(log_d - m_t[:, :, None])
        s_inter = jnp.exp(inter - m_t)
        s = jnp.einsum('bthd,bshd->btsh', qc, kc) * dmat
        num = jnp.einsum('btsh,bshv->bthv', s, vc) + s_inter[..., None] * jnp.einsum('bthd,bhdv->bthv', qc, c_st)
        den = jnp.sum(s, axis=2) + s_inter * jnp.einsum('bthd,bhd->bth', qc, n_st)
        h = num / jnp.maximum(jnp.abs(den), jnp.exp(-m_t))[..., None]
        m_end = m_t[:, -1]
        w_end = jnp.exp(b[:, -1:] - b + ic - m_end[:, None])
        scale = jnp.exp(b[:, -1] + m_st - m_end)
        c_new = scale[..., None, None] * c_st + jnp.einsum('bsh,bshd,bshv->bhdv', w_end, kc, vc)
        n_new = scale[..., None] * n_st + jnp.einsum('bsh,bshd->bhd', w_end, kc)
        return (c_new, n_new, m_end), h

    (c_end, n_end, m_end), hs = lax.scan(step, (c0.astype(f32), n0.astype(f32), m0.astype(f32)), xs)
    h = jnp.moveaxis(hs, 0, 1).reshape(bsz, length, n_heads, v.shape[-1])
    return h.astype(q.dtype), c_end.astype(c0.dtype), n_end.astype(n0.dtype), m_end.astype(m0.dtype)


def memory_kv(mem, g_mem, w_mem_k, w_mem_v):
    bsz = mem.shape[0]
    u = _rms(mem) * g_mem
    mk = (u @ w_mem_k).reshape(bsz, N_MEM, X_HEADS, X_HEAD_DIM)
    mv = (u @ w_mem_v).reshape(bsz, N_MEM, X_HEADS, X_HEAD_DIM)
    return mk, mv


def hybrid_layer(x, mem_k, mem_v, conv_buf, h_ssm, mc, mn, mm,
                 g_pre_mix, w_in, conv_w, conv_b, dt_bias, a_log, d_skip, g_ssm_out,
                 b_igate, b_fgate, g_mlstm_out, w_out, g_post_mix,
                 g_pre_x, w_xq, w_xo, g_post_x, g_pre_ffn, w_gate, w_up, w_down, g_post_ffn):
    bsz, length, _ = x.shape
    u = _rms(x) * g_pre_mix
    proj = u @ w_in
    split_at = np.cumsum([SSM_INNER, SSM_CONV_DIM, SSM_HEADS, ML_QK_WIDTH, ML_QK_WIDTH,
                          ML_INNER, ML_HEADS, ML_HEADS]).tolist()
    z, xbc, dt_raw, q, k, v, ig, fg, og = jnp.split(proj, split_at, axis=-1)
    xbc, conv_new = causal_conv(xbc, conv_buf, conv_w, conv_b)
    xbc = jax.nn.silu(xbc)
    xs, bm, cm = jnp.split(xbc, [SSM_INNER, SSM_INNER + SSM_GROUPS * SSM_STATE], axis=-1)
    xs = xs.reshape(bsz, length, SSM_HEADS, SSM_HEAD_DIM)
    bm = bm.reshape(bsz, length, SSM_GROUPS, SSM_STATE)
    cm = cm.reshape(bsz, length, SSM_GROUPS, SSM_STATE)
    dt = jax.nn.softplus(dt_raw.astype(jnp.float32) + dt_bias.astype(jnp.float32))
    a = -jnp.exp(a_log.astype(jnp.float32))
    y_ssd, h_new = ssd_scan(xs, dt, a, bm, cm, h_ssm)
    y_ssd = (y_ssd + d_skip[:, None] * xs).reshape(bsz, length, SSM_INNER) * jax.nn.silu(z)
    y_ssd = _rms(y_ssd.reshape(bsz, length, SSM_GROUPS, SSM_INNER // SSM_GROUPS)).reshape(bsz, length, SSM_INNER) * g_ssm_out
    q = q.reshape(bsz, length, ML_HEADS, ML_QK_DIM) * (ML_QK_DIM ** -0.5)
    k = k.reshape(bsz, length, ML_HEADS, ML_QK_DIM)
    v = v.reshape(bsz, length, ML_HEADS, ML_V_DIM)
    i_pre = (ig + b_igate).astype(jnp.float32)
    logf = jax.nn.log_sigmoid((fg + b_fgate).astype(jnp.float32))
    h_ml, c_new, n_new, m_new = mlstm_scan(q, k, v, i_pre, logf, mc, mn, mm)
    h_ml = _rms(h_ml).reshape(bsz, length, ML_INNER) * g_mlstm_out * jax.nn.sigmoid(og)
    mix = jnp.concatenate([y_ssd.astype(x.dtype), h_ml.astype(x.dtype)], axis=-1) @ w_out
    x = x + _rms(mix) * g_post_mix
    u = _rms(x) * g_pre_x
    qx = (u @ w_xq).reshape(bsz, length, X_HEADS, X_HEAD_DIM)
    sc = jnp.einsum('blhd,bmhd->bhlm', qx, mem_k).astype(jnp.float32) * (X_HEAD_DIM ** -0.5)
    pr = jax.nn.softmax(sc, axis=-1).astype(x.dtype)
    o = jnp.einsum('bhlm,bmhd->blhd', pr, mem_v).reshape(bsz, length, X_WIDTH) @ w_xo
    x = x + _rms(o) * g_post_x
    u = _rms(x) * g_pre_ffn
    f = (jax.nn.silu(u @ w_gate) * (u @ w_up)) @ w_down
    x = x + _rms(f) * g_post_ffn
    return x, conv_new, h_new, c_new, n_new, m_new


def setup_inputs(seed: int = 0) -> dict:
    key = jax.random.key(seed)
    ks = iter(jax.random.split(key, 64))

    def nrm(shape, scale):
        return jax.random.normal(next(ks), shape, jnp.float32) * scale

    def gain(width):
        return 1.0 + nrm((DEPTH, width), 0.05)

    dt0 = jnp.exp(jax.random.uniform(next(ks), (DEPTH, SSM_HEADS), jnp.float32, math.log(1e-3), math.log(0.1)))
    return {
        'x_prompt': nrm((BATCH, SEQ, D_MODEL), 1.0),
        'x_sample': nrm((DEC_BATCH, DEC_SEQ, D_MODEL), 1.0),
        'mem_prompt': nrm((BATCH, N_MEM, D_MODEL), 1.0),
        'state_ssm': nrm((DEPTH, DEC_BATCH, SSM_HEADS, SSM_HEAD_DIM, SSM_STATE), 0.1),
        'state_conv': nrm((DEPTH, DEC_BATCH, SSM_CONV - 1, SSM_CONV_DIM), 1.0),
        'state_mlstm_c': nrm((DEPTH, DEC_BATCH, ML_HEADS, ML_QK_DIM, ML_V_DIM), 0.1),
        'state_mlstm_n': nrm((DEPTH, DEC_BATCH, ML_HEADS, ML_QK_DIM), 0.1),
        'state_mlstm_m': nrm((DEPTH, DEC_BATCH, ML_HEADS), 0.5),
        'cache_mem_k': nrm((DEPTH, DEC_BATCH, N_MEM, X_HEADS, X_HEAD_DIM), 1.0),
        'cache_mem_v': nrm((DEPTH, DEC_BATCH, N_MEM, X_HEADS, X_HEAD_DIM), 1.0),
        'g_pre_mix': gain(D_MODEL),
        'w_in': nrm((DEPTH, D_MODEL, IN_WIDTH), D_MODEL ** -0.5),
        'conv_w': nrm((DEPTH, SSM_CONV, SSM_CONV_DIM), SSM_CONV ** -0.5),
        'conv_b': nrm((DEPTH, SSM_CONV_DIM), 0.02),
        'dt_bias': dt0 + jnp.log(-jnp.expm1(-dt0)),
        'a_log': jnp.log(jax.random.uniform(next(ks), (DEPTH, SSM_HEADS), jnp.float32, 1.0, 16.0)),
        'd_skip': 1.0 + nrm((DEPTH, SSM_HEADS), 0.1),
        'g_ssm_out': gain(SSM_INNER),
        'b_igate': nrm((DEPTH, ML_HEADS), 0.1),
        'b_fgate': 3.0 + jax.random.uniform(next(ks), (DEPTH, ML_HEADS), jnp.float32, 0.0, 3.0),
        'g_mlstm_out': gain(ML_INNER),
        'w_out': nrm((DEPTH, MIX_WIDTH, D_MODEL), MIX_WIDTH ** -0.5),
        'g_post_mix': gain(D_MODEL),
        'g_mem': gain(D_MODEL),
        'w_mem_k': nrm((DEPTH, D_MODEL, X_WIDTH), D_MODEL ** -0.5),
        'w_mem_v': nrm((DEPTH, D_MODEL, X_WIDTH), D_MODEL ** -0.5),
        'g_pre_x': gain(D_MODEL),
        'w_xq': nrm((DEPTH, D_MODEL, X_WIDTH), D_MODEL ** -0.5),
        'w_xo': nrm((DEPTH, X_WIDTH, D_MODEL), X_WIDTH ** -0.5),
        'g_post_x': gain(D_MODEL),
        'g_pre_ffn': gain(D_MODEL),
        'w_gate': nrm((DEPTH, D_MODEL, FFN_HIDDEN), D_MODEL ** -0.5),
        'w_up': nrm((DEPTH, D_MODEL, FFN_HIDDEN), D_MODEL ** -0.5),
        'w_down': nrm((DEPTH, FFN_HIDDEN, D_MODEL), FFN_HIDDEN ** -0.5),
        'g_post_ffn': gain(D_MODEL),
    }


def reference(x_prompt, x_sample, mem_prompt, state_ssm, state_conv, state_mlstm_c, state_mlstm_n,
              state_mlstm_m, cache_mem_k, cache_mem_v, g_pre_mix, w_in, conv_w, conv_b, dt_bias, a_log,
              d_skip, g_ssm_out, b_igate, b_fgate, g_mlstm_out, w_out, g_post_mix, g_mem, w_mem_k, w_mem_v,
              g_pre_x, w_xq, w_xo, g_post_x, g_pre_ffn, w_gate, w_up, w_down, g_post_ffn):
    yp, ys = x_prompt, x_sample
    dtp = x_prompt.dtype
    mk_l, mv_l = [], []
    ssm_p, conv_p, c_p, n_p, m_p = [], [], [], [], []
    ssm_s, conv_s, c_s, n_s, m_s = [], [], [], [], []
    for l in range(DEPTH):
        lw = (g_pre_mix[l], w_in[l], conv_w[l], conv_b[l], dt_bias[l], a_log[l], d_skip[l], g_ssm_out[l],
              b_igate[l], b_fgate[l], g_mlstm_out[l], w_out[l], g_post_mix[l],
              g_pre_x[l], w_xq[l], w_xo[l], g_post_x[l], g_pre_ffn[l], w_gate[l], w_up[l], w_down[l], g_post_ffn[l])
        mk, mv = memory_kv(mem_prompt, g_mem[l], w_mem_k[l], w_mem_v[l])
        bp = yp.shape[0]
        yp, cb, hs, cc, nn, mm = hybrid_layer(
            yp, mk, mv,
            jnp.zeros((bp, SSM_CONV - 1, SSM_CONV_DIM), dtp),
            jnp.zeros((bp, SSM_HEADS, SSM_HEAD_DIM, SSM_STATE), dtp),
            jnp.zeros((bp, ML_HEADS, ML_QK_DIM, ML_V_DIM), dtp),
            jnp.zeros((bp, ML_HEADS, ML_QK_DIM), dtp),
            jnp.zeros((bp, ML_HEADS), dtp), *lw)
        mk_l.append(mk); mv_l.append(mv)
        ssm_p.append(hs); conv_p.append(cb); c_p.append(cc); n_p.append(nn); m_p.append(mm)
        ys, cb, hs, cc, nn, mm = hybrid_layer(
            ys, cache_mem_k[l], cache_mem_v[l], state_conv[l], state_ssm[l],
            state_mlstm_c[l], state_mlstm_n[l], state_mlstm_m[l], *lw)
        ssm_s.append(hs); conv_s.append(cb); c_s.append(cc); n_s.append(nn); m_s.append(mm)
    return (yp, ys,
            jnp.stack(mk_l), jnp.stack(mv_l),
            jnp.stack(ssm_p), jnp.stack(conv_p), jnp.stack(c_p), jnp.stack(n_p), jnp.stack(m_p),
            jnp.stack(ssm_s), jnp.stack(conv_s), jnp.stack(c_s), jnp.stack(n_s), jnp.stack(m_s))
```

```cpp
#include <hip/hip_runtime.h>
#include <hip/hip_cooperative_groups.h>
#include <cstdio>
#include <cstdint>
namespace cg = cooperative_groups;

#define LAS __attribute__((address_space(3)))
typedef unsigned short bf16_t;
typedef short bf16x8 __attribute__((ext_vector_type(8)));
typedef float f32x4 __attribute__((ext_vector_type(4)));
typedef float f32x2 __attribute__((ext_vector_type(2)));
typedef unsigned u32x4 __attribute__((ext_vector_type(4)));
typedef unsigned u32x2 __attribute__((ext_vector_type(2)));
typedef LAS unsigned char* ldsp;

typedef __bf16 bf16v2_t __attribute__((ext_vector_type(2)));
__device__ __forceinline__ unsigned cvt_pk_bf16(float lo, float hi) { f32x2 v = {lo, hi}; bf16v2_t b = __builtin_convertvector(v, bf16v2_t); return __builtin_bit_cast(unsigned, b); }
__device__ __forceinline__ float bf2f(unsigned short b) { return __uint_as_float(((unsigned)b) << 16); }
__device__ __forceinline__ float bflo(unsigned w) { return __uint_as_float(w << 16); }
__device__ __forceinline__ float bfhi(unsigned w) { return __uint_as_float(w & 0xffff0000u); }
__device__ __forceinline__ unsigned short f2bf(float f) { return (unsigned short)(cvt_pk_bf16(f, 0.f) & 0xffffu); }
__device__ __forceinline__ float wave_sum(float v) {
#pragma unroll
    for (int o = 1; o < 64; o <<= 1) v += __shfl_xor(v, o);
    return v;
}
__device__ __forceinline__ float wave_max(float v) {
#pragma unroll
    for (int o = 1; o < 64; o <<= 1) v = fmaxf(v, __shfl_xor(v, o));
    return v;
}
__device__ __forceinline__ float softplusf(float x) { return x > 20.f ? x : __logf(1.f + __expf(x)); }
__device__ __forceinline__ float siluf(float x) { return x * __builtin_amdgcn_rcpf(1.f + __expf(-x)); }
__device__ __forceinline__ float sigmoidf_(float x) { return __builtin_amdgcn_rcpf(1.f + __expf(-x)); }
#define LDS_WAIT() asm volatile("s_waitcnt lgkmcnt(0)" ::: "memory")
__device__ __forceinline__ int fresh_tid() { int t = threadIdx.x; asm volatile("" : "+v"(t)); return t; }

namespace pg8 {
constexpr int BM = 256, BK = 64, HALF = 128, HTB = HALF * BK * 2, STAGE_BYTES = 8 * HTB, NXCD = 8, WGM = 8;
__host__ __device__ __forceinline__ int lds_byte(int r, int c) { const int st = (r >> 4) * 2 + (c >> 5), rr = r & 15, cc = c & 31, ob = rr * 64 + cc * 2; return st * 1024 + (ob ^ (((ob >> 9) & 1) << 5)); }
__host__ __device__ __forceinline__ void stage_rc(int b, int& R, int& C) { const int st = b / 1024, sb = b % 1024, swz = sb ^ (((sb >> 9) & 1) << 5); R = (st >> 1) * 16 + swz / 64; C = (st & 1) * 32 + (swz % 64) / 2; }
__host__ __device__ __forceinline__ int perm32(int rho) { const int n = rho >> 4, i = rho & 15; return 8 * (i >> 2) + 4 * n + (i & 3); }
struct Unit { int pm, pn; };
struct Gemm { const bf16_t* A; const bf16_t* Bt; int M, N, K; int ld; };
struct StaticOrder {
    int nM, nN, nwg, G, c;
    __host__ __device__ void init(int M, int N, int G_, int c_) { nM = M / BM; nN = N / BM; nwg = nM * nN; G = G_; c = c_; }
    __host__ __device__ bool next(int i, Unit& u) const {
        const long L = (long)i * G + c; if (L >= nwg) return false;
        int wgid = (int)L; { const int q = nwg / NXCD, r = nwg % NXCD, xcd = wgid % NXCD, off = wgid / NXCD; wgid = (xcd < r ? xcd * (q + 1) : r * (q + 1) + (xcd - r) * q) + off; }
        const int nig = WGM * nN, gid = wgid / nig, fm = gid * WGM, gsz = (nM - fm) < WGM ? (nM - fm) : WGM;
        u.pm = fm + ((wgid % nig) % gsz); u.pn = (wgid % nig) / gsz; return true;
    }
    __device__ __forceinline__ void a_ready(const Unit&) const {}
    __device__ __forceinline__ void done(const Unit&) const {}
};
template <class Epi, class Sched, bool ALIGN_EPI = false, bool SP2 = false>
__device__ __forceinline__ void gemm_phase(ldsp lds, const Gemm g, const Sched& S, const Epi& E) {
    const int tid = fresh_tid(), wid = __builtin_amdgcn_readfirstlane(tid >> 6), lane = tid & 63, wr = wid >> 2, wc = wid & 3, fr = lane & 15, fq = lane >> 4;
    const int nt = g.K / BK, K = g.ld ? g.ld : g.K;
    unsigned voffA[2], voffB[2];
#pragma unroll
    for (int i = 0; i < 2; ++i) { int R, C; stage_rc(tid * 16 + i * 8192, R, C); const int Rb = Epi::PERM ? ((R & ~31) + perm32(R & 31)) : R;
        voffA[i] = (unsigned)(R * K + C) * 2u; voffB[i] = (unsigned)(Rb * K + C) * 2u; }
    const size_t kstep = (size_t)(BK * 2);
    const size_t hstep = (size_t)HALF * K * 2;
    const size_t tstep = 2 * hstep;
    const unsigned ldsw = (unsigned)wid * 1024u;
    const int aoff = lds_byte(wr * 64 + fr, fq * 8), boff = lds_byte(wc * 32 + fr, fq * 8);
#define PG8_SA(b, h) (((b) * 2 + (h)) * HTB)
#define PG8_SB(b, h) ((4 + (b) * 2 + (h)) * HTB)
#define PG8_STAGE(bufoff, gbase, voff) do { _Pragma("unroll") for (int _i = 0; _i < 2; ++_i) \
        __builtin_amdgcn_global_load_lds((const unsigned*)((const char*)(gbase) + (voff)[_i]), (LAS unsigned*)(lds + (bufoff) + ldsw + _i * 8192), 16, 0, 0); } while (0)
#define PG8_LDA(dst, b, h) do { _Pragma("unroll") for (int m = 0; m < 4; ++m) _Pragma("unroll") for (int k = 0; k < 2; ++k) dst[m][k] = *(const LAS bf16x8*)(lds + PG8_SA(b, h) + aoff + m * 2048 + k * 1024); } while (0)
#define PG8_LDB(dst, b, h) do { _Pragma("unroll") for (int n = 0; n < 2; ++n) _Pragma("unroll") for (int k = 0; k < 2; ++k) dst[n][k] = *(const LAS bf16x8*)(lds + PG8_SB(b, h) + boff + n * 2048 + k * 1024); } while (0)
#define PG8_MMA(ai, bj, At, Bt) do { __builtin_amdgcn_s_setprio(1); _Pragma("unroll") for (int m = 0; m < 4; ++m) _Pragma("unroll") for (int n = 0; n < 2; ++n) _Pragma("unroll") for (int k = 0; k < 2; ++k) \
        acc[ai][bj][m][n] = __builtin_amdgcn_mfma_f32_16x16x32_bf16(Bt[n][k], At[m][k], acc[ai][bj][m][n], 0, 0, 0); __builtin_amdgcn_s_setprio(0); } while (0)
#define PG8_WAIT_V(n) asm volatile("s_waitcnt vmcnt(" #n ")" ::: "memory")
#define PG8_WAIT_L(n) asm volatile("s_waitcnt lgkmcnt(" #n ")" ::: "memory")
#define PG8_BAR __builtin_amdgcn_s_barrier()
#define PG8_SCHED __builtin_amdgcn_sched_barrier(0)
    Unit cur, nxt; int ui = 0;
    if (!S.next(0, cur)) return;
    f32x4 acc[2][2][4][2];
#pragma unroll
    for (int a = 0; a < 2; ++a)
#pragma unroll
        for (int b = 0; b < 2; ++b)
#pragma unroll
            for (int m = 0; m < 4; ++m)
#pragma unroll
                for (int n = 0; n < 2; ++n) acc[a][b][m][n] = (f32x4){0.f, 0.f, 0.f, 0.f};
    bf16x8 At[4][2], B0[2][2], B1[2][2];
    const char* cA = (const char*)g.A + (size_t)cur.pm * tstep; const char* cB = (const char*)g.Bt + (size_t)cur.pn * tstep;
    S.a_ready(cur);
    if constexpr (SP2) {
        PG8_STAGE(PG8_SB(0, 0), cB, voffB); PG8_STAGE(PG8_SB(0, 1), cB + hstep, voffB); PG8_STAGE(PG8_SA(0, 0), cA, voffA); PG8_STAGE(PG8_SA(0, 1), cA + hstep, voffA);
        if (wr == 1) PG8_BAR;
        PG8_WAIT_V(2); PG8_BAR;
        PG8_STAGE(PG8_SB(1, 0), cB + kstep, voffB); PG8_STAGE(PG8_SA(1, 0), cA + kstep, voffA); PG8_STAGE(PG8_SB(1, 1), cB + hstep + kstep, voffB);
        PG8_WAIT_V(6); PG8_BAR;
    } else {
        PG8_STAGE(PG8_SB(0, 0), cB, voffB); PG8_STAGE(PG8_SA(0, 0), cA, voffA); PG8_STAGE(PG8_SB(0, 1), cB + hstep, voffB); PG8_STAGE(PG8_SA(0, 1), cA + hstep, voffA);
        if (wr == 1) PG8_BAR;
        PG8_WAIT_V(4); PG8_BAR;
        PG8_STAGE(PG8_SB(1, 0), cB + kstep, voffB); PG8_STAGE(PG8_SA(1, 0), cA + kstep, voffA); PG8_STAGE(PG8_SB(1, 1), cB + hstep + kstep, voffB);
        PG8_WAIT_V(6); PG8_BAR;
    }
    for (;;) {
        const bool has_next = S.next(ui + 1, nxt);
        const char* nA = has_next ? (const char*)g.A + (size_t)nxt.pm * tstep : cA; const char* nB = has_next ? (const char*)g.Bt + (size_t)nxt.pn * tstep : cB;
        for (int t = 0; t < nt; t += 2) {
            const bool last = (t == nt - 2);
            const char* a1 = cA + (size_t)(t + 1) * kstep;
            const char* a2 = last ? nA : cA + (size_t)(t + 2) * kstep; const char* b2 = last ? nB : cB + (size_t)(t + 2) * kstep;
            const char* a3 = a2 + kstep; const char* b3 = b2 + kstep;
            if (last && has_next) S.a_ready(nxt);
            if constexpr (SP2) {
            PG8_LDB(B0, 0, 0); PG8_LDB(B1, 0, 1); PG8_SCHED; PG8_LDA(At, 0, 0); PG8_STAGE(PG8_SA(1, 1), a1 + hstep, voffA);
            PG8_WAIT_V(8); PG8_WAIT_L(0); PG8_BAR; PG8_MMA(0, 0, At, B0); PG8_MMA(0, 1, At, B1); PG8_BAR; PG8_SCHED;
            PG8_LDA(At, 0, 1); PG8_STAGE(PG8_SB(0, 0), b2, voffB); PG8_STAGE(PG8_SB(0, 1), b2 + hstep, voffB); PG8_STAGE(PG8_SA(0, 0), a2, voffA);
            PG8_WAIT_V(8); PG8_WAIT_L(0); PG8_BAR; PG8_MMA(1, 0, At, B0); PG8_MMA(1, 1, At, B1); PG8_BAR; PG8_SCHED;
            PG8_LDB(B0, 1, 0); PG8_LDB(B1, 1, 1); PG8_SCHED; PG8_LDA(At, 1, 0); PG8_STAGE(PG8_SA(0, 1), a2 + hstep, voffA);
            PG8_WAIT_V(8); PG8_WAIT_L(0); PG8_BAR; PG8_MMA(0, 0, At, B0); PG8_MMA(0, 1, At, B1); PG8_BAR; PG8_SCHED;
            PG8_LDA(At, 1, 1); PG8_STAGE(PG8_SB(1, 0), b3, voffB); PG8_STAGE(PG8_SB(1, 1), b3 + hstep, voffB); PG8_STAGE(PG8_SA(1, 0), a3, voffA);
            PG8_WAIT_V(8); PG8_WAIT_L(0); PG8_BAR; PG8_MMA(1, 0, At, B0); PG8_MMA(1, 1, At, B1); PG8_BAR; PG8_SCHED;
            } else {
            PG8_LDB(B0, 0, 0); PG8_SCHED; PG8_LDA(At, 0, 0); PG8_STAGE(PG8_SA(1, 1), a1 + hstep, voffA);
            PG8_WAIT_L(8); PG8_BAR; PG8_WAIT_L(0); PG8_MMA(0, 0, At, B0); PG8_BAR; PG8_SCHED;
            PG8_LDB(B1, 0, 1); PG8_STAGE(PG8_SB(0, 0), b2, voffB);
            PG8_BAR; PG8_WAIT_L(0); PG8_MMA(0, 1, At, B1); PG8_BAR;
            PG8_LDA(At, 0, 1); PG8_STAGE(PG8_SA(0, 0), a2, voffA);
            PG8_BAR; PG8_WAIT_L(0); PG8_MMA(1, 0, At, B0); PG8_BAR; PG8_SCHED;
            PG8_STAGE(PG8_SB(0, 1), b2 + hstep, voffB);
            PG8_WAIT_V(6); PG8_BAR; PG8_MMA(1, 1, At, B1); PG8_BAR;
            PG8_LDB(B0, 1, 0); PG8_SCHED; PG8_LDA(At, 1, 0); PG8_STAGE(PG8_SA(0, 1), a2 + hstep, voffA);
            PG8_WAIT_L(8); PG8_BAR; PG8_WAIT_L(0); PG8_MMA(0, 0, At, B0); PG8_BAR; PG8_SCHED;
            PG8_LDB(B1, 1, 1); PG8_STAGE(PG8_SB(1, 0), b3, voffB);
            PG8_BAR; PG8_WAIT_L(0); PG8_MMA(0, 1, At, B1); PG8_BAR;
            PG8_LDA(At, 1, 1); PG8_STAGE(PG8_SA(1, 0), a3, voffA);
            PG8_BAR; PG8_WAIT_L(0); PG8_MMA(1, 0, At, B0); PG8_BAR; PG8_SCHED;
            PG8_STAGE(PG8_SB(1, 1), b3 + hstep, voffB);
            PG8_WAIT_V(6); PG8_BAR; PG8_MMA(1, 1, At, B1); PG8_BAR;
            }
        }
        if constexpr (ALIGN_EPI) { if (wr == 0) PG8_BAR; }
        E(acc, cur, wr, wc, fr, fq);
        if (!has_next) break;
#pragma unroll
        for (int a = 0; a < 2; ++a)
#pragma unroll
            for (int b = 0; b < 2; ++b)
#pragma unroll
                for (int m = 0; m < 4; ++m)
#pragma unroll
                    for (int n = 0; n < 2; ++n) acc[a][b][m][n] = (f32x4){0.f, 0.f, 0.f, 0.f};
        cur = nxt; cA = nA; cB = nB; ++ui;
        if constexpr (ALIGN_EPI) { if (wr == 1) PG8_BAR; }
    }
    PG8_WAIT_V(0);
    if constexpr (!ALIGN_EPI) { if (wr == 0) PG8_BAR; }
    PG8_BAR;
#undef PG8_SA
#undef PG8_SB
#undef PG8_STAGE
#undef PG8_LDA
#undef PG8_LDB
#undef PG8_MMA
#undef PG8_WAIT_V
#undef PG8_WAIT_L
#undef PG8_BAR
#undef PG8_SCHED
}
}

constexpr int DM = 1024, MP = 16384, MS = 1024, MT = 17408, NMEMROWS = 2048;
constexpr int PROJ_LD = 5632, N1PAD = 5888, XBC_LD = 1536, YP_LD = 2048, FFH = 2816;
constexpr float EPSN = 1e-6f;
constexpr size_t MiB = 1u << 20;
constexpr size_t WS_W1T = 1 * MiB, WS_W2T = 13 * MiB, WS_WKVT = 17 * MiB, WS_WXQT = 21 * MiB, WS_WXOT = 23 * MiB, WS_WGUT = 25 * MiB, WS_WDT = 36 * MiB;
constexpr size_t WS_U = 42 * MiB, WS_UM = 76 * MiB, WS_KM = 80 * MiB, WS_VMT = 84 * MiB, WS_GATES = 88 * MiB, WS_BIG = 91 * MiB;
constexpr size_t WS_XBC = 278 * MiB, WS_YPRE = 329 * MiB, WS_A2 = 397 * MiB, WS_END = 465 * MiB;
constexpr size_t WS_QX = WS_BIG, WS_O = WS_BIG + 34 * MiB, WS_HID = WS_BIG + 68 * MiB, WS_R1 = WS_XBC;
constexpr size_t O_YP = 0, O_YS = 16777216, O_MK = 17825792, O_MV = 19922944, O_SSMP = 22020096, O_CONVP = 23068672, O_MCP = 23105536, O_MNP = 24154112, O_MMP = 24158208,
                 O_SSMS = 24158240, O_CONVS = 40935456, O_MCS = 41525280, O_MNS = 58302496, O_MMS = 58368032;
constexpr int LDS_BYTES = 147456;

struct Params { const float* in[35]; float* out; unsigned char* ws; };
typedef const __attribute__((address_space(4))) Params* KPtr;
__device__ __forceinline__ KPtr kparams() { KPtr k = (KPtr)__builtin_amdgcn_kernarg_segment_ptr(); asm volatile("" : "+s"(k)); return k; }

struct EpiG1 {
    static constexpr bool PERM = true;
    bf16_t* proj; float* gates;
    __device__ __forceinline__ void operator()(const f32x4 (&acc)[2][2][4][2], const pg8::Unit& u, int wr, int wc, int fr, int fq) const {
        const int row0 = u.pm * 256 + wr * 64 + fr;
        if (u.pn < 22) {
            const int col0 = u.pn * 256 + wc * 32 + 8 * fq;
#pragma unroll
            for (int ai = 0; ai < 2; ++ai)
#pragma unroll
                for (int m = 0; m < 4; ++m) { bf16_t* rowp = proj + (size_t)(row0 + ai * 128 + m * 16) * PROJ_LD + col0;
#pragma unroll
                    for (int bj = 0; bj < 2; ++bj) { const f32x4 v0 = acc[ai][bj][m][0], v1 = acc[ai][bj][m][1]; u32x4 w;
                        w.x = cvt_pk_bf16(v0[0], v0[1]); w.y = cvt_pk_bf16(v0[2], v0[3]); w.z = cvt_pk_bf16(v1[0], v1[1]); w.w = cvt_pk_bf16(v1[2], v1[3]);
                        *(u32x4*)(rowp + bj * 128) = w; } }
        } else if (wc == 0) {
#pragma unroll
            for (int ai = 0; ai < 2; ++ai)
#pragma unroll
                for (int m = 0; m < 4; ++m) { float* rp = gates + (size_t)(row0 + ai * 128 + m * 16) * 32 + 8 * fq;
                    *(f32x4*)rp = acc[ai][0][m][0]; *(f32x4*)(rp + 4) = acc[ai][0][m][1]; }
        }
    }
};
struct EpiKV {
    static constexpr bool PERM = true;
    float* outk; float* outv; bf16_t* km; bf16_t* vmt;
    __device__ __forceinline__ void operator()(const f32x4 (&acc)[2][2][4][2], const pg8::Unit& u, int wr, int wc, int fr, int fq) const {
        const int row0 = u.pm * 256 + wr * 64 + fr;
#pragma unroll
        for (int ai = 0; ai < 2; ++ai)
#pragma unroll
            for (int m = 0; m < 4; ++m) { const int row = row0 + ai * 128 + m * 16;
#pragma unroll
                for (int bj = 0; bj < 2; ++bj) { const int c = u.pn * 256 + bj * 128 + wc * 32 + 8 * fq; const f32x4 v0 = acc[ai][bj][m][0], v1 = acc[ai][bj][m][1];
                    if (u.pn < 4) {
                        *(f32x4*)(outk + (size_t)row * 1024 + c) = v0; *(f32x4*)(outk + (size_t)row * 1024 + c + 4) = v1;
                        u32x4 w; w.x = cvt_pk_bf16(v0[0], v0[1]); w.y = cvt_pk_bf16(v0[2], v0[3]); w.z = cvt_pk_bf16(v1[0], v1[1]); w.w = cvt_pk_bf16(v1[2], v1[3]);
                        *(u32x4*)(km + (size_t)row * 1024 + c) = w;
                    } else {
                        const int c2 = c - 1024;
                        *(f32x4*)(outv + (size_t)row * 1024 + c2) = v0; *(f32x4*)(outv + (size_t)row * 1024 + c2 + 4) = v1;
                        const int b = row >> 8, mt = row & 255, h = c2 >> 8, d = c2 & 255;
                        bf16_t* vp = vmt + ((size_t)(b * 4 + h) * 256 + d) * 256 + mt;
#pragma unroll
                        for (int j = 0; j < 4; ++j) { vp[(size_t)j * 256] = f2bf(v0[j]); vp[(size_t)(j + 4) * 256] = f2bf(v1[j]); }
                    } } }
    }
};
struct EpiB {
    static constexpr bool PERM = true;
    bf16_t* O; int ldc; float scale;
    __device__ __forceinline__ void operator()(const f32x4 (&acc)[2][2][4][2], const pg8::Unit& u, int wr, int wc, int fr, int fq) const {
        const int row0 = u.pm * 256 + wr * 64 + fr, col0 = u.pn * 256 + wc * 32 + 8 * fq;
#pragma unroll
        for (int ai = 0; ai < 2; ++ai)
#pragma unroll
            for (int m = 0; m < 4; ++m) { bf16_t* rowp = O + (size_t)(row0 + ai * 128 + m * 16) * ldc + col0;
#pragma unroll
                for (int bj = 0; bj < 2; ++bj) { const f32x4 v0 = acc[ai][bj][m][0] * scale, v1 = acc[ai][bj][m][1] * scale; u32x4 w;
                    w.x = cvt_pk_bf16(v0[0], v0[1]); w.y = cvt_pk_bf16(v0[2], v0[3]); w.z = cvt_pk_bf16(v1[0], v1[1]); w.w = cvt_pk_bf16(v1[2], v1[3]);
                    *(u32x4*)(rowp + bj * 128) = w; } }
    }
};
struct EpiP32 {
    static constexpr bool PERM = true;
    float* C; int ldc;
    __device__ __forceinline__ void operator()(const f32x4 (&acc)[2][2][4][2], const pg8::Unit& u, int wr, int wc, int fr, int fq) const {
        const int row0 = u.pm * 256 + wr * 64 + fr, col0 = u.pn * 256 + wc * 32 + 8 * fq;
#pragma unroll
        for (int ai = 0; ai < 2; ++ai)
#pragma unroll
            for (int m = 0; m < 4; ++m) { float* rowp = C + (size_t)(row0 + ai * 128 + m * 16) * ldc + col0;
#pragma unroll
                for (int bj = 0; bj < 2; ++bj) { *(f32x4*)(rowp + bj * 128) = acc[ai][bj][m][0]; *(f32x4*)(rowp + bj * 128 + 4) = acc[ai][bj][m][1]; } }
    }
};
struct EpiSwi {
    static constexpr bool PERM = true;
    bf16_t* hid;
    __device__ __forceinline__ void operator()(const f32x4 (&acc)[2][2][4][2], const pg8::Unit& u, int wr, int wc, int fr, int fq) const {
        const int row0 = u.pm * 256 + wr * 64 + fr, col0 = u.pn * 128 + wc * 32 + 8 * fq;
#pragma unroll
        for (int ai = 0; ai < 2; ++ai)
#pragma unroll
            for (int m = 0; m < 4; ++m) { bf16_t* rowp = hid + (size_t)(row0 + ai * 128 + m * 16) * FFH + col0;
                float r[8];
#pragma unroll
                for (int n = 0; n < 2; ++n)
#pragma unroll
                    for (int j = 0; j < 4; ++j) { const float gt = acc[ai][0][m][n][j], up = acc[ai][1][m][n][j]; r[n * 4 + j] = siluf(gt) * up; }
                u32x4 w; w.x = cvt_pk_bf16(r[0], r[1]); w.y = cvt_pk_bf16(r[2], r[3]); w.z = cvt_pk_bf16(r[4], r[5]); w.w = cvt_pk_bf16(r[6], r[7]);
                *(u32x4*)rowp = w; }
    }
};


#define XB_TMO      128
#define XB_XCNT(j)  (256  + 64 * (j))
#define XB_XSUB(j)  (1280 + 64 * (j))
#define XB_XGEN(j)  (2304 + 64 * (j))
#define XB_TOP      3328
#define XB_TOPGEN   3392
#define XB_SPIN_CAP (1u << 22)
__device__ __forceinline__ unsigned xb_ld(unsigned* p)              { return __hip_atomic_load(p, __ATOMIC_RELAXED, __HIP_MEMORY_SCOPE_AGENT); }
__device__ __forceinline__ unsigned xb_add(unsigned* p, unsigned v) { return __hip_atomic_fetch_add(p, v, __ATOMIC_RELAXED, __HIP_MEMORY_SCOPE_AGENT); }
__device__ __forceinline__ unsigned xb_xcc_id() { return (unsigned)__builtin_amdgcn_s_getreg((3 << 11) | 20) & 0xFu; }
#define XB_SPIN(cond, bar) do { unsigned _sp = 0; while (cond) { __builtin_amdgcn_s_sleep(1); \
    if ((++_sp & 255u) == 0u) { if (xb_ld(&(bar)[XB_TMO])) break; if (_sp > XB_SPIN_CAP) { atomicAdd(&(bar)[XB_TMO], 1u); break; } } } } while (0)
__device__ __forceinline__ void xcd_barrier_complete(unsigned* bar, unsigned x, unsigned& nloc, unsigned& nx) {
    const unsigned G = gridDim.x * gridDim.y * gridDim.z;
    unsigned sum, cnt, mine, sp = 0u;
    for (;;) {
        sum = 0u; cnt = 0u; mine = 0u;
#pragma unroll
        for (unsigned j = 0; j < 16; ++j) { const unsigned c = xb_ld(&bar[XB_XCNT(j)]); sum += c; cnt += (c > 0u) ? 1u : 0u; mine = (j == x) ? c : mine; }
        if (sum == G) break;
        __builtin_amdgcn_s_sleep(1);
        if ((++sp & 255u) == 0u) { if (xb_ld(&bar[XB_TMO])) break; if (sp > XB_SPIN_CAP) { atomicAdd(&bar[XB_TMO], 1u); break; } }
    }
    nloc = mine > 0u ? mine : 1u; nx = cnt > 0u ? cnt : 1u;
}
__device__ __forceinline__ void xcd_barrier(unsigned* bar, volatile LAS unsigned* st) {
    asm volatile("s_waitcnt vmcnt(0)" ::: "memory");
    __syncthreads();
    if (threadIdx.x == 0) {
        const unsigned x = xb_xcc_id();
        __builtin_amdgcn_s_waitcnt(0);
        unsigned nloc = st[0], nx = st[1];
        if (nloc == 0u) { xcd_barrier_complete(bar, x, nloc, nx); st[0] = nloc; st[1] = nx; }
        const unsigned old = xb_add(&bar[XB_XSUB(x)], 1u);
        const unsigned gen = old / nloc;
        if (old + 1u == (gen + 1u) * nloc) {
            __builtin_amdgcn_fence(__ATOMIC_RELEASE, "agent");
            asm volatile("s_waitcnt vmcnt(0)" ::: "memory");
            const unsigned og = xb_add(&bar[XB_TOP], 1u);
            const unsigned tg = og / nx;
            if (og + 1u == (tg + 1u) * nx) xb_add(&bar[XB_TOPGEN], 1u);
            else XB_SPIN(xb_ld(&bar[XB_TOPGEN]) == tg, bar);
            __builtin_amdgcn_fence(__ATOMIC_ACQUIRE, "agent");
            xb_add(&bar[XB_XGEN(x)], 1u);
            asm volatile("s_waitcnt vmcnt(0)" ::: "memory");
        } else {
            XB_SPIN(xb_ld(&bar[XB_XGEN(x)]) == gen, bar);
            __builtin_amdgcn_fence(__ATOMIC_ACQUIRE, "agent");
            asm volatile("s_waitcnt vmcnt(0)" ::: "memory");
        }
    }
    __syncthreads();
}

__device__ __forceinline__ void tr_item(const float* __restrict__ W, int ldn, int c0, int k0, bf16_t* WT, int Kp, int r0, LAS float* scr, int lane) {
#pragma unroll 16
    for (int i = 0; i < 32; ++i) { const int kk = 2 * i + (lane >> 5); scr[kk * 33 + (lane & 31)] = W[(size_t)(k0 + kk) * ldn + c0 + (lane & 31)]; }
    LDS_WAIT();
    const int c = lane & 7;
#pragma unroll
    for (int j = 0; j < 4; ++j) { const int n = (lane >> 3) + 8 * j; const LAS float* s = scr + (8 * c) * 33 + n;
        u32x4 o; o.x = cvt_pk_bf16(s[0 * 33], s[1 * 33]); o.y = cvt_pk_bf16(s[2 * 33], s[3 * 33]); o.z = cvt_pk_bf16(s[4 * 33], s[5 * 33]); o.w = cvt_pk_bf16(s[6 * 33], s[7 * 33]);
        *(u32x4*)(WT + (size_t)(r0 + n) * Kp + k0 + 8 * c) = o; }
    LDS_WAIT();
}
__device__ __forceinline__ void rms_row_to_bf16(const float* xrow, const float* g, bf16_t* orow, int lane) {
    const f32x4* xr = (const f32x4*)xrow + lane; const f32x4* gr = (const f32x4*)g + lane;
    f32x4 v[4]; float s = 0.f;
#pragma unroll
    for (int j = 0; j < 4; ++j) { v[j] = xr[64 * j]; s += (v[j].x * v[j].x + v[j].y * v[j].y) + (v[j].z * v[j].z + v[j].w * v[j].w); }
    const float rstd = rsqrtf(wave_sum(s) * (1.f / DM) + EPSN);
    u32x2* o8 = (u32x2*)orow + lane;
#pragma unroll
    for (int j = 0; j < 4; ++j) { const f32x4 gg = gr[64 * j]; u32x2 w; w.x = cvt_pk_bf16(v[j].x * rstd * gg.x, v[j].y * rstd * gg.y); w.y = cvt_pk_bf16(v[j].z * rstd * gg.z, v[j].w * rstd * gg.w); o8[64 * j] = w; }
}
__device__ __forceinline__ void p0_prologue(KPtr p, ldsp lds, int G) {
    const int tid = fresh_tid(), lane = tid & 63, wave = __builtin_amdgcn_readfirstlane(tid >> 6);
    LAS float* scr = (LAS float*)(lds + wave * 16384);
    const int gw = blockIdx.x * 8 + wave, NGW = G * 8;
    unsigned char* ws = p->ws;
    bf16_t* W1T = (bf16_t*)(ws + WS_W1T); bf16_t* W2T = (bf16_t*)(ws + WS_W2T); bf16_t* WKVT = (bf16_t*)(ws + WS_WKVT); bf16_t* WXQT = (bf16_t*)(ws + WS_WXQT);
    bf16_t* WXOT = (bf16_t*)(ws + WS_WXOT); bf16_t* WGUT = (bf16_t*)(ws + WS_WGUT); bf16_t* WDT = (bf16_t*)(ws + WS_WDT);
    constexpr int I0 = 80 * 16, I1 = 64 * 16, I2 = 32 * 16, I3 = 32 * 32, I4 = 32 * 16, I8 = 88 * 16, I10 = 44 * 32;
    constexpr int NITEMS = I0 + I1 + I2 + I3 + 4 * I4 + 2 * I8 + I10;
    for (int it = gw; it < NITEMS; it += NGW) {
        int r = it;
        if (r < I0) { const int kb = r / 80, nb = r % 80; tr_item(p->in[11], 5656, nb * 32, kb * 64, W1T, 1024, nb * 32, scr, lane); continue; } r -= I0;
        if (r < I1) { const int kb = r / 64, nb = r % 64; tr_item(p->in[11], 5656, 2576 + nb * 32, kb * 64, W1T, 1024, 2560 + nb * 32, scr, lane); continue; } r -= I1;
        if (r < I2) { const int kb = r / 32, nb = r % 32; tr_item(p->in[11], 5656, 4632 + nb * 32, kb * 64, W1T, 1024, 4608 + nb * 32, scr, lane); continue; } r -= I2;
        if (r < I3) { const int kb = r / 32, nb = r % 32; tr_item(p->in[21], 1024, nb * 32, kb * 64, W2T, 2048, nb * 32, scr, lane); continue; } r -= I3;
        if (r < I4) { const int kb = r / 32, nb = r % 32; tr_item(p->in[24], 1024, nb * 32, kb * 64, WKVT, 1024, nb * 32, scr, lane); continue; } r -= I4;
        if (r < I4) { const int kb = r / 32, nb = r % 32; tr_item(p->in[25], 1024, nb * 32, kb * 64, WKVT, 1024, 1024 + nb * 32, scr, lane); continue; } r -= I4;
        if (r < I4) { const int kb = r / 32, nb = r % 32; tr_item(p->in[27], 1024, nb * 32, kb * 64, WXQT, 1024, nb * 32, scr, lane); continue; } r -= I4;
        if (r < I4) { const int kb = r / 32, nb = r % 32; tr_item(p->in[28], 1024, nb * 32, kb * 64, WXOT, 1024, nb * 32, scr, lane); continue; } r -= I4;
        if (r < I8) { const int kb = r / 88, nb = r % 88, n0 = nb * 32; tr_item(p->in[31], FFH, n0, kb * 64, WGUT, 1024, 256 * (n0 >> 7) + (n0 & 127), scr, lane); continue; } r -= I8;
        if (r < I8) { const int kb = r / 88, nb = r % 88, n0 = nb * 32; tr_item(p->in[32], FFH, n0, kb * 64, WGUT, 1024, 256 * (n0 >> 7) + (n0 & 127) + 128, scr, lane); continue; } r -= I8;
        { const int kb = r / 32, nb = r % 32; tr_item(p->in[33], 1024, nb * 32, kb * 64, WDT, FFH, nb * 32, scr, lane); }
    }
    for (int idx = blockIdx.x * 512 + tid; idx < 256 * 1024; idx += G * 512) { const int j = idx >> 10, k = idx & 1023; float v = 0.f;
        if (j < 16) v = p->in[11][(size_t)k * 5656 + 2560 + j]; else if (j < 24) v = p->in[11][(size_t)k * 5656 + 4624 + (j - 16)];
        W1T[(size_t)(5632 + j) * 1024 + k] = f2bf(v); }
    bf16_t* U = (bf16_t*)(ws + WS_U); bf16_t* UM = (bf16_t*)(ws + WS_UM);
    for (int r = gw; r < MT + NMEMROWS; r += NGW) {
        if (r < MP) rms_row_to_bf16(p->in[0] + (size_t)r * DM, p->in[10], U + (size_t)r * DM, lane);
        else if (r < MT) rms_row_to_bf16(p->in[1] + (size_t)(r - MP) * DM, p->in[10], U + (size_t)r * DM, lane);
        else rms_row_to_bf16(p->in[2] + (size_t)(r - MT) * DM, p->in[23], UM + (size_t)(r - MT) * DM, lane);
    }
}

__device__ __forceinline__ void conv_phase(KPtr p, int G) {
    const bf16_t* PROJ = (const bf16_t*)(p->ws + WS_BIG); bf16_t* XBC = (bf16_t*)(p->ws + WS_XBC);
    const float* cw = p->in[12]; const float* cb = p->in[13]; const float* sconv = p->in[4];
    const int NIT = (MT / 8) * 192;
    for (int it = blockIdx.x * 512 + fresh_tid(); it < NIT; it += G * 512) {
        const int rg = it / 192, cg8 = it % 192, c0 = cg8 * 8, r0 = rg * 8;
        const bool samp = r0 >= MP; const int tl0 = samp ? 0 : (r0 & 2047);
        float win[11][8];
#pragma unroll
        for (int i = 0; i < 11; ++i) {
            const int rr = i - 3;
            if (rr >= 0 || tl0 > 0) { const u32x4 w = *(const u32x4*)(PROJ + (size_t)(r0 + rr) * PROJ_LD + 1024 + c0);
                win[i][0] = bflo(w.x); win[i][1] = bfhi(w.x); win[i][2] = bflo(w.y); win[i][3] = bfhi(w.y); win[i][4] = bflo(w.z); win[i][5] = bfhi(w.z); win[i][6] = bflo(w.w); win[i][7] = bfhi(w.w); }
            else if (samp) { const int b = (r0 - MP) >> 3; const float* sp = sconv + ((size_t)b * 3 + i) * XBC_LD + c0; const f32x4 a = *(const f32x4*)sp, bq = *(const f32x4*)(sp + 4);
                win[i][0] = a.x; win[i][1] = a.y; win[i][2] = a.z; win[i][3] = a.w; win[i][4] = bq.x; win[i][5] = bq.y; win[i][6] = bq.z; win[i][7] = bq.w; }
            else {
#pragma unroll
                for (int e = 0; e < 8; ++e) win[i][e] = 0.f; }
        }
        float w4[4][8], bb[8];
#pragma unroll
        for (int j = 0; j < 4; ++j) { const f32x4 a = *(const f32x4*)(cw + j * XBC_LD + c0), bq = *(const f32x4*)(cw + j * XBC_LD + c0 + 4);
            w4[j][0] = a.x; w4[j][1] = a.y; w4[j][2] = a.z; w4[j][3] = a.w; w4[j][4] = bq.x; w4[j][5] = bq.y; w4[j][6] = bq.z; w4[j][7] = bq.w; }
        { const f32x4 a = *(const f32x4*)(cb + c0), bq = *(const f32x4*)(cb + c0 + 4); bb[0] = a.x; bb[1] = a.y; bb[2] = a.z; bb[3] = a.w; bb[4] = bq.x; bb[5] = bq.y; bb[6] = bq.z; bb[7] = bq.w; }
#pragma unroll
        for (int t = 0; t < 8; ++t) { float y[8];
#pragma unroll
            for (int e = 0; e < 8; ++e) { float a = bb[e];
#pragma unroll
                for (int j = 0; j < 4; ++j) a += win[t + j][e] * w4[j][e];
                y[e] = siluf(a); }
            u32x4 w; w.x = cvt_pk_bf16(y[0], y[1]); w.y = cvt_pk_bf16(y[2], y[3]); w.z = cvt_pk_bf16(y[4], y[5]); w.w = cvt_pk_bf16(y[6], y[7]);
            *(u32x4*)(XBC + (size_t)(r0 + t) * XBC_LD + c0) = w; }
        if (samp || tl0 + 8 == 2048) {
            float* dst = samp ? (p->out + O_CONVS + (size_t)((r0 - MP) >> 3) * 3 * XBC_LD) : (p->out + O_CONVP + (size_t)(r0 >> 11) * 3 * XBC_LD);
#pragma unroll
            for (int i = 0; i < 3; ++i) { *(f32x4*)(dst + (size_t)i * XBC_LD + c0) = (f32x4){win[8 + i][0], win[8 + i][1], win[8 + i][2], win[8 + i][3]};
                *(f32x4*)(dst + (size_t)i * XBC_LD + c0 + 4) = (f32x4){win[8 + i][4], win[8 + i][5], win[8 + i][6], win[8 + i][7]}; }
        }
    }
}

#define MFMA16(a, b, c) __builtin_amdgcn_mfma_f32_16x16x32_bf16(a, b, c, 0, 0, 0)
#define LBAR() do { asm volatile("s_waitcnt lgkmcnt(0)" ::: "memory"); __builtin_amdgcn_s_barrier(); asm volatile("" ::: "memory"); } while (0)
#define LDSF(off) (*(LAS float*)(lds + (off)))
#define LDSH(off) (*(LAS unsigned short*)(lds + (off)))
#define LDSV8(off) (*(const LAS bf16x8*)(lds + (off)))

constexpr int SP_CM = 0, SP_BM = 17408, SP_BMT = 34816, SP_XT = 53248, SP_WM = 62464, SP_HB = 71680, SP_DT = 89088, SP_CUM = 89344;
__device__ __forceinline__ void ssd_prompt_unit(KPtr p, ldsp lds, int b, int h) {
    const int tid = fresh_tid(), lane = tid & 63, wid = __builtin_amdgcn_readfirstlane(tid >> 6), l15 = lane & 15, quad = lane >> 4;
    const int g = h >> 3, tq = wid >> 1, half = wid & 1;
    const bf16_t* XBC = (const bf16_t*)(p->ws + WS_XBC); const bf16_t* PROJ = (const bf16_t*)(p->ws + WS_BIG); const float* GATES = (const float*)(p->ws + WS_GATES);
    bf16_t* YPRE = (bf16_t*)(p->ws + WS_YPRE);
    const float dtb = p->in[14][h], aneg = -__expf(p->in[15][h]), dsk = p->in[16][h];
    const size_t rowbase = (size_t)b * 2048;
    for (int i = tid; i < 17408 / 4; i += 512) *(LAS unsigned*)(lds + SP_HB + i * 4) = 0u;
    f32x4 Hst[4];
#pragma unroll
    for (int i = 0; i < 4; ++i) Hst[i] = (f32x4){0.f, 0.f, 0.f, 0.f};
    u32x4 pa[3], pb[3]; float dtraw = 0.f;
    int spr[3], sgrp[3];
#pragma unroll
    for (int i = 0; i < 3; ++i) { int v = (i < 2) ? tid + 512 * i : (tid >= 256 ? tid + 768 : 1279); spr[i] = v & 31; sgrp[i] = v >> 5; }
#define SSD_COL(gi) ((gi) < 8 ? h * 64 + (gi) * 8 : ((gi) < 24 ? 1024 + g * 128 + ((gi) - 8) * 8 : 1280 + g * 128 + ((gi) - 24) * 8))
#pragma unroll
    for (int i = 0; i < 3; ++i) { const bf16_t* src_ = XBC + (rowbase + 2 * spr[i]) * XBC_LD + SSD_COL(sgrp[i]); pa[i] = *(const u32x4*)src_; pb[i] = *(const u32x4*)(src_ + XBC_LD); }
    if (wid == 0) dtraw = GATES[(rowbase + lane) * 32 + h];
    for (int ch = 0; ch < 32; ++ch) {
        const size_t crow = rowbase + (size_t)ch * 64;
        if (wid == 0) { const float dt = softplusf(dtraw + dtb); float cum = dt * aneg;
#pragma unroll
            for (int o = 1; o < 64; o <<= 1) { const float t2 = __shfl_up(cum, o); if (lane >= o) cum += t2; }
            LDSF(SP_DT + lane * 4) = dt; LDSF(SP_CUM + lane * 4) = cum; }
        LBAR();
        const float cum63 = LDSF(SP_CUM + 63 * 4);
#pragma unroll
        for (int i = 0; i < 3; ++i) { if (i < 2 || tid >= 256) { const int gi = sgrp[i], sp = spr[i]; const unsigned wa[4] = {pa[i].x, pa[i].y, pa[i].z, pa[i].w}, wb[4] = {pb[i].x, pb[i].y, pb[i].z, pb[i].w};
            if (gi < 8) { const int p0 = gi * 8;
#pragma unroll
                for (int e = 0; e < 4; ++e) { *(LAS unsigned*)(lds + SP_XT + (p0 + 2 * e) * 144 + sp * 4) = (wa[e] & 0xffffu) | (wb[e] << 16); *(LAS unsigned*)(lds + SP_XT + (p0 + 2 * e + 1) * 144 + sp * 4) = (wa[e] >> 16) | (wb[e] & 0xffff0000u); } }
            else if (gi < 24) { const int n0 = (gi - 8) * 8; *(LAS u32x4*)(lds + SP_BM + (2 * sp) * 272 + n0 * 2) = pa[i]; *(LAS u32x4*)(lds + SP_BM + (2 * sp + 1) * 272 + n0 * 2) = pb[i];
                const f32x2 cs = *(const LAS f32x2*)(lds + SP_CUM + sp * 8), ds = *(const LAS f32x2*)(lds + SP_DT + sp * 8);
                const float wea = __expf(cum63 - cs.x) * ds.x, web = __expf(cum63 - cs.y) * ds.y;
#pragma unroll
                for (int e = 0; e < 4; ++e) { *(LAS unsigned*)(lds + SP_BMT + (n0 + 2 * e) * 144 + sp * 4) = cvt_pk_bf16(bflo(wa[e]) * wea, bflo(wb[e]) * web); *(LAS unsigned*)(lds + SP_BMT + (n0 + 2 * e + 1) * 144 + sp * 4) = cvt_pk_bf16(bfhi(wa[e]) * wea, bfhi(wb[e]) * web); } }
            else { *(LAS u32x4*)(lds + SP_CM + (2 * sp) * 272 + (gi - 24) * 16) = pa[i]; *(LAS u32x4*)(lds + SP_CM + (2 * sp + 1) * 272 + (gi - 24) * 16) = pb[i]; } } }
        if (ch + 1 < 32) {
#pragma unroll
            for (int i = 0; i < 3; ++i) { const bf16_t* src_ = XBC + (crow + 64 + 2 * spr[i]) * XBC_LD + SSD_COL(sgrp[i]); pa[i] = *(const u32x4*)src_; pb[i] = *(const u32x4*)(src_ + XBC_LD); }
            if (wid == 0) dtraw = GATES[(crow + 64 + lane) * 32 + h];
        }
        const int t = tq * 16 + l15;
        u32x2 zr[2];
#pragma unroll
        for (int pt2 = 0; pt2 < 2; ++pt2) zr[pt2] = *(const u32x2*)(PROJ + (crow + t) * PROJ_LD + h * 64 + (2 * half + pt2) * 16 + quad * 4);
        LBAR();
        const float cum_t = LDSF(SP_CUM + t * 4);
        {
            f32x4 cbv[2] = {(f32x4){0.f, 0.f, 0.f, 0.f}, (f32x4){0.f, 0.f, 0.f, 0.f}};
#pragma unroll
            for (int ks = 0; ks < 4; ++ks) { const bf16x8 bfr = LDSV8(SP_CM + t * 272 + ks * 64 + quad * 16);
#pragma unroll
                for (int s2 = 0; s2 < 2; ++s2) { const bf16x8 afr = LDSV8(SP_BM + ((2 * half + s2) * 16 + l15) * 272 + ks * 64 + quad * 16); cbv[s2] = MFMA16(afr, bfr, cbv[s2]); } }
#pragma unroll
            for (int s2 = 0; s2 < 2; ++s2) { const int s0 = (2 * half + s2) * 16 + quad * 4; const f32x4 cs = *(const LAS f32x4*)(lds + SP_CUM + s0 * 4), ds = *(const LAS f32x4*)(lds + SP_DT + s0 * 4);
                float wv[4];
#pragma unroll
                for (int j = 0; j < 4; ++j) wv[j] = (s0 + j <= t) ? cbv[s2][j] * __expf(cum_t - cs[j]) * ds[j] : 0.f;
                u32x2 o; o.x = cvt_pk_bf16(wv[0], wv[1]); o.y = cvt_pk_bf16(wv[2], wv[3]); *(LAS u32x2*)(lds + SP_WM + t * 144 + s0 * 2) = o; }
        }
        LBAR();
        {
            f32x4 ya[2] = {(f32x4){0.f, 0.f, 0.f, 0.f}, (f32x4){0.f, 0.f, 0.f, 0.f}};
#pragma unroll
            for (int ks = 0; ks < 4; ++ks) { const bf16x8 bfr = LDSV8(SP_CM + t * 272 + ks * 64 + quad * 16);
#pragma unroll
                for (int p2 = 0; p2 < 2; ++p2) { const bf16x8 afr = LDSV8(SP_HB + ((2 * half + p2) * 16 + l15) * 272 + ks * 64 + quad * 16); ya[p2] = MFMA16(afr, bfr, ya[p2]); } }
            const float ec = __expf(cum_t); ya[0] = ya[0] * ec; ya[1] = ya[1] * ec;
#pragma unroll
            for (int ks = 0; ks < 2; ++ks) { const bf16x8 bfr = LDSV8(SP_WM + t * 144 + ks * 64 + quad * 16);
#pragma unroll
                for (int p2 = 0; p2 < 2; ++p2) { const bf16x8 afr = LDSV8(SP_XT + ((2 * half + p2) * 16 + l15) * 144 + ks * 64 + quad * 16); ya[p2] = MFMA16(afr, bfr, ya[p2]); } }
#pragma unroll
            for (int p2 = 0; p2 < 2; ++p2) { const int p0 = (2 * half + p2) * 16 + quad * 4; float yv[4]; const float zz[4] = {bflo(zr[p2].x), bfhi(zr[p2].x), bflo(zr[p2].y), bfhi(zr[p2].y)};
#pragma unroll
                for (int j = 0; j < 4; ++j) { const float xv = bf2f(LDSH(SP_XT + (p0 + j) * 144 + t * 2)); yv[j] = (ya[p2][j] + dsk * xv) * siluf(zz[j]); }
                u32x2 o; o.x = cvt_pk_bf16(yv[0], yv[1]); o.y = cvt_pk_bf16(yv[2], yv[3]); *(u32x2*)(YPRE + (crow + t) * YP_LD + h * 64 + p0) = o; }
        }
        {
            const float eend = __expf(cum63);
#pragma unroll
            for (int i = 0; i < 4; ++i) Hst[i] = Hst[i] * eend;
#pragma unroll
            for (int ks = 0; ks < 2; ++ks) { const bf16x8 afr = LDSV8(SP_BMT + (wid * 16 + l15) * 144 + ks * 64 + quad * 16);
#pragma unroll
                for (int pt = 0; pt < 4; ++pt) { const bf16x8 bfr = LDSV8(SP_XT + (pt * 16 + l15) * 144 + ks * 64 + quad * 16); Hst[pt] = MFMA16(afr, bfr, Hst[pt]); } }
        }
        LBAR();
#pragma unroll
        for (int pt = 0; pt < 4; ++pt) { u32x2 o; o.x = cvt_pk_bf16(Hst[pt][0], Hst[pt][1]); o.y = cvt_pk_bf16(Hst[pt][2], Hst[pt][3]);
            *(LAS u32x2*)(lds + SP_HB + (pt * 16 + l15) * 272 + (wid * 16 + quad * 4) * 2) = o; }
    }
    float* so = p->out + O_SSMP + (size_t)(b * 16 + h) * 64 * 128;
#pragma unroll
    for (int pt = 0; pt < 4; ++pt) *(f32x4*)(so + (size_t)(pt * 16 + l15) * 128 + wid * 16 + quad * 4) = Hst[pt];
    __syncthreads();
}

constexpr int ML_QM = 0, ML_KM = 17408, ML_KMT = 34816, ML_VT = 53248, ML_SM = 64768, ML_CBT = 73984, ML_AV = 95744, ML_MV = 96000, ML_EM = 96256, ML_SI = 96512, ML_SC = 96768;
__device__ __forceinline__ void mlstm_prompt_unit(KPtr p, ldsp lds, int b, int head, int vq) {
    const int tid = fresh_tid(), lane = tid & 63, wid = __builtin_amdgcn_readfirstlane(tid >> 6), l15 = lane & 15, quad = lane >> 4;
    const int tq = wid >> 1, half = wid & 1;
    const bf16_t* PROJ = (const bf16_t*)(p->ws + WS_BIG); const float* GATES = (const float*)(p->ws + WS_GATES); bf16_t* YPRE = (bf16_t*)(p->ws + WS_YPRE);
    const float bi = p->in[18][head], bfg = p->in[19][head];
    const float qscale = 0.08838834764831845f;
    const size_t rowbase = (size_t)b * 2048;
    for (int i = tid; i < 21760 / 4; i += 512) *(LAS unsigned*)(lds + ML_CBT + i * 4) = 0u;
    for (int i = tid; i < 16 * 144 / 4; i += 512) { const int off = i * 4; *(LAS unsigned*)(lds + ML_VT + 64 * 144 + off) = (off < 128) ? 0x3F803F80u : 0u; }
    f32x4 Cst[5];
#pragma unroll
    for (int i = 0; i < 5; ++i) Cst[i] = (f32x4){0.f, 0.f, 0.f, 0.f};
    float mprev = 0.f, igr = 0.f, fgr = 0.f;
    u32x4 pa[3], pb[3]; int spr[3], sgrp[3];
#pragma unroll
    for (int i = 0; i < 3; ++i) { int v = (i < 2) ? tid + 512 * i : (tid >= 256 ? tid + 768 : 1279); spr[i] = v & 31; sgrp[i] = v >> 5; }
#define ML_COL(gi) ((gi) < 16 ? 2560 + head * 128 + (gi) * 8 : ((gi) < 32 ? 3072 + head * 128 + ((gi) - 16) * 8 : 3584 + head * 256 + vq * 64 + ((gi) - 32) * 8))
#pragma unroll
    for (int i = 0; i < 3; ++i) { const bf16_t* src_ = PROJ + (rowbase + 2 * spr[i]) * PROJ_LD + ML_COL(sgrp[i]); pa[i] = *(const u32x4*)src_; pb[i] = *(const u32x4*)(src_ + PROJ_LD); }
    if (wid == 0) { igr = GATES[(rowbase + lane) * 32 + 16 + head]; fgr = GATES[(rowbase + lane) * 32 + 20 + head]; }
    for (int ch = 0; ch < 32; ++ch) {
        const size_t crow = rowbase + (size_t)ch * 64;
        if (wid == 0) {
            const float iv = igr + bi, x = fgr + bfg; const float logf = fminf(x, 0.f) - __logf(1.f + __expf(-fabsf(x)));
            float bc = logf;
#pragma unroll
            for (int o = 1; o < 64; o <<= 1) { const float t2 = __shfl_up(bc, o); if (lane >= o) bc += t2; }
            const float a = iv - bc; float pm = a;
#pragma unroll
            for (int o = 1; o < 64; o <<= 1) { const float t2 = __shfl_up(pm, o); if (lane >= o) pm = fmaxf(pm, t2); }
            const float M = fmaxf(pm, mprev);
            LDSF(ML_AV + lane * 4) = a; LDSF(ML_MV + lane * 4) = M; LDSF(ML_EM + lane * 4) = __expf(-(bc + M)); LDSF(ML_SI + lane * 4) = __expf(mprev - M) * qscale;
            const float M63 = __shfl(M, 63), bc63 = __shfl(bc, 63);
            if (lane == 0) { LDSF(ML_SC) = M63; LDSF(ML_SC + 4) = __expf(mprev - M63); }
            mprev = bc63 + M63;
        }
        LBAR();
        const float M63 = LDSF(ML_SC), scaleC = LDSF(ML_SC + 4);
#pragma unroll
        for (int i = 0; i < 3; ++i) { if (i < 2 || tid >= 256) { const int gi = sgrp[i], sp = spr[i]; const unsigned wa[4] = {pa[i].x, pa[i].y, pa[i].z, pa[i].w}, wb[4] = {pb[i].x, pb[i].y, pb[i].z, pb[i].w};
            if (gi < 16) { *(LAS u32x4*)(lds + ML_QM + (2 * sp) * 272 + gi * 16) = pa[i]; *(LAS u32x4*)(lds + ML_QM + (2 * sp + 1) * 272 + gi * 16) = pb[i]; }
            else if (gi < 32) { const int d0 = (gi - 16) * 8; *(LAS u32x4*)(lds + ML_KM + (2 * sp) * 272 + d0 * 2) = pa[i]; *(LAS u32x4*)(lds + ML_KM + (2 * sp + 1) * 272 + d0 * 2) = pb[i];
                const f32x2 av = *(const LAS f32x2*)(lds + ML_AV + sp * 8); const float wea = __expf(av.x - M63), web = __expf(av.y - M63);
#pragma unroll
                for (int e = 0; e < 4; ++e) { *(LAS unsigned*)(lds + ML_KMT + (d0 + 2 * e) * 144 + sp * 4) = cvt_pk_bf16(bflo(wa[e]) * wea, bflo(wb[e]) * web); *(LAS unsigned*)(lds + ML_KMT + (d0 + 2 * e + 1) * 144 + sp * 4) = cvt_pk_bf16(bfhi(wa[e]) * wea, bfhi(wb[e]) * web); } }
            else { const int v0 = (gi - 32) * 8;
#pragma unroll
                for (int e = 0; e < 4; ++e) { *(LAS unsigned*)(lds + ML_VT + (v0 + 2 * e) * 144 + sp * 4) = (wa[e] & 0xffffu) | (wb[e] << 16); *(LAS unsigned*)(lds + ML_VT + (v0 + 2 * e + 1) * 144 + sp * 4) = (wa[e] >> 16) | (wb[e] & 0xffff0000u); } } } }
        if (ch + 1 < 32) {
#pragma unroll
            for (int i = 0; i < 3; ++i) { const bf16_t* src_ = PROJ + (crow + 64 + 2 * spr[i]) * PROJ_LD + ML_COL(sgrp[i]); pa[i] = *(const u32x4*)src_; pb[i] = *(const u32x4*)(src_ + PROJ_LD); }
            if (wid == 0) { igr = GATES[(crow + 64 + lane) * 32 + 16 + head]; fgr = GATES[(crow + 64 + lane) * 32 + 20 + head]; }
        }
        LBAR();
        const int t = tq * 16 + l15;
        const float M_t = LDSF(ML_MV + t * 4);
        {
            f32x4 sv[2] = {(f32x4){0.f, 0.f, 0.f, 0.f}, (f32x4){0.f, 0.f, 0.f, 0.f}};
#pragma unroll
            for (int ks = 0; ks < 4; ++ks) { const bf16x8 bfr = LDSV8(ML_QM + t * 272 + ks * 64 + quad * 16);
#pragma unroll
                for (int s2 = 0; s2 < 2; ++s2) { const bf16x8 afr = LDSV8(ML_KM + ((2 * half + s2) * 16 + l15) * 272 + ks * 64 + quad * 16); sv[s2] = MFMA16(afr, bfr, sv[s2]); } }
#pragma unroll
            for (int s2 = 0; s2 < 2; ++s2) { const int s0 = (2 * half + s2) * 16 + quad * 4; const f32x4 as = *(const LAS f32x4*)(lds + ML_AV + s0 * 4); float wv[4];
#pragma unroll
                for (int j = 0; j < 4; ++j) wv[j] = (s0 + j <= t) ? sv[s2][j] * qscale * __expf(as[j] - M_t) : 0.f;
                u32x2 o; o.x = cvt_pk_bf16(wv[0], wv[1]); o.y = cvt_pk_bf16(wv[2], wv[3]); *(LAS u32x2*)(lds + ML_SM + t * 144 + s0 * 2) = o; }
        }
        LBAR();
        {
            f32x4 na[3] = {(f32x4){0.f, 0.f, 0.f, 0.f}, (f32x4){0.f, 0.f, 0.f, 0.f}, (f32x4){0.f, 0.f, 0.f, 0.f}};
#pragma unroll
            for (int ks = 0; ks < 4; ++ks) { const bf16x8 bfr = LDSV8(ML_QM + t * 272 + ks * 64 + quad * 16);
#pragma unroll
                for (int v2 = 0; v2 < 3; ++v2) { const int vt = v2 < 2 ? 2 * half + v2 : 4; const bf16x8 afr = LDSV8(ML_CBT + (vt * 16 + l15) * 272 + ks * 64 + quad * 16); na[v2] = MFMA16(afr, bfr, na[v2]); } }
            const float si = LDSF(ML_SI + t * 4);
#pragma unroll
            for (int v2 = 0; v2 < 3; ++v2) na[v2] = na[v2] * si;
#pragma unroll
            for (int ks = 0; ks < 2; ++ks) { const bf16x8 bfr = LDSV8(ML_SM + t * 144 + ks * 64 + quad * 16);
#pragma unroll
                for (int v2 = 0; v2 < 3; ++v2) { const int vt = v2 < 2 ? 2 * half + v2 : 4; const bf16x8 afr = LDSV8(ML_VT + (vt * 16 + l15) * 144 + ks * 64 + quad * 16); na[v2] = MFMA16(afr, bfr, na[v2]); } }
            const float den = __shfl(na[2][0], l15);
            const float dn = __builtin_amdgcn_rcpf(fmaxf(fabsf(den), LDSF(ML_EM + t * 4)));
#pragma unroll
            for (int v2 = 0; v2 < 2; ++v2) { const int v0 = (2 * half + v2) * 16 + quad * 4; u32x2 o; o.x = cvt_pk_bf16(na[v2][0] * dn, na[v2][1] * dn); o.y = cvt_pk_bf16(na[v2][2] * dn, na[v2][3] * dn);
                *(u32x2*)(YPRE + (crow + t) * YP_LD + 1024 + head * 256 + vq * 64 + v0) = o; }
        }
        {
#pragma unroll
            for (int i = 0; i < 5; ++i) Cst[i] = Cst[i] * scaleC;
#pragma unroll
            for (int ks = 0; ks < 2; ++ks) { const bf16x8 afr = LDSV8(ML_KMT + (wid * 16 + l15) * 144 + ks * 64 + quad * 16);
#pragma unroll
                for (int vt = 0; vt < 5; ++vt) { const bf16x8 bfr = LDSV8(ML_VT + (vt * 16 + l15) * 144 + ks * 64 + quad * 16); Cst[vt] = MFMA16(afr, bfr, Cst[vt]); } }
        }
        LBAR();
#pragma unroll
        for (int vt = 0; vt < 5; ++vt) { u32x2 o; o.x = cvt_pk_bf16(Cst[vt][0], Cst[vt][1]); o.y = cvt_pk_bf16(Cst[vt][2], Cst[vt][3]);
            *(LAS u32x2*)(lds + ML_CBT + (vt * 16 + l15) * 272 + (wid * 16 + quad * 4) * 2) = o; }
    }
    float* co = p->out + O_MCP + (size_t)(b * 4 + head) * 128 * 256;
#pragma unroll
    for (int vt = 0; vt < 4; ++vt)
#pragma unroll
        for (int j = 0; j < 4; ++j) co[(size_t)(wid * 16 + quad * 4 + j) * 256 + vq * 64 + vt * 16 + l15] = Cst[vt][j];
    if (vq == 0) {
        if (l15 == 0) *(f32x4*)(p->out + O_MNP + (size_t)(b * 4 + head) * 128 + wid * 16 + quad * 4) = Cst[4];
        if (tid == 0) p->out[O_MMP + b * 4 + head] = mprev;
    }
    __syncthreads();
}

constexpr int SS_X = 0, SS_B = 2048, SS_C = 6144, SS_DT = 10240, SS_CUM = 10272, SS_W = 10304;
__device__ __forceinline__ void ssd_sample_unit(KPtr p, ldsp lds, int b, int h) {
    const int tid = fresh_tid(); const int g = h >> 3;
    const bf16_t* XBC = (const bf16_t*)(p->ws + WS_XBC); const bf16_t* PROJ = (const bf16_t*)(p->ws + WS_BIG); const float* GATES = (const float*)(p->ws + WS_GATES); bf16_t* YPRE = (bf16_t*)(p->ws + WS_YPRE);
    const float dtb = p->in[14][h], aneg = -__expf(p->in[15][h]), dsk = p->in[16][h];
    const size_t r0 = (size_t)MP + (size_t)b * 8;
    const int pp = tid >> 3, ns = tid & 7;
    const float* hp = p->in[3] + ((size_t)(b * 16 + h) * 64 + pp) * 128 + ns * 16;
    f32x4 h0[4];
#pragma unroll
    for (int i = 0; i < 4; ++i) h0[i] = *(const f32x4*)(hp + 4 * i);
    if (tid < 320) {
        const int kind = tid < 64 ? 0 : (tid < 192 ? 1 : 2), i = kind == 0 ? tid : (kind == 1 ? tid - 64 : tid - 192);
        const int t = kind == 0 ? (i >> 3) : (i >> 4), c8 = kind == 0 ? (i & 7) * 8 : (i & 15) * 8;
        const int col = kind == 0 ? h * 64 + c8 : (kind == 1 ? 1024 : 1280) + g * 128 + c8;
        const int off = kind == 0 ? SS_X + (t * 64 + c8) * 4 : (kind == 1 ? SS_B : SS_C) + (t * 128 + c8) * 4;
        const u32x4 w = *(const u32x4*)(XBC + (r0 + t) * XBC_LD + col);
        *(LAS f32x4*)(lds + off) = (f32x4){bflo(w.x), bfhi(w.x), bflo(w.y), bfhi(w.y)}; *(LAS f32x4*)(lds + off + 16) = (f32x4){bflo(w.z), bfhi(w.z), bflo(w.w), bfhi(w.w)}; }
    if (tid < 8) LDSF(SS_DT + tid * 4) = softplusf(GATES[(r0 + tid) * 32 + h] + dtb);
    const float zv = bf2f(PROJ[(r0 + ns) * PROJ_LD + h * 64 + pp]);
    __syncthreads();
    if (tid < 8) { float c = 0.f; for (int u = 0; u <= tid; ++u) c += LDSF(SS_DT + u * 4) * aneg; LDSF(SS_CUM + tid * 4) = c; }
    __syncthreads();
    if (tid < 64) { const int t = tid >> 3, s = tid & 7; float cbv = 0.f;
        for (int n = 0; n < 128; n += 4) { const f32x4 cv = *(const LAS f32x4*)(lds + SS_C + (t * 128 + n) * 4), bv = *(const LAS f32x4*)(lds + SS_B + (s * 128 + n) * 4); cbv += (cv.x * bv.x + cv.y * bv.y) + (cv.z * bv.z + cv.w * bv.w); }
        LDSF(SS_W + tid * 4) = (s <= t) ? cbv * __expf(LDSF(SS_CUM + t * 4) - LDSF(SS_CUM + s * 4)) * LDSF(SS_DT + s * 4) : 0.f; }
    float part[8];
#pragma unroll
    for (int t = 0; t < 8; ++t) { float a = 0.f;
#pragma unroll
        for (int i = 0; i < 4; ++i) { const f32x4 cv = *(const LAS f32x4*)(lds + SS_C + (t * 128 + ns * 16 + i * 4) * 4); a += cv.x * h0[i].x + cv.y * h0[i].y + cv.z * h0[i].z + cv.w * h0[i].w; }
        a += __shfl_xor(a, 1); a += __shfl_xor(a, 2); a += __shfl_xor(a, 4); part[t] = a; }
    __syncthreads();
    {
        float yi = part[0];
#pragma unroll
        for (int t = 1; t < 8; ++t) yi = (ns == t) ? part[t] : yi;
        const int t = ns; float y = yi * __expf(LDSF(SS_CUM + t * 4));
#pragma unroll
        for (int s = 0; s < 8; ++s) y += LDSF(SS_W + (t * 8 + s) * 4) * LDSF(SS_X + (s * 64 + pp) * 4);
        y += dsk * LDSF(SS_X + (t * 64 + pp) * 4);
        YPRE[(r0 + t) * YP_LD + h * 64 + pp] = f2bf(y * siluf(zv));
    }
    const float cum7 = LDSF(SS_CUM + 7 * 4), e7 = __expf(cum7);
    f32x4 hn[4];
#pragma unroll
    for (int i = 0; i < 4; ++i) hn[i] = h0[i] * e7;
#pragma unroll
    for (int s = 0; s < 8; ++s) { const float wx = __expf(cum7 - LDSF(SS_CUM + s * 4)) * LDSF(SS_DT + s * 4) * LDSF(SS_X + (s * 64 + pp) * 4);
#pragma unroll
        for (int i = 0; i < 4; ++i) { const f32x4 bv = *(const LAS f32x4*)(lds + SS_B + (s * 128 + ns * 16 + i * 4) * 4); hn[i] = hn[i] + bv * wx; } }
    float* ho = p->out + O_SSMS + ((size_t)(b * 16 + h) * 64 + pp) * 128 + ns * 16;
#pragma unroll
    for (int i = 0; i < 4; ++i) *(f32x4*)(ho + 4 * i) = hn[i];
    __syncthreads();
}

constexpr int MS_Q = 0, MS_K = 4096, MS_V = 8192, MS_I = 12288, MS_LF = 12320, MS_A = 12352, MS_M = 12384, MS_EM = 12416, MS_SI = 12448, MS_WE = 12480, MS_DEN = 12512, MS_SC = 12544, MS_S = 12608, MS_N0 = 12864, MS_RED = 16384;
__device__ __forceinline__ void mlstm_sample_unit(KPtr p, ldsp lds, int b, int head, int vh) {
    const int tid = fresh_tid(), lane = tid & 63, wid = __builtin_amdgcn_readfirstlane(tid >> 6);
    const bf16_t* PROJ = (const bf16_t*)(p->ws + WS_BIG); const float* GATES = (const float*)(p->ws + WS_GATES); bf16_t* YPRE = (bf16_t*)(p->ws + WS_YPRE);
    const float bi = p->in[18][head], bfg = p->in[19][head]; const float qscale = 0.08838834764831845f;
    const size_t r0 = (size_t)MP + (size_t)b * 8;
    const float mprev = p->in[7][b * 4 + head];
    const int dsg = tid >> 5, vq4 = tid & 31;
    const float* cp = p->in[5] + ((size_t)(b * 4 + head) * 128 + dsg * 8) * 256 + vh * 128 + vq4 * 4;
    f32x4 Cr[8];
#pragma unroll
    for (int i = 0; i < 8; ++i) Cr[i] = *(const f32x4*)(cp + (size_t)i * 256);
    if (tid < 384) {
        const int kind = tid >> 7, i = tid & 127, t = i >> 4, c8 = (i & 15) * 8;
        const int col = kind == 0 ? 2560 + head * 128 + c8 : (kind == 1 ? 3072 + head * 128 + c8 : 3584 + head * 256 + vh * 128 + c8);
        const int off = (kind == 0 ? MS_Q : (kind == 1 ? MS_K : MS_V)) + (t * 128 + c8) * 4; const float sc = kind == 0 ? qscale : 1.f;
        const u32x4 w = *(const u32x4*)(PROJ + (r0 + t) * PROJ_LD + col);
        *(LAS f32x4*)(lds + off) = (f32x4){bflo(w.x), bfhi(w.x), bflo(w.y), bfhi(w.y)} * sc; *(LAS f32x4*)(lds + off + 16) = (f32x4){bflo(w.z), bfhi(w.z), bflo(w.w), bfhi(w.w)} * sc; }
    if (tid < 128) LDSF(MS_N0 + tid * 4) = p->in[6][(size_t)(b * 4 + head) * 128 + tid];
    if (tid < 8) { const float x = GATES[(r0 + tid) * 32 + 20 + head] + bfg; LDSF(MS_I + tid * 4) = GATES[(r0 + tid) * 32 + 16 + head] + bi;
        LDSF(MS_LF + tid * 4) = fminf(x, 0.f) - __logf(1.f + __expf(-fabsf(x))); }
    __syncthreads();
    if (tid < 8) { float bc = 0.f, am = -3.0e38f, a = 0.f;
        for (int s = 0; s <= tid; ++s) { bc += LDSF(MS_LF + s * 4); a = LDSF(MS_I + s * 4) - bc; am = fmaxf(am, a); }
        const float M = fmaxf(am, mprev);
        LDSF(MS_A + tid * 4) = a; LDSF(MS_M + tid * 4) = M; LDSF(MS_EM + tid * 4) = __expf(-(bc + M)); LDSF(MS_SI + tid * 4) = __expf(mprev - M);
        if (tid == 7) { LDSF(MS_SC) = __expf(mprev - M); LDSF(MS_SC + 4) = bc + M; } }
    __syncthreads();
    if (tid < 8) LDSF(MS_WE + tid * 4) = __expf(LDSF(MS_A + tid * 4) - LDSF(MS_M + 7 * 4));
    if (tid < 64) { const int t = tid >> 3, s = tid & 7; float a = 0.f;
        for (int d = 0; d < 128; d += 4) { const f32x4 qv = *(const LAS f32x4*)(lds + MS_Q + (t * 128 + d) * 4), kv = *(const LAS f32x4*)(lds + MS_K + (s * 128 + d) * 4); a += (qv.x * kv.x + qv.y * kv.y) + (qv.z * kv.z + qv.w * kv.w); }
        LDSF(MS_S + tid * 4) = (s <= t) ? a * __expf(LDSF(MS_A + s * 4) - LDSF(MS_M + t * 4)) : 0.f; }
    {
#pragma unroll
        for (int t = 0; t < 8; ++t) { f32x4 a = (f32x4){0.f, 0.f, 0.f, 0.f};
#pragma unroll
            for (int dd = 0; dd < 8; ++dd) { const float qv = LDSF(MS_Q + (t * 128 + dsg * 8 + dd) * 4); a = a + Cr[dd] * qv; }
            a.x += __shfl_xor(a.x, 32); a.y += __shfl_xor(a.y, 32); a.z += __shfl_xor(a.z, 32); a.w += __shfl_xor(a.w, 32);
            if (lane < 32) *(LAS f32x4*)(lds + MS_RED + ((wid * 8 + t) * 128 + vq4 * 4) * 4) = a; }
    }
    __syncthreads();
    if (tid < 8) { float d = 0.f, qn = 0.f; for (int s = 0; s < 8; ++s) d += LDSF(MS_S + (tid * 8 + s) * 4);
        for (int dd = 0; dd < 128; dd += 4) { const f32x4 qv = *(const LAS f32x4*)(lds + MS_Q + (tid * 128 + dd) * 4), nv = *(const LAS f32x4*)(lds + MS_N0 + dd * 4); qn += (qv.x * nv.x + qv.y * nv.y) + (qv.z * nv.z + qv.w * nv.w); }
        LDSF(MS_DEN + tid * 4) = d + LDSF(MS_SI + tid * 4) * qn; }
    __syncthreads();
    { const int t = tid >> 6, v2 = (tid & 63) * 2; const float si = LDSF(MS_SI + t * 4); const float dn = 1.f / fmaxf(fabsf(LDSF(MS_DEN + t * 4)), LDSF(MS_EM + t * 4)); float r[2];
#pragma unroll
        for (int e = 0; e < 2; ++e) { const int v = v2 + e; float ni = 0.f;
#pragma unroll
            for (int w = 0; w < 8; ++w) ni += LDSF(MS_RED + ((w * 8 + t) * 128 + v) * 4);
            float num = ni * si;
#pragma unroll
            for (int s = 0; s < 8; ++s) num += LDSF(MS_S + (t * 8 + s) * 4) * LDSF(MS_V + (s * 128 + v) * 4);
            r[e] = num * dn; }
        *(unsigned*)(YPRE + (r0 + t) * YP_LD + 1024 + head * 256 + vh * 128 + v2) = cvt_pk_bf16(r[0], r[1]); }
    const float scaleC = LDSF(MS_SC);
#pragma unroll
    for (int i = 0; i < 8; ++i) Cr[i] = Cr[i] * scaleC;
#pragma unroll
    for (int s = 0; s < 8; ++s) { const float we = LDSF(MS_WE + s * 4); const f32x4 vv = *(const LAS f32x4*)(lds + MS_V + (s * 128 + vq4 * 4) * 4) * we;
#pragma unroll
        for (int i = 0; i < 8; ++i) Cr[i] = Cr[i] + vv * LDSF(MS_K + (s * 128 + dsg * 8 + i) * 4); }
    float* co = p->out + O_MCS + ((size_t)(b * 4 + head) * 128 + dsg * 8) * 256 + vh * 128 + vq4 * 4;
#pragma unroll
    for (int i = 0; i < 8; ++i) *(f32x4*)(co + (size_t)i * 256) = Cr[i];
    if (vh == 0) {
        if (tid < 128) { float n = scaleC * LDSF(MS_N0 + tid * 4); for (int s = 0; s < 8; ++s) n += LDSF(MS_WE + s * 4) * LDSF(MS_K + (s * 128 + tid) * 4); p->out[O_MNS + (size_t)(b * 4 + head) * 128 + tid] = n; }
        if (tid == 0) p->out[O_MMS + b * 4 + head] = LDSF(MS_SC + 4);
    }
    __syncthreads();
}

__device__ __forceinline__ void norm_phase(KPtr p, int G) {
    const int tid_ = fresh_tid(); const int lane = tid_ & 63, wave = tid_ >> 6; const int gw = blockIdx.x * 8 + wave, NGW = G * 8;
    const bf16_t* YPRE = (const bf16_t*)(p->ws + WS_YPRE); const bf16_t* PROJ = (const bf16_t*)(p->ws + WS_BIG); bf16_t* A2 = (bf16_t*)(p->ws + WS_A2);
    const float* gs = p->in[17]; const float* gm = p->in[20];
    for (int r = gw; r < MT; r += NGW) {
        const bf16_t* yr = YPRE + (size_t)r * YP_LD; bf16_t* ar = A2 + (size_t)r * YP_LD;
#pragma unroll
        for (int i = 0; i < 4; ++i) {
            const int c0 = i * 512 + lane * 8; const u32x4 w = *(const u32x4*)(yr + c0);
            float v[8] = {bflo(w.x), bfhi(w.x), bflo(w.y), bfhi(w.y), bflo(w.z), bfhi(w.z), bflo(w.w), bfhi(w.w)};
            float s = 0.f;
#pragma unroll
            for (int e = 0; e < 8; ++e) s += v[e] * v[e];
            float rstd; float gg[8];
            if (i < 2) { rstd = rsqrtf(wave_sum(s) * (1.f / 512.f) + EPSN);
                const f32x4 a = *(const f32x4*)(gs + c0), bq = *(const f32x4*)(gs + c0 + 4); gg[0] = a.x; gg[1] = a.y; gg[2] = a.z; gg[3] = a.w; gg[4] = bq.x; gg[5] = bq.y; gg[6] = bq.z; gg[7] = bq.w; }
            else {
#pragma unroll
                for (int o = 1; o < 32; o <<= 1) s += __shfl_xor(s, o);
                rstd = rsqrtf(s * (1.f / 256.f) + EPSN);
                const int cm = c0 - 1024; const f32x4 a = *(const f32x4*)(gm + cm), bq = *(const f32x4*)(gm + cm + 4); const u32x4 og = *(const u32x4*)(PROJ + (size_t)r * PROJ_LD + 4608 + cm);
                const float ov[8] = {bflo(og.x), bfhi(og.x), bflo(og.y), bfhi(og.y), bflo(og.z), bfhi(og.z), bflo(og.w), bfhi(og.w)};
                gg[0] = a.x; gg[1] = a.y; gg[2] = a.z; gg[3] = a.w; gg[4] = bq.x; gg[5] = bq.y; gg[6] = bq.z; gg[7] = bq.w;
#pragma unroll
                for (int e = 0; e < 8; ++e) gg[e] *= sigmoidf_(ov[e]); }
            u32x4 o; o.x = cvt_pk_bf16(v[0] * rstd * gg[0], v[1] * rstd * gg[1]); o.y = cvt_pk_bf16(v[2] * rstd * gg[2], v[3] * rstd * gg[3]);
            o.z = cvt_pk_bf16(v[4] * rstd * gg[4], v[5] * rstd * gg[5]); o.w = cvt_pk_bf16(v[6] * rstd * gg[6], v[7] * rstd * gg[7]);
            *(u32x4*)(ar + c0) = o;
        }
    }
}

template <bool FIRST, bool LASTP, bool PART = false>
__device__ __forceinline__ void row_phase(KPtr p, int wg0, int nwg, int r_lo, int r_hi, const float* gpost, const float* gpre) {
    const int tid_ = fresh_tid(); const int lane = tid_ & 63, wave = tid_ >> 6; const int gw = ((int)blockIdx.x - wg0) * 8 + wave, NGW = nwg * 8;
    const bf16_t* R1 = (const bf16_t*)(p->ws + WS_R1); bf16_t* U = (bf16_t*)(p->ws + WS_U);
    if ((int)blockIdx.x < wg0) return;
    for (int r = r_lo + gw; r < r_hi; r += NGW) {
        const float* xs = FIRST ? (r < MP ? p->in[0] + (size_t)r * DM : p->in[1] + (size_t)(r - MP) * DM) : p->out + (size_t)r * DM;
        float* xo = p->out + (size_t)r * DM;
        const u32x2* rr = (const u32x2*)(R1 + (size_t)r * DM) + lane;
        f32x4 rv[4], xv[4]; float s = 0.f;
#pragma unroll
        for (int j = 0; j < 4; ++j) { if (PART) { const f32x4* pp = (const f32x4*)(p->ws + WS_A2) + (size_t)(r - MP) * 256 + lane + 64 * j; rv[j] = pp[0] + pp[(size_t)MS * 256]; }
            else { const u32x2 w = rr[64 * j]; rv[j] = (f32x4){bflo(w.x), bfhi(w.x), bflo(w.y), bfhi(w.y)}; } xv[j] = ((const f32x4*)xs)[lane + 64 * j];
            s += (rv[j].x * rv[j].x + rv[j].y * rv[j].y) + (rv[j].z * rv[j].z + rv[j].w * rv[j].w); }
        const float rstd = rsqrtf(wave_sum(s) * (1.f / DM) + EPSN);
        float s2 = 0.f;
#pragma unroll
        for (int j = 0; j < 4; ++j) { const f32x4 gg = ((const f32x4*)gpost)[lane + 64 * j]; xv[j] = xv[j] + rv[j] * rstd * gg; ((f32x4*)xo)[lane + 64 * j] = xv[j];
            s2 += (xv[j].x * xv[j].x + xv[j].y * xv[j].y) + (xv[j].z * xv[j].z + xv[j].w * xv[j].w); }
        if (!LASTP) { const float rstd2 = rsqrtf(wave_sum(s2) * (1.f / DM) + EPSN); u32x2* uo = (u32x2*)(U + (size_t)r * DM) + lane;
#pragma unroll
            for (int j = 0; j < 4; ++j) { const f32x4 gg = ((const f32x4*)gpre)[lane + 64 * j]; u32x2 w; w.x = cvt_pk_bf16(xv[j].x * rstd2 * gg.x, xv[j].y * rstd2 * gg.y); w.y = cvt_pk_bf16(xv[j].z * rstd2 * gg.z, xv[j].w * rstd2 * gg.w); uo[64 * j] = w; } }
    }
}

constexpr int AT_K = 0, AT_V = 33792;
__device__ __forceinline__ void attn_prompt_unit(KPtr p, ldsp lds, int unit) {
    const int tid = fresh_tid(), lane = tid & 63, wid = __builtin_amdgcn_readfirstlane(tid >> 6), l15 = lane & 15, quad = lane >> 4;
    const int qb = unit & 15, head = (unit >> 4) & 3, b = unit >> 6;
    const bf16_t* QX = (const bf16_t*)(p->ws + WS_QX); const bf16_t* KM = (const bf16_t*)(p->ws + WS_KM); const bf16_t* VMT = (const bf16_t*)(p->ws + WS_VMT); bf16_t* O = (bf16_t*)(p->ws + WS_O);
    const size_t qrow = (size_t)b * 2048 + qb * 128 + wid * 16 + l15;
    bf16x8 qf[8];
#pragma unroll
    for (int ks = 0; ks < 8; ++ks) qf[ks] = *(const bf16x8*)(QX + qrow * DM + head * 256 + ks * 32 + quad * 8);
    f32x4 oa[16];
#pragma unroll
    for (int i = 0; i < 16; ++i) oa[i] = (f32x4){0.f, 0.f, 0.f, 0.f};
    float mrun = -3.0e38f, lrun = 0.f;
    for (int kt = 0; kt < 4; ++kt) {
        __syncthreads();
#pragma unroll
        for (int i = 0; i < 4; ++i) { const int v = tid + 512 * i; const int kr = v >> 5, kc = v & 31;
            *(LAS u32x4*)(lds + AT_K + kr * 528 + kc * 16) = *(const u32x4*)(KM + ((size_t)b * 256 + kt * 64 + kr) * DM + head * 256 + kc * 8);
            const int vr = v >> 3, vc = v & 7;
            *(LAS u32x4*)(lds + AT_V + vr * 144 + vc * 16) = *(const u32x4*)(VMT + ((size_t)(b * 4 + head) * 256 + vr) * 256 + kt * 64 + vc * 8); }
        __syncthreads();
        f32x4 sT[4];
#pragma unroll
        for (int k16 = 0; k16 < 4; ++k16) { sT[k16] = (f32x4){0.f, 0.f, 0.f, 0.f};
#pragma unroll
            for (int ks = 0; ks < 8; ++ks) { const bf16x8 afr = LDSV8(AT_K + (k16 * 16 + l15) * 528 + ks * 64 + quad * 16); sT[k16] = MFMA16(afr, qf[ks], sT[k16]); } }
        float mx = mrun;
#pragma unroll
        for (int k16 = 0; k16 < 4; ++k16)
#pragma unroll
            for (int j = 0; j < 4; ++j) mx = fmaxf(mx, sT[k16][j]);
        mx = fmaxf(mx, __shfl_xor(mx, 16)); mx = fmaxf(mx, __shfl_xor(mx, 32));
        const float alpha = __expf(mrun - mx); mrun = mx; float ls = 0.f;
#pragma unroll
        for (int k16 = 0; k16 < 4; ++k16)
#pragma unroll
            for (int j = 0; j < 4; ++j) { const float e = __expf(sT[k16][j] - mx); sT[k16][j] = e; ls += e; }
        lrun = lrun * alpha + ls;
#pragma unroll
        for (int i = 0; i < 16; ++i) oa[i] = oa[i] * alpha;
#pragma unroll
        for (int k2 = 0; k2 < 2; ++k2) {
            u32x4 pw; pw.x = cvt_pk_bf16(sT[2 * k2][0], sT[2 * k2][1]); pw.y = cvt_pk_bf16(sT[2 * k2][2], sT[2 * k2][3]); pw.z = cvt_pk_bf16(sT[2 * k2 + 1][0], sT[2 * k2 + 1][1]); pw.w = cvt_pk_bf16(sT[2 * k2 + 1][2], sT[2 * k2 + 1][3]);
            const bf16x8 pf = __builtin_bit_cast(bf16x8, pw);
#pragma unroll
            for (int dt = 0; dt < 16; ++dt) { const u32x2 v0 = *(const LAS u32x2*)(lds + AT_V + (dt * 16 + l15) * 144 + (k2 * 32 + quad * 4) * 2), v1 = *(const LAS u32x2*)(lds + AT_V + (dt * 16 + l15) * 144 + (k2 * 32 + 16 + quad * 4) * 2);
                u32x4 vw; vw.x = v0.x; vw.y = v0.y; vw.z = v1.x; vw.w = v1.y; oa[dt] = MFMA16(__builtin_bit_cast(bf16x8, vw), pf, oa[dt]); }
        }
    }
    lrun += __shfl_xor(lrun, 16); lrun += __shfl_xor(lrun, 32);
    const float inv = 1.f / lrun;
#pragma unroll
    for (int dt = 0; dt < 16; ++dt) { u32x2 o; o.x = cvt_pk_bf16(oa[dt][0] * inv, oa[dt][1] * inv); o.y = cvt_pk_bf16(oa[dt][2] * inv, oa[dt][3] * inv);
        *(u32x2*)(O + qrow * DM + head * 256 + dt * 16 + quad * 4) = o; }
}
constexpr int AS_S = 0, AS_P = 8192, AS_O = 16384;
__device__ __forceinline__ void attn_sample_unit(KPtr p, ldsp lds, int unit) {
    const int tid = fresh_tid(), lane = tid & 63, wid = __builtin_amdgcn_readfirstlane(tid >> 6), l15 = lane & 15, quad = lane >> 4;
    const int head = unit & 3, b = unit >> 2;
    const bf16_t* QX = (const bf16_t*)(p->ws + WS_QX); bf16_t* O = (bf16_t*)(p->ws + WS_O);
    const float* CK = p->in[8] + (size_t)b * 256 * 1024 + head * 256; const float* CV = p->in[9] + (size_t)b * 256 * 1024 + head * 256;
    const size_t r0 = (size_t)MP + (size_t)b * 8;
    bf16x8 qf[8];
#pragma unroll
    for (int ks = 0; ks < 8; ++ks) { u32x4 w = (u32x4){0u, 0u, 0u, 0u}; if (l15 < 8) w = *(const u32x4*)(QX + (r0 + l15) * DM + head * 256 + ks * 32 + quad * 8); qf[ks] = __builtin_bit_cast(bf16x8, w); }
    __syncthreads();
    {
        f32x4 ka[2][8], kb[2][8];
#pragma unroll
        for (int ps = 0; ps < 2; ++ps) { const float* kp = CK + (size_t)(ps * 128 + wid * 16 + l15) * 1024 + quad * 8;
#pragma unroll
            for (int ks = 0; ks < 8; ++ks) { ka[ps][ks] = *(const f32x4*)(kp + ks * 32); kb[ps][ks] = *(const f32x4*)(kp + ks * 32 + 4); } }
#pragma unroll
        for (int ps = 0; ps < 2; ++ps) { const int m0 = ps * 128 + wid * 16;
            f32x4 sc = (f32x4){0.f, 0.f, 0.f, 0.f};
#pragma unroll
            for (int ks = 0; ks < 8; ++ks) { u32x4 w; w.x = cvt_pk_bf16(ka[ps][ks].x, ka[ps][ks].y); w.y = cvt_pk_bf16(ka[ps][ks].z, ka[ps][ks].w); w.z = cvt_pk_bf16(kb[ps][ks].x, kb[ps][ks].y); w.w = cvt_pk_bf16(kb[ps][ks].z, kb[ps][ks].w);
                sc = MFMA16(__builtin_bit_cast(bf16x8, w), qf[ks], sc); }
            if (l15 < 8) *(LAS f32x4*)(lds + AS_S + (l15 * 256 + m0 + quad * 4) * 4) = sc; }
    }
    const float* vp = CV + (size_t)(wid * 32) * 1024 + lane * 4;
    f32x4 vA[8], vB[8];
#pragma unroll
    for (int i = 0; i < 8; ++i) vA[i] = *(const f32x4*)(vp + (size_t)i * 1024);
    LBAR();
    {
        const f32x4 s4 = *(const LAS f32x4*)(lds + AS_S + (wid * 256 + lane * 4) * 4);
        const float mx = wave_max(fmaxf(fmaxf(s4.x, s4.y), fmaxf(s4.z, s4.w)));
        const float e0 = __expf(s4.x - mx), e1 = __expf(s4.y - mx), e2 = __expf(s4.z - mx), e3 = __expf(s4.w - mx);
        const float inv = 1.f / wave_sum(e0 + e1 + e2 + e3);
        LDSF(AS_P + ((lane * 4 + 0) * 8 + wid) * 4) = e0 * inv; LDSF(AS_P + ((lane * 4 + 1) * 8 + wid) * 4) = e1 * inv;
        LDSF(AS_P + ((lane * 4 + 2) * 8 + wid) * 4) = e2 * inv; LDSF(AS_P + ((lane * 4 + 3) * 8 + wid) * 4) = e3 * inv;
    }
    LBAR();
    {
        f32x4 acc[8];
#pragma unroll
        for (int t = 0; t < 8; ++t) acc[t] = (f32x4){0.f, 0.f, 0.f, 0.f};
#define AS_PV(vv, mb) do { _Pragma("unroll") for (int i = 0; i < 8; ++i) { const int m = wid * 32 + (mb) + i; const f32x4 pa = *(const LAS f32x4*)(lds + AS_P + m * 32), pb = *(const LAS f32x4*)(lds + AS_P + m * 32 + 16); \
                acc[0] = acc[0] + vv[i] * pa.x; acc[1] = acc[1] + vv[i] * pa.y; acc[2] = acc[2] + vv[i] * pa.z; acc[3] = acc[3] + vv[i] * pa.w; \
                acc[4] = acc[4] + vv[i] * pb.x; acc[5] = acc[5] + vv[i] * pb.y; acc[6] = acc[6] + vv[i] * pb.z; acc[7] = acc[7] + vv[i] * pb.w; } } while (0)
#define AS_LD(vv, mb) do { _Pragma("unroll") for (int i = 0; i < 8; ++i) vv[i] = *(const f32x4*)(vp + (size_t)((mb) + i) * 1024); } while (0)
        AS_LD(vB, 8);  AS_PV(vA, 0);
        AS_LD(vA, 16); AS_PV(vB, 8);
        AS_LD(vB, 24); AS_PV(vA, 16);
        AS_PV(vB, 24);
#undef AS_PV
#undef AS_LD
#pragma unroll
        for (int t = 0; t < 8; ++t) *(LAS f32x4*)(lds + AS_O + ((wid * 8 + t) * 256 + lane * 4) * 4) = acc[t];
    }
    __syncthreads();
    { const int t = tid >> 6, d4 = (tid & 63) * 4; f32x4 a = (f32x4){0.f, 0.f, 0.f, 0.f};
#pragma unroll
        for (int w = 0; w < 8; ++w) a = a + *(const LAS f32x4*)(lds + AS_O + ((w * 8 + t) * 256 + d4) * 4);
        u32x2 o; o.x = cvt_pk_bf16(a.x, a.y); o.y = cvt_pk_bf16(a.z, a.w); *(u32x2*)(O + (r0 + t) * DM + head * 256 + d4) = o; }
}


#ifndef DUMP_AT
#define DUMP_AT -1
#define DUMP_OFF 0
#define DUMP_LD 1024
#define DUMP_COL0 0
#endif
#ifndef DUMP_COL1
#define DUMP_COL1 -1
#endif
__device__ __forceinline__ void dump_phase(KPtr p, int G) {
    const bf16_t* B = (const bf16_t*)(p->ws + (size_t)DUMP_OFF);
    for (size_t i = (size_t)blockIdx.x * 512 + threadIdx.x; i < (size_t)MT * 1024; i += (size_t)G * 512) { const size_t r = i >> 10, c = i & 1023; float v = bf2f(B[r * DUMP_LD + DUMP_COL0 + c]); if (DUMP_COL1 >= 0) v += 1.7f * bf2f(B[r * DUMP_LD + DUMP_COL1 + c]); p->out[i] = v; }
}
#define DUMP(n) do { if (DUMP_AT == (n)) { dump_phase(kparams(), G); return; } } while (0)

__global__ void __launch_bounds__(512, 2) hymba_fwd(Params pv) {
    extern __shared__ __attribute__((aligned(16))) unsigned char lds_raw[];
    ldsp lds = (ldsp)lds_raw;
    cg::grid_group grid = cg::this_grid();
    const int G = gridDim.x;
    volatile LAS unsigned* bst = (volatile LAS unsigned*)(lds + LDS_BYTES - 64);
    { unsigned* bar0 = (unsigned*)kparams()->ws; if (threadIdx.x == 0) { bst[0] = 0u; bst[1] = 0u; xb_add(bar0 + XB_XCNT(xb_xcc_id()), 1u); } }
    __syncthreads();
#define GSYNC() xcd_barrier((unsigned*)kparams()->ws, bst)
#ifndef PHMASK
#define PHMASK 0xffffffffu
#endif
#define PH(n) ((PHMASK >> (n)) & 1u)
    if (PH(0)) { KPtr p = kparams(); p0_prologue(p, lds, G); }
    if (kparams()->ws == nullptr) grid.sync();
    GSYNC();
    DUMP(0);
    if (PH(1)) {
        KPtr p = kparams(); unsigned char* ws = p->ws;
        pg8::Gemm g0{(const bf16_t*)(ws + WS_UM), (const bf16_t*)(ws + WS_WKVT), NMEMROWS, 2048, 1024}; pg8::StaticOrder S0; S0.init(NMEMROWS, 2048, G, G - 1 - (int)blockIdx.x);
        EpiKV E0{p->out + O_MK, p->out + O_MV, (bf16_t*)(ws + WS_KM), (bf16_t*)(ws + WS_VMT)};
        pg8::gemm_phase<EpiKV, pg8::StaticOrder, true, true>(lds, g0, S0, E0);
        __syncthreads();
        pg8::Gemm g1{(const bf16_t*)(ws + WS_U), (const bf16_t*)(ws + WS_W1T), MT, N1PAD, 1024}; pg8::StaticOrder S1; S1.init(MT, N1PAD, G, (int)blockIdx.x);
        EpiG1 E1{(bf16_t*)(ws + WS_BIG), (float*)(ws + WS_GATES)};
        pg8::gemm_phase<EpiG1, pg8::StaticOrder, true, true>(lds, g1, S1, E1);
    }
    GSYNC();
    DUMP(1);
    if (PH(2)) { KPtr p = kparams(); conv_phase(p, G); }
    GSYNC();
    DUMP(2);
    if (PH(3)) { KPtr p = kparams(); for (int u = blockIdx.x; u < 128; u += G) ssd_prompt_unit(p, lds, u >> 4, u & 15); }
    if (PH(4)) { KPtr p = kparams(); for (int u = blockIdx.x; u < 256; u += G) { if (u >= 128) { const int v = u - 128; mlstm_prompt_unit(p, lds, v >> 4, (v >> 2) & 3, v & 3); } } }
    if (PH(6)) { KPtr p = kparams(); unsigned* q = (unsigned*)p->ws + 8256; volatile LAS unsigned* slot = (volatile LAS unsigned*)(lds + LDS_BYTES - 32);
        for (;;) { if (threadIdx.x == 0) slot[0] = atomicAdd(q, 1u); __syncthreads(); const unsigned v = slot[0]; __syncthreads(); if (v >= 1024u) break; mlstm_sample_unit(p, lds, (int)(v >> 3), (int)((v >> 1) & 3), (int)(v & 1)); } }
    if (PH(5)) { KPtr p = kparams(); unsigned* q = (unsigned*)p->ws + 8192; volatile LAS unsigned* slot = (volatile LAS unsigned*)(lds + LDS_BYTES - 32);
        for (;;) { if (threadIdx.x == 0) slot[0] = atomicAdd(q, 1u); __syncthreads(); const unsigned v = slot[0]; __syncthreads(); if (v >= 2048u) break; ssd_sample_unit(p, lds, (int)(v >> 4), (int)(v & 15)); } }
    GSYNC();
    DUMP(3);
    if (PH(7)) { KPtr p = kparams(); norm_phase(p, G); }
    GSYNC();
    DUMP(4);
    if (PH(8)) { KPtr p = kparams(); unsigned char* ws = p->ws;
        pg8::Gemm g{(const bf16_t*)(ws + WS_A2), (const bf16_t*)(ws + WS_W2T), MP, 1024, 2048}; pg8::StaticOrder S; S.init(MP, 1024, G, (int)blockIdx.x);
        EpiB E{(bf16_t*)(ws + WS_R1), 1024, 1.f};
        pg8::gemm_phase<EpiB, pg8::StaticOrder, true, true>(lds, g, S, E);
    }
    GSYNC();
    {
        KPtr p = kparams(); unsigned char* ws = p->ws;
        if (blockIdx.x < 16) { if (PH(8)) {
            pg8::Gemm g{(const bf16_t*)(ws + WS_A2) + (size_t)MP * 2048, (const bf16_t*)(ws + WS_W2T), MS, 1024, 2048}; pg8::StaticOrder S; S.init(MS, 1024, 16, (int)blockIdx.x);
            EpiB E{(bf16_t*)(ws + WS_R1) + (size_t)MP * 1024, 1024, 1.f};
            pg8::gemm_phase<EpiB, pg8::StaticOrder, true, true>(lds, g, S, E); }
            asm volatile("s_waitcnt vmcnt(0)" ::: "memory"); __syncthreads();
            if (threadIdx.x == 0) { __builtin_amdgcn_fence(__ATOMIC_RELEASE, "agent"); asm volatile("s_waitcnt vmcnt(0)" ::: "memory"); (void)xb_add((unsigned*)ws + 8320, 1u); } }
        else if (PH(9)) {
            row_phase<true, false>(p, 16, G - 16, 0, MP, p->in[22], p->in[26]);
            if (threadIdx.x == 0) { unsigned* cw = (unsigned*)ws + 8320; while (xb_ld(cw) < 16u) __builtin_amdgcn_s_sleep(1);
                __builtin_amdgcn_fence(__ATOMIC_ACQUIRE, "agent"); asm volatile("s_waitcnt vmcnt(0)" ::: "memory"); }
            __syncthreads();
            row_phase<true, false>(p, 16, G - 16, MP, MT, p->in[22], p->in[26]); }
    }
    GSYNC();
    DUMP(6);
    if (PH(8)) { KPtr p = kparams(); unsigned char* ws = p->ws;
        pg8::Gemm g{(const bf16_t*)(ws + WS_U), (const bf16_t*)(ws + WS_WXQT), MT, 1024, 1024}; pg8::StaticOrder S; S.init(MT, 1024, G, (int)blockIdx.x);
        EpiB E{(bf16_t*)(ws + WS_QX), 1024, 0.0625f};
        pg8::gemm_phase<EpiB, pg8::StaticOrder, true, true>(lds, g, S, E);
    }
    GSYNC();
    DUMP(7);
    if ((blockIdx.x & 1) && PH(11)) { KPtr p = kparams(); for (int u = blockIdx.x; u < 512; u += G) { attn_sample_unit(p, lds, u); __syncthreads(); } }
    if (PH(10)) { KPtr p = kparams(); for (int u = blockIdx.x; u < 512; u += G) { attn_prompt_unit(p, lds, u); __syncthreads(); } }
    if (!(blockIdx.x & 1) && PH(11)) { KPtr p = kparams(); for (int u = blockIdx.x; u < 512; u += G) { attn_sample_unit(p, lds, u); __syncthreads(); } }
    GSYNC();
    DUMP(8);
    if (PH(8)) { KPtr p = kparams(); unsigned char* ws = p->ws;
        pg8::Gemm g{(const bf16_t*)(ws + WS_O), (const bf16_t*)(ws + WS_WXOT), MP, 1024, 1024}; pg8::StaticOrder S; S.init(MP, 1024, G, (int)blockIdx.x);
        EpiB E{(bf16_t*)(ws + WS_R1), 1024, 1.f};
        pg8::gemm_phase<EpiB, pg8::StaticOrder, true, true>(lds, g, S, E);
    }
    GSYNC();
    {
        KPtr p = kparams(); unsigned char* ws = p->ws;
        if (blockIdx.x < 16) { if (PH(8)) {
            pg8::Gemm g{(const bf16_t*)(ws + WS_O) + (size_t)MP * 1024, (const bf16_t*)(ws + WS_WXOT), MS, 1024, 1024}; pg8::StaticOrder S; S.init(MS, 1024, 16, (int)blockIdx.x);
            EpiB E{(bf16_t*)(ws + WS_R1) + (size_t)MP * 1024, 1024, 1.f};
            pg8::gemm_phase<EpiB, pg8::StaticOrder, true, true>(lds, g, S, E); }
            asm volatile("s_waitcnt vmcnt(0)" ::: "memory"); __syncthreads();
            if (threadIdx.x == 0) { __builtin_amdgcn_fence(__ATOMIC_RELEASE, "agent"); asm volatile("s_waitcnt vmcnt(0)" ::: "memory"); (void)xb_add((unsigned*)ws + 8384, 1u); } }
        else if (PH(9)) {
            row_phase<false, false>(p, 16, G - 16, 0, MP, p->in[29], p->in[30]);
            if (threadIdx.x == 0) { unsigned* cw = (unsigned*)ws + 8384; while (xb_ld(cw) < 16u) __builtin_amdgcn_s_sleep(1);
                __builtin_amdgcn_fence(__ATOMIC_ACQUIRE, "agent"); asm volatile("s_waitcnt vmcnt(0)" ::: "memory"); }
            __syncthreads();
            row_phase<false, false>(p, 16, G - 16, MP, MT, p->in[29], p->in[30]); }
    }
    GSYNC();
    DUMP(10);
    if (PH(12)) { KPtr p = kparams(); unsigned char* ws = p->ws;
        pg8::Gemm g{(const bf16_t*)(ws + WS_U), (const bf16_t*)(ws + WS_WGUT), MT, 5632, 1024}; pg8::StaticOrder S; S.init(MT, 5632, G, (int)blockIdx.x);
        EpiSwi E{(bf16_t*)(ws + WS_HID)};
        pg8::gemm_phase<EpiSwi, pg8::StaticOrder, true, true>(lds, g, S, E);
    }
    GSYNC();
    DUMP(11);
    if (PH(8)) { KPtr p = kparams(); unsigned char* ws = p->ws;
        pg8::Gemm g{(const bf16_t*)(ws + WS_HID), (const bf16_t*)(ws + WS_WDT), MP, 1024, 2816}; pg8::StaticOrder S; S.init(MP, 1024, G, (int)blockIdx.x);
        EpiB E{(bf16_t*)(ws + WS_R1), 1024, 1.f};
        pg8::gemm_phase<EpiB, pg8::StaticOrder, true, true>(lds, g, S, E);
    }
    GSYNC();
    {
        KPtr p = kparams(); unsigned char* ws = p->ws;
        if (blockIdx.x < 32) { if (PH(8)) { const int kh = (int)blockIdx.x >> 4;
            pg8::Gemm g{(const bf16_t*)(ws + WS_HID) + (size_t)MP * 2816 + kh * 1408, (const bf16_t*)(ws + WS_WDT) + kh * 1408, MS, 1024, 1408, 2816}; pg8::StaticOrder S; S.init(MS, 1024, 16, (int)blockIdx.x & 15);
            EpiP32 E{(float*)(ws + WS_A2) + (size_t)kh * MS * 1024, 1024};
            pg8::gemm_phase<EpiP32, pg8::StaticOrder, true, true>(lds, g, S, E); }
            asm volatile("s_waitcnt vmcnt(0)" ::: "memory"); __syncthreads();
            if (threadIdx.x == 0) { __builtin_amdgcn_fence(__ATOMIC_RELEASE, "agent"); asm volatile("s_waitcnt vmcnt(0)" ::: "memory"); (void)xb_add((unsigned*)ws + 8448, 1u); } }
        else if (PH(9)) {
            row_phase<false, true>(p, 32, G - 32, 0, MP, p->in[34], p->in[34]);
            if (threadIdx.x == 0) { unsigned* cw = (unsigned*)ws + 8448; while (xb_ld(cw) < 32u) __builtin_amdgcn_s_sleep(1);
                __builtin_amdgcn_fence(__ATOMIC_ACQUIRE, "agent"); asm volatile("s_waitcnt vmcnt(0)" ::: "memory"); }
            __syncthreads();
            row_phase<false, true, true>(p, 32, G - 32, MP, MT, p->in[34], p->in[34]); }
    }
}

extern "C" void kernel_launch(void* const* d_in, const int* in_sizes, int n_in, void* d_out, int out_size, void* d_ws, size_t ws_size, hipStream_t stream) {
    static int grid = 0;
    if (grid == 0) {
        if (n_in != 35 || ws_size < WS_END) { fprintf(stderr, "kernel_launch: unexpected n_in %d / ws %zu\n", n_in, ws_size); grid = -1; return; }
        int dev = 0, cus = 0, per_cu = 0;
        (void)hipGetDevice(&dev); (void)hipDeviceGetAttribute(&cus, hipDeviceAttributeMultiprocessorCount, dev);
        if (hipFuncSetAttribute((const void*)hymba_fwd, hipFuncAttributeMaxDynamicSharedMemorySize, LDS_BYTES) != hipSuccess) { fprintf(stderr, "kernel_launch: hipFuncSetAttribute failed\n"); grid = -1; return; }
        if (hipOccupancyMaxActiveBlocksPerMultiprocessor(&per_cu, (const void*)hymba_fwd, 512, LDS_BYTES) != hipSuccess || per_cu < 1) { fprintf(stderr, "kernel_launch: occupancy query says %d\n", per_cu); per_cu = 1; }
        (void)hipGetLastError();
        grid = cus * 1;
    }
    if (grid < 0) return;
    if (hipMemsetAsync(d_ws, 0, 65536, stream) != hipSuccess) { fprintf(stderr, "kernel_launch: memset failed\n"); return; }
    Params p{};
    for (int i = 0; i < 35; ++i) p.in[i] = (const float*)d_in[i];
    p.out = (float*)d_out; p.ws = (unsigned char*)d_ws;
    void* args[] = {&p};
    hipError_t e = hipLaunchCooperativeKernel((const void*)hymba_fwd, dim3(grid), dim3(512), args, LDS_BYTES, stream);
    if (e != hipSuccess) fprintf(stderr, "cooperative launch failed: %s (grid %d)\n", hipGetErrorString(e), grid);
}
```

```cpp
#include <hip/hip_runtime.h>
#include <hip/hip_cooperative_groups.h>
#include <cstdio>
#include <cstdint>
namespace cg = cooperative_groups;

#define LAS __attribute__((address_space(3)))
typedef unsigned short bf16_t;
typedef short bf16x8 __attribute__((ext_vector_type(8)));
typedef float f32x4 __attribute__((ext_vector_type(4)));
typedef float f32x2 __attribute__((ext_vector_type(2)));
typedef unsigned u32x4 __attribute__((ext_vector_type(4)));
typedef unsigned u32x2 __attribute__((ext_vector_type(2)));
typedef LAS unsigned char* ldsp;

typedef __bf16 bf16v2_t __attribute__((ext_vector_type(2)));
__device__ __forceinline__ unsigned cvt_pk_bf16(float lo, float hi) { f32x2 v = {lo, hi}; bf16v2_t b = __builtin_convertvector(v, bf16v2_t); return __builtin_bit_cast(unsigned, b); }
__device__ __forceinline__ float bf2f(unsigned short b) { return __uint_as_float(((unsigned)b) << 16); }
__device__ __forceinline__ float bflo(unsigned w) { return __uint_as_float(w << 16); }
__device__ __forceinline__ float bfhi(unsigned w) { return __uint_as_float(w & 0xffff0000u); }
__device__ __forceinline__ unsigned short f2bf(float f) { return (unsigned short)(cvt_pk_bf16(f, 0.f) & 0xffffu); }
__device__ __forceinline__ float wave_sum(float v) {
#pragma unroll
    for (int o = 1; o < 64; o <<= 1) v += __shfl_xor(v, o);
    return v;
}
__device__ __forceinline__ float wave_max(float v) {
#pragma unroll
    for (int o = 1; o < 64; o <<= 1) v = fmaxf(v, __shfl_xor(v, o));
    return v;
}
__device__ __forceinline__ float softplusf(float x) { return x > 20.f ? x : __logf(1.f + __expf(x)); }
__device__ __forceinline__ float siluf(float x) { return x * __builtin_amdgcn_rcpf(1.f + __expf(-x)); }
__device__ __forceinline__ float sigmoidf_(float x) { return __builtin_amdgcn_rcpf(1.f + __expf(-x)); }
#define LDS_WAIT() asm volatile("s_waitcnt lgkmcnt(0)" ::: "memory")
__device__ __forceinline__ int fresh_tid() { int t = threadIdx.x; asm volatile("" : "+v"(t)); return t; }

namespace pg8 {
constexpr int BM = 256, BK = 64, HALF = 128, HTB = HALF * BK * 2, STAGE_BYTES = 8 * HTB, NXCD = 8, WGM = 8;
__host__ __device__ __forceinline__ int lds_byte(int r, int c) { const int st = (r >> 4) * 2 + (c >> 5), rr = r & 15, cc = c & 31, ob = rr * 64 + cc * 2; return st * 1024 + (ob ^ (((ob >> 9) & 1) << 5)); }
__host__ __device__ __forceinline__ void stage_rc(int b, int& R, int& C) { const int st = b / 1024, sb = b % 1024, swz = sb ^ (((sb >> 9) & 1) << 5); R = (st >> 1) * 16 + swz / 64; C = (st & 1) * 32 + (swz % 64) / 2; }
__host__ __device__ __forceinline__ int perm32(int rho) { const int n = rho >> 4, i = rho & 15; return 8 * (i >> 2) + 4 * n + (i & 3); }
struct Unit { int pm, pn; };
struct Gemm { const bf16_t* A; const bf16_t* Bt; int M, N, K; int ld; };
struct StaticOrder {
    int nM, nN, nwg, G, c;
    __host__ __device__ void init(int M, int N, int G_, int c_) { nM = M / BM; nN = N / BM; nwg = nM * nN; G = G_; c = c_; }
    __host__ __device__ bool next(int i, Unit& u) const {
        const long L = (long)i * G + c; if (L >= nwg) return false;
        int wgid = (int)L; { const int q = nwg / NXCD, r = nwg % NXCD, xcd = wgid % NXCD, off = wgid / NXCD; wgid = (xcd < r ? xcd * (q + 1) : r * (q + 1) + (xcd - r) * q) + off; }
        const int nig = WGM * nN, gid = wgid / nig, fm = gid * WGM, gsz = (nM - fm) < WGM ? (nM - fm) : WGM;
        u.pm = fm + ((wgid % nig) % gsz); u.pn = (wgid % nig) / gsz; return true;
    }
    __device__ __forceinline__ void a_ready(const Unit&) const {}
    __device__ __forceinline__ void done(const Unit&) const {}
};
template <class Epi, class Sched, bool ALIGN_EPI = false, bool SP2 = false>
__device__ __forceinline__ void gemm_phase(ldsp lds, const Gemm g, const Sched& S, const Epi& E) {
    const int tid = fresh_tid(), wid = __builtin_amdgcn_readfirstlane(tid >> 6), lane = tid & 63, wr = wid >> 2, wc = wid & 3, fr = lane & 15, fq = lane >> 4;
    const int nt = g.K / BK, K = g.ld ? g.ld : g.K;
    unsigned voffA[2], voffB[2];
#pragma unroll
    for (int i = 0; i < 2; ++i) { int R, C; stage_rc(tid * 16 + i * 8192, R, C); const int Rb = Epi::PERM ? ((R & ~31) + perm32(R & 31)) : R;
        voffA[i] = (unsigned)(R * K + C) * 2u; voffB[i] = (unsigned)(Rb * K + C) * 2u; }
    const size_t kstep = (size_t)(BK * 2);
    const size_t hstep = (size_t)HALF * K * 2;
    const size_t tstep = 2 * hstep;
    const unsigned ldsw = (unsigned)wid * 1024u;
    const int aoff = lds_byte(wr * 64 + fr, fq * 8), boff = lds_byte(wc * 32 + fr, fq * 8);
#define PG8_SA(b, h) (((b) * 2 + (h)) * HTB)
#define PG8_SB(b, h) ((4 + (b) * 2 + (h)) * HTB)
#define PG8_STAGE(bufoff, gbase, voff) do { _Pragma("unroll") for (int _i = 0; _i < 2; ++_i) \
        __builtin_amdgcn_global_load_lds((const unsigned*)((const char*)(gbase) + (voff)[_i]), (LAS unsigned*)(lds + (bufoff) + ldsw + _i * 8192), 16, 0, 0); } while (0)
#define PG8_LDA(dst, b, h) do { _Pragma("unroll") for (int m = 0; m < 4; ++m) _Pragma("unroll") for (int k = 0; k < 2; ++k) dst[m][k] = *(const LAS bf16x8*)(lds + PG8_SA(b, h) + aoff + m * 2048 + k * 1024); } while (0)
#define PG8_LDB(dst, b, h) do { _Pragma("unroll") for (int n = 0; n < 2; ++n) _Pragma("unroll") for (int k = 0; k < 2; ++k) dst[n][k] = *(const LAS bf16x8*)(lds + PG8_SB(b, h) + boff + n * 2048 + k * 1024); } while (0)
#define PG8_MMA(ai, bj, At, Bt) do { __builtin_amdgcn_s_setprio(1); _Pragma("unroll") for (int m = 0; m < 4; ++m) _Pragma("unroll") for (int n = 0; n < 2; ++n) _Pragma("unroll") for (int k = 0; k < 2; ++k) \
        acc[ai][bj][m][n] = __builtin_amdgcn_mfma_f32_16x16x32_bf16(Bt[n][k], At[m][k], acc[ai][bj][m][n], 0, 0, 0); __builtin_amdgcn_s_setprio(0); } while (0)
#define PG8_WAIT_V(n) asm volatile("s_waitcnt vmcnt(" #n ")" ::: "memory")
#define PG8_WAIT_L(n) asm volatile("s_waitcnt lgkmcnt(" #n ")" ::: "memory")
#define PG8_BAR __builtin_amdgcn_s_barrier()
#define PG8_SCHED __builtin_amdgcn_sched_barrier(0)
    Unit cur, nxt; int ui = 0;
    if (!S.next(0, cur)) return;
    f32x4 acc[2][2][4][2];
#pragma unroll
    for (int a = 0; a < 2; ++a)
#pragma unroll
        for (int b = 0; b < 2; ++b)
#pragma unroll
            for (int m = 0; m < 4; ++m)
#pragma unroll
                for (int n = 0; n < 2; ++n) acc[a][b][m][n] = (f32x4){0.f, 0.f, 0.f, 0.f};
    bf16x8 At[4][2], B0[2][2], B1[2][2];
    const char* cA = (const char*)g.A + (size_t)cur.pm * tstep; const char* cB = (const char*)g.Bt + (size_t)cur.pn * tstep;
    S.a_ready(cur);
    if constexpr (SP2) {
        PG8_STAGE(PG8_SB(0, 0), cB, voffB); PG8_STAGE(PG8_SB(0, 1), cB + hstep, voffB); PG8_STAGE(PG8_SA(0, 0), cA, voffA); PG8_STAGE(PG8_SA(0, 1), cA + hstep, voffA);
        if (wr == 1) PG8_BAR;
        PG8_WAIT_V(2); PG8_BAR;
        PG8_STAGE(PG8_SB(1, 0), cB + kstep, voffB); PG8_STAGE(PG8_SA(1, 0), cA + kstep, voffA); PG8_STAGE(PG8_SB(1, 1), cB + hstep + kstep, voffB);
        PG8_WAIT_V(6); PG8_BAR;
    } else {
        PG8_STAGE(PG8_SB(0, 0), cB, voffB); PG8_STAGE(PG8_SA(0, 0), cA, voffA); PG8_STAGE(PG8_SB(0, 1), cB + hstep, voffB); PG8_STAGE(PG8_SA(0, 1), cA + hstep, voffA);
        if (wr == 1) PG8_BAR;
        PG8_WAIT_V(4); PG8_BAR;
        PG8_STAGE(PG8_SB(1, 0), cB + kstep, voffB); PG8_STAGE(PG8_SA(1, 0), cA + kstep, voffA); PG8_STAGE(PG8_SB(1, 1), cB + hstep + kstep, voffB);
        PG8_WAIT_V(6); PG8_BAR;
    }
    for (;;) {
        const bool has_next = S.next(ui + 1, nxt);
        const char* nA = has_next ? (const char*)g.A + (size_t)nxt.pm * tstep : cA; const char* nB = has_next ? (const char*)g.Bt + (size_t)nxt.pn * tstep : cB;
        for (int t = 0; t < nt; t += 2) {
            const bool last = (t == nt - 2);
            const char* a1 = cA + (size_t)(t + 1) * kstep;
            const char* a2 = last ? nA : cA + (size_t)(t + 2) * kstep; const char* b2 = last ? nB : cB + (size_t)(t + 2) * kstep;
            const char* a3 = a2 + kstep; const char* b3 = b2 + kstep;
            if (last && has_next) S.a_ready(nxt);
            if constexpr (SP2) {
            PG8_LDB(B0, 0, 0); PG8_LDB(B1, 0, 1); PG8_SCHED; PG8_LDA(At, 0, 0); PG8_STAGE(PG8_SA(1, 1), a1 + hstep, voffA);
            PG8_WAIT_V(8); PG8_WAIT_L(0); PG8_BAR; PG8_MMA(0, 0, At, B0); PG8_MMA(0, 1, At, B1); PG8_BAR; PG8_SCHED;
            PG8_LDA(At, 0, 1); PG8_STAGE(PG8_SB(0, 0), b2, voffB); PG8_STAGE(PG8_SB(0, 1), b2 + hstep, voffB); PG8_STAGE(PG8_SA(0, 0), a2, voffA);
            PG8_WAIT_V(8); PG8_WAIT_L(0); PG8_BAR; PG8_MMA(1, 0, At, B0); PG8_MMA(1, 1, At, B1); PG8_BAR; PG8_SCHED;
            PG8_LDB(B0, 1, 0); PG8_LDB(B1, 1, 1); PG8_SCHED; PG8_LDA(At, 1, 0); PG8_STAGE(PG8_SA(0, 1), a2 + hstep, voffA);
            PG8_WAIT_V(8); PG8_WAIT_L(0); PG8_BAR; PG8_MMA(0, 0, At, B0); PG8_MMA(0, 1, At, B1); PG8_BAR; PG8_SCHED;
            PG8_LDA(At, 1, 1); PG8_STAGE(PG8_SB(1, 0), b3, voffB); PG8_STAGE(PG8_SB(1, 1), b3 + hstep, voffB); PG8_STAGE(PG8_SA(1, 0), a3, voffA);
            PG8_WAIT_V(8); PG8_WAIT_L(0); PG8_BAR; PG8_MMA(1, 0, At, B0); PG8_MMA(1, 1, At, B1); PG8_BAR; PG8_SCHED;
            } else {
            PG8_LDB(B0, 0, 0); PG8_SCHED; PG8_LDA(At, 0, 0); PG8_STAGE(PG8_SA(1, 1), a1 + hstep, voffA);
            PG8_WAIT_L(8); PG8_BAR; PG8_WAIT_L(0); PG8_MMA(0, 0, At, B0); PG8_BAR; PG8_SCHED;
            PG8_LDB(B1, 0, 1); PG8_STAGE(PG8_SB(0, 0), b2, voffB);
            PG8_BAR; PG8_WAIT_L(0); PG8_MMA(0, 1, At, B1); PG8_BAR;
            PG8_LDA(At, 0, 1); PG8_STAGE(PG8_SA(0, 0), a2, voffA);
            PG8_BAR; PG8_WAIT_L(0); PG8_MMA(1, 0, At, B0); PG8_BAR; PG8_SCHED;
            PG8_STAGE(PG8_SB(0, 1), b2 + hstep, voffB);
            PG8_WAIT_V(6); PG8_BAR; PG8_MMA(1, 1, At, B1); PG8_BAR;
            PG8_LDB(B0, 1, 0); PG8_SCHED; PG8_LDA(At, 1, 0); PG8_STAGE(PG8_SA(0, 1), a2 + hstep, voffA);
            PG8_WAIT_L(8); PG8_BAR; PG8_WAIT_L(0); PG8_MMA(0, 0, At, B0); PG8_BAR; PG8_SCHED;
            PG8_LDB(B1, 1, 1); PG8_STAGE(PG8_SB(1, 0), b3, voffB);
            PG8_BAR; PG8_WAIT_L(0); PG8_MMA(0, 1, At, B1); PG8_BAR;
            PG8_LDA(At, 1, 1); PG8_STAGE(PG8_SA(1, 0), a3, voffA);
            PG8_BAR; PG8_WAIT_L(0); PG8_MMA(1, 0, At, B0); PG8_BAR; PG8_SCHED;
            PG8_STAGE(PG8_SB(1, 1), b3 + hstep, voffB);
            PG8_WAIT_V(6); PG8_BAR; PG8_MMA(1, 1, At, B1); PG8_BAR;
            }
        }
        if constexpr (ALIGN_EPI) { if (wr == 0) PG8_BAR; }
        E(acc, cur, wr, wc, fr, fq);
        if (!has_next) break;
#pragma unroll
        for (int a = 0; a < 2; ++a)
#pragma unroll
            for (int b = 0; b < 2; ++b)
#pragma unroll
                for (int m = 0; m < 4; ++m)
#pragma unroll
                    for (int n = 0; n < 2; ++n) acc[a][b][m][n] = (f32x4){0.f, 0.f, 0.f, 0.f};
        cur = nxt; cA = nA; cB = nB; ++ui;
        if constexpr (ALIGN_EPI) { if (wr == 1) PG8_BAR; }
    }
    PG8_WAIT_V(0);
    if constexpr (!ALIGN_EPI) { if (wr == 0) PG8_BAR; }
    PG8_BAR;
#undef PG8_SA
#undef PG8_SB
#undef PG8_STAGE
#undef PG8_LDA
#undef PG8_LDB
#undef PG8_MMA
#undef PG8_WAIT_V
#undef PG8_WAIT_L
#undef PG8_BAR
#undef PG8_SCHED
}
}

constexpr int DM = 1024, MP = 16384, MS = 1024, MT = 17408, NMEMROWS = 2048;
constexpr int PROJ_LD = 5632, N1PAD = 5888, XBC_LD = 1536, YP_LD = 2048, FFH = 2816;
constexpr float EPSN = 1e-6f;
constexpr size_t MiB = 1u << 20;
constexpr size_t WS_W1T = 1 * MiB, WS_W2T = 13 * MiB, WS_WKVT = 17 * MiB, WS_WXQT = 21 * MiB, WS_WXOT = 23 * MiB, WS_WGUT = 25 * MiB, WS_WDT = 36 * MiB;
constexpr size_t WS_U = 42 * MiB, WS_UM = 76 * MiB, WS_KM = 80 * MiB, WS_VMT = 84 * MiB, WS_GATES = 88 * MiB, WS_BIG = 91 * MiB;
constexpr size_t WS_XBC = 278 * MiB, WS_YPRE = 329 * MiB, WS_A2 = 397 * MiB, WS_END = 465 * MiB;
constexpr size_t WS_QX = WS_BIG, WS_O = WS_BIG + 34 * MiB, WS_HID = WS_BIG + 68 * MiB, WS_R1 = WS_XBC;
constexpr size_t O_YP = 0, O_YS = 16777216, O_MK = 17825792, O_MV = 19922944, O_SSMP = 22020096, O_CONVP = 23068672, O_MCP = 23105536, O_MNP = 24154112, O_MMP = 24158208,
                 O_SSMS = 24158240, O_CONVS = 40935456, O_MCS = 41525280, O_MNS = 58302496, O_MMS = 58368032;
constexpr int LDS_BYTES = 147456;

struct Params { const float* in[35]; float* out; unsigned char* ws; };
typedef const __attribute__((address_space(4))) Params* KPtr;
__device__ __forceinline__ KPtr kparams() { KPtr k = (KPtr)__builtin_amdgcn_kernarg_segment_ptr(); asm volatile("" : "+s"(k)); return k; }

struct EpiG1 {
    static constexpr bool PERM = true;
    bf16_t* proj; float* gates;
    __device__ __forceinline__ void operator()(const f32x4 (&acc)[2][2][4][2], const pg8::Unit& u, int wr, int wc, int fr, int fq) const {
        const int row0 = u.pm * 256 + wr * 64 + fr;
        if (u.pn < 22) {
            const int col0 = u.pn * 256 + wc * 32 + 8 * fq;
#pragma unroll
            for (int ai = 0; ai < 2; ++ai)
#pragma unroll
                for (int m = 0; m < 4; ++m) { bf16_t* rowp = proj + (size_t)(row0 + ai * 128 + m * 16) * PROJ_LD + col0;
#pragma unroll
                    for (int bj = 0; bj < 2; ++bj) { const f32x4 v0 = acc[ai][bj][m][0], v1 = acc[ai][bj][m][1]; u32x4 w;
                        w.x = cvt_pk_bf16(v0[0], v0[1]); w.y = cvt_pk_bf16(v0[2], v0[3]); w.z = cvt_pk_bf16(v1[0], v1[1]); w.w = cvt_pk_bf16(v1[2], v1[3]);
                        *(u32x4*)(rowp + bj * 128) = w; } }
        } else if (wc == 0) {
#pragma unroll
            for (int ai = 0; ai < 2; ++ai)
#pragma unroll
                for (int m = 0; m < 4; ++m) { float* rp = gates + (size_t)(row0 + ai * 128 + m * 16) * 32 + 8 * fq;
                    *(f32x4*)rp = acc[ai][0][m][0]; *(f32x4*)(rp + 4) = acc[ai][0][m][1]; }
        }
    }
};
struct EpiKV {
    static constexpr bool PERM = true;
    float* outk; float* outv; bf16_t* km; bf16_t* vmt;
    __device__ __forceinline__ void operator()(const f32x4 (&acc)[2][2][4][2], const pg8::Unit& u, int wr, int wc, int fr, int fq) const {
        const int row0 = u.pm * 256 + wr * 64 + fr;
#pragma unroll
        for (int ai = 0; ai < 2; ++ai)
#pragma unroll
            for (int m = 0; m < 4; ++m) { const int row = row0 + ai * 128 + m * 16;
#pragma unroll
                for (int bj = 0; bj < 2; ++bj) { const int c = u.pn * 256 + bj * 128 + wc * 32 + 8 * fq; const f32x4 v0 = acc[ai][bj][m][0], v1 = acc[ai][bj][m][1];
                    if (u.pn < 4) {
                        *(f32x4*)(outk + (size_t)row * 1024 + c) = v0; *(f32x4*)(outk + (size_t)row * 1024 + c + 4) = v1;
                        u32x4 w; w.x = cvt_pk_bf16(v0[0], v0[1]); w.y = cvt_pk_bf16(v0[2], v0[3]); w.z = cvt_pk_bf16(v1[0], v1[1]); w.w = cvt_pk_bf16(v1[2], v1[3]);
                        *(u32x4*)(km + (size_t)row * 1024 + c) = w;
                    } else {
                        const int c2 = c - 1024;
                        *(f32x4*)(outv + (size_t)row * 1024 + c2) = v0; *(f32x4*)(outv + (size_t)row * 1024 + c2 + 4) = v1;
                        const int b = row >> 8, mt = row & 255, h = c2 >> 8, d = c2 & 255;
                        bf16_t* vp = vmt + ((size_t)(b * 4 + h) * 256 + d) * 256 + mt;
#pragma unroll
                        for (int j = 0; j < 4; ++j) { vp[(size_t)j * 256] = f2bf(v0[j]); vp[(size_t)(j + 4) * 256] = f2bf(v1[j]); }
                    } } }
    }
};
struct EpiB {
    static constexpr bool PERM = true;
    bf16_t* O; int ldc; float scale;
    __device__ __forceinline__ void operator()(const f32x4 (&acc)[2][2][4][2], const pg8::Unit& u, int wr, int wc, int fr, int fq) const {
        const int row0 = u.pm * 256 + wr * 64 + fr, col0 = u.pn * 256 + wc * 32 + 8 * fq;
#pragma unroll
        for (int ai = 0; ai < 2; ++ai)
#pragma unroll
            for (int m = 0; m < 4; ++m) { bf16_t* rowp = O + (size_t)(row0 + ai * 128 + m * 16) * ldc + col0;
#pragma unroll
                for (int bj = 0; bj < 2; ++bj) { const f32x4 v0 = acc[ai][bj][m][0] * scale, v1 = acc[ai][bj][m][1] * scale; u32x4 w;
                    w.x = cvt_pk_bf16(v0[0], v0[1]); w.y = cvt_pk_bf16(v0[2], v0[3]); w.z = cvt_pk_bf16(v1[0], v1[1]); w.w = cvt_pk_bf16(v1[2], v1[3]);
                    *(u32x4*)(rowp + bj * 128) = w; } }
    }
};
struct EpiP32 {
    static constexpr bool PERM = true;
    float* C; int ldc;
    __device__ __forceinline__ void operator()(const f32x4 (&acc)[2][2][4][2], const pg8::Unit& u, int wr, int wc, int fr, int fq) const {
        const int row0 = u.pm * 256 + wr * 64 + fr, col0 = u.pn * 256 + wc * 32 + 8 * fq;
#pragma unroll
        for (int ai = 0; ai < 2; ++ai)
#pragma unroll
            for (int m = 0; m < 4; ++m) { float* rowp = C + (size_t)(row0 + ai * 128 + m * 16) * ldc + col0;
#pragma unroll
                for (int bj = 0; bj < 2; ++bj) { *(f32x4*)(rowp + bj * 128) = acc[ai][bj][m][0]; *(f32x4*)(rowp + bj * 128 + 4) = acc[ai][bj][m][1]; } }
    }
};
struct EpiSwi {
    static constexpr bool PERM = true;
    bf16_t* hid;
    __device__ __forceinline__ void operator()(const f32x4 (&acc)[2][2][4][2], const pg8::Unit& u, int wr, int wc, int fr, int fq) const {
        const int row0 = u.pm * 256 + wr * 64 + fr, col0 = u.pn * 128 + wc * 32 + 8 * fq;
#pragma unroll
        for (int ai = 0; ai < 2; ++ai)
#pragma unroll
            for (int m = 0; m < 4; ++m) { bf16_t* rowp = hid + (size_t)(row0 + ai * 128 + m * 16) * FFH + col0;
                float r[8];
#pragma unroll
                for (int n = 0; n < 2; ++n)
#pragma unroll
                    for (int j = 0; j < 4; ++j) { const float gt = acc[ai][0][m][n][j], up = acc[ai][1][m][n][j]; r[n * 4 + j] = siluf(gt) * up; }
                u32x4 w; w.x = cvt_pk_bf16(r[0], r[1]); w.y = cvt_pk_bf16(r[2], r[3]); w.z = cvt_pk_bf16(r[4], r[5]); w.w = cvt_pk_bf16(r[6], r[7]);
                *(u32x4*)rowp = w; }
    }
};


#define XB_TMO      128
#define XB_XCNT(j)  (256  + 64 * (j))
#define XB_XSUB(j)  (1280 + 64 * (j))
#define XB_XGEN(j)  (2304 + 64 * (j))
#define XB_TOP      3328
#define XB_TOPGEN   3392
#define XB_SPIN_CAP (1u << 22)
__device__ __forceinline__ unsigned xb_ld(unsigned* p)              { return __hip_atomic_load(p, __ATOMIC_RELAXED, __HIP_MEMORY_SCOPE_AGENT); }
__device__ __forceinline__ unsigned xb_add(unsigned* p, unsigned v) { return __hip_atomic_fetch_add(p, v, __ATOMIC_RELAXED, __HIP_MEMORY_SCOPE_AGENT); }
__device__ __forceinline__ unsigned xb_xcc_id() { return (unsigned)__builtin_amdgcn_s_getreg((3 << 11) | 20) & 0xFu; }
#define XB_SPIN(cond, bar) do { unsigned _sp = 0; while (cond) { __builtin_amdgcn_s_sleep(1); \
    if ((++_sp & 255u) == 0u) { if (xb_ld(&(bar)[XB_TMO])) break; if (_sp > XB_SPIN_CAP) { atomicAdd(&(bar)[XB_TMO], 1u); break; } } } } while (0)
__device__ __forceinline__ void xcd_barrier_complete(unsigned* bar, unsigned x, unsigned& nloc, unsigned& nx) {
    const unsigned G = gridDim.x * gridDim.y * gridDim.z;
    unsigned sum, cnt, mine, sp = 0u;
    for (;;) {
        sum = 0u; cnt = 0u; mine = 0u;
#pragma unroll
        for (unsigned j = 0; j < 16; ++j) { const unsigned c = xb_ld(&bar[XB_XCNT(j)]); sum += c; cnt += (c > 0u) ? 1u : 0u; mine = (j == x) ? c : mine; }
        if (sum == G) break;
        __builtin_amdgcn_s_sleep(1);
        if ((++sp & 255u) == 0u) { if (xb_ld(&bar[XB_TMO])) break; if (sp > XB_SPIN_CAP) { atomicAdd(&bar[XB_TMO], 1u); break; } }
    }
    nloc = mine > 0u ? mine : 1u; nx = cnt > 0u ? cnt : 1u;
}
__device__ __forceinline__ void xcd_barrier(unsigned* bar, volatile LAS unsigned* st) {
    asm volatile("s_waitcnt vmcnt(0)" ::: "memory");
    __syncthreads();
    if (threadIdx.x == 0) {
        const unsigned x = xb_xcc_id();
        __builtin_amdgcn_s_waitcnt(0);
        unsigned nloc = st[0], nx = st[1];
        if (nloc == 0u) { xcd_barrier_complete(bar, x, nloc, nx); st[0] = nloc; st[1] = nx; }
        const unsigned old = xb_add(&bar[XB_XSUB(x)], 1u);
        const unsigned gen = old / nloc;
        if (old + 1u == (gen + 1u) * nloc) {
            __builtin_amdgcn_fence(__ATOMIC_RELEASE, "agent");
            asm volatile("s_waitcnt vmcnt(0)" ::: "memory");
            const unsigned og = xb_add(&bar[XB_TOP], 1u);
            const unsigned tg = og / nx;
            if (og + 1u == (tg + 1u) * nx) xb_add(&bar[XB_TOPGEN], 1u);
            else XB_SPIN(xb_ld(&bar[XB_TOPGEN]) == tg, bar);
            __builtin_amdgcn_fence(__ATOMIC_ACQUIRE, "agent");
            xb_add(&bar[XB_XGEN(x)], 1u);
            asm volatile("s_waitcnt vmcnt(0)" ::: "memory");
        } else {
            XB_SPIN(xb_ld(&bar[XB_XGEN(x)]) == gen, bar);
            __builtin_amdgcn_fence(__ATOMIC_ACQUIRE, "agent");
            asm volatile("s_waitcnt vmcnt(0)" ::: "memory");
        }
    }
    __syncthreads();
}

__device__ __forceinline__ void tr_item(const float* __restrict__ W, int ldn, int c0, int k0, bf16_t* WT, int Kp, int r0, LAS float* scr, int lane) {
#pragma unroll 16
    for (int i = 0; i < 32; ++i) { const int kk = 2 * i + (lane >> 5); scr[kk * 33 + (lane & 31)] = W[(size_t)(k0 + kk) * ldn + c0 + (lane & 31)]; }
    LDS_WAIT();
    const int c = lane & 7;
#pragma unroll
    for (int j = 0; j < 4; ++j) { const int n = (lane >> 3) + 8 * j; const LAS float* s = scr + (8 * c) * 33 + n;
        u32x4 o; o.x = cvt_pk_bf16(s[0 * 33], s[1 * 33]); o.y = cvt_pk_bf16(s[2 * 33], s[3 * 33]); o.z = cvt_pk_bf16(s[4 * 33], s[5 * 33]); o.w = cvt_pk_bf16(s[6 * 33], s[7 * 33]);
        *(u32x4*)(WT + (size_t)(r0 + n) * Kp + k0 + 8 * c) = o; }
    LDS_WAIT();
}
__device__ __forceinline__ void rms_row_to_bf16(const float* xrow, const float* g, bf16_t* orow, int lane) {
    const f32x4* xr = (const f32x4*)xrow + lane; const f32x4* gr = (const f32x4*)g + lane;
    f32x4 v[4]; float s = 0.f;
#pragma unroll
    for (int j = 0; j < 4; ++j) { v[j] = xr[64 * j]; s += (v[j].x * v[j].x + v[j].y * v[j].y) + (v[j].z * v[j].z + v[j].w * v[j].w); }
    const float rstd = rsqrtf(wave_sum(s) * (1.f / DM) + EPSN);
    u32x2* o8 = (u32x2*)orow + lane;
#pragma unroll
    for (int j = 0; j < 4; ++j) { const f32x4 gg = gr[64 * j]; u32x2 w; w.x = cvt_pk_bf16(v[j].x * rstd * gg.x, v[j].y * rstd * gg.y); w.y = cvt_pk_bf16(v[j].z * rstd * gg.z, v[j].w * rstd * gg.w); o8[64 * j] = w; }
}
__device__ __forceinline__ void p0_prologue(KPtr p, ldsp lds, int G) {
    const int tid = fresh_tid(), lane = tid & 63, wave = __builtin_amdgcn_readfirstlane(tid >> 6);
    LAS float* scr = (LAS float*)(lds + wave * 16384);
    const int gw = blockIdx.x * 8 + wave, NGW = G * 8;
    unsigned char* ws = p->ws;
    bf16_t* W1T = (bf16_t*)(ws + WS_W1T); bf16_t* W2T = (bf16_t*)(ws + WS_W2T); bf16_t* WKVT = (bf16_t*)(ws + WS_WKVT); bf16_t* WXQT = (bf16_t*)(ws + WS_WXQT);
    bf16_t* WXOT = (bf16_t*)(ws + WS_WXOT); bf16_t* WGUT = (bf16_t*)(ws + WS_WGUT); bf16_t* WDT = (bf16_t*)(ws + WS_WDT);
    constexpr int I0 = 80 * 16, I1 = 64 * 16, I2 = 32 * 16, I3 = 32 * 32, I4 = 32 * 16, I8 = 88 * 16, I10 = 44 * 32;
    constexpr int NITEMS = I0 + I1 + I2 + I3 + 4 * I4 + 2 * I8 + I10;
    for (int it = gw; it < NITEMS; it += NGW) {
        int r = it;
        if (r < I0) { const int kb = r / 80, nb = r % 80; tr_item(p->in[11], 5656, nb * 32, kb * 64, W1T, 1024, nb * 32, scr, lane); continue; } r -= I0;
        if (r < I1) { const int kb = r / 64, nb = r % 64; tr_item(p->in[11], 5656, 2576 + nb * 32, kb * 64, W1T, 1024, 2560 + nb * 32, scr, lane); continue; } r -= I1;
        if (r < I2) { const int kb = r / 32, nb = r % 32; tr_item(p->in[11], 5656, 4632 + nb * 32, kb * 64, W1T, 1024, 4608 + nb * 32, scr, lane); continue; } r -= I2;
        if (r < I3) { const int kb = r / 32, nb = r % 32; tr_item(p->in[21], 1024, nb * 32, kb * 64, W2T, 2048, nb * 32, scr, lane); continue; } r -= I3;
        if (r < I4) { const int kb = r / 32, nb = r % 32; tr_item(p->in[24], 1024, nb * 32, kb * 64, WKVT, 1024, nb * 32, scr, lane); continue; } r -= I4;
        if (r < I4) { const int kb = r / 32, nb = r % 32; tr_item(p->in[25], 1024, nb * 32, kb * 64, WKVT, 1024, 1024 + nb * 32, scr, lane); continue; } r -= I4;
        if (r < I4) { const int kb = r / 32, nb = r % 32; tr_item(p->in[27], 1024, nb * 32, kb * 64, WXQT, 1024, nb * 32, scr, lane); continue; } r -= I4;
        if (r < I4) { const int kb = r / 32, nb = r % 32; tr_item(p->in[28], 1024, nb * 32, kb * 64, WXOT, 1024, nb * 32, scr, lane); continue; } r -= I4;
        if (r < I8) { const int kb = r / 88, nb = r % 88, n0 = nb * 32; tr_item(p->in[31], FFH, n0, kb * 64, WGUT, 1024, 256 * (n0 >> 7) + (n0 & 127), scr, lane); continue; } r -= I8;
        if (r < I8) { const int kb = r / 88, nb = r % 88, n0 = nb * 32; tr_item(p->in[32], FFH, n0, kb * 64, WGUT, 1024, 256 * (n0 >> 7) + (n0 & 127) + 128, scr, lane); continue; } r -= I8;
        { const int kb = r / 32, nb = r % 32; tr_item(p->in[33], 1024, nb * 32, kb * 64, WDT, FFH, nb * 32, scr, lane); }
    }
    for (int idx = blockIdx.x * 512 + tid; idx < 256 * 1024; idx += G * 512) { const int j = idx >> 10, k = idx & 1023; float v = 0.f;
        if (j < 16) v = p->in[11][(size_t)k * 5656 + 2560 + j]; else if (j < 24) v = p->in[11][(size_t)k * 5656 + 4624 + (j - 16)];
        W1T[(size_t)(5632 + j) * 1024 + k] = f2bf(v); }
    bf16_t* U = (bf16_t*)(ws + WS_U); bf16_t* UM = (bf16_t*)(ws + WS_UM);
    for (int r = gw; r < MT + NMEMROWS; r += NGW) {
        if (r < MP) rms_row_to_bf16(p->in[0] + (size_t)r * DM, p->in[10], U + (size_t)r * DM, lane);
        else if (r < MT) rms_row_to_bf16(p->in[1] + (size_t)(r - MP) * DM, p->in[10], U + (size_t)r * DM, lane);
        else rms_row_to_bf16(p->in[2] + (size_t)(r - MT) * DM, p->in[23], UM + (size_t)(r - MT) * DM, lane);
    }
}

__device__ __forceinline__ void conv_phase(KPtr p, int G) {
    const bf16_t* PROJ = (const bf16_t*)(p->ws + WS_BIG); bf16_t* XBC = (bf16_t*)(p->ws + WS_XBC);
    const float* cw = p->in[12]; const float* cb = p->in[13]; const float* sconv = p->in[4];
    const int NIT = (MT / 8) * 192;
    for (int it = blockIdx.x * 512 + fresh_tid(); it < NIT; it += G * 512) {
        const int rg = it / 192, cg8 = it % 192, c0 = cg8 * 8, r0 = rg * 8;
        const bool samp = r0 >= MP; const int tl0 = samp ? 0 : (r0 & 2047);
        float win[11][8];
#pragma unroll
        for (int i = 0; i < 11; ++i) {
            const int rr = i - 3;
            if (rr >= 0 || tl0 > 0) { const u32x4 w = *(const u32x4*)(PROJ + (size_t)(r0 + rr) * PROJ_LD + 1024 + c0);
                win[i][0] = bflo(w.x); win[i][1] = bfhi(w.x); win[i][2] = bflo(w.y); win[i][3] = bfhi(w.y); win[i][4] = bflo(w.z); win[i][5] = bfhi(w.z); win[i][6] = bflo(w.w); win[i][7] = bfhi(w.w); }
            else if (samp) { const int b = (r0 - MP) >> 3; const float* sp = sconv + ((size_t)b * 3 + i) * XBC_LD + c0; const f32x4 a = *(const f32x4*)sp, bq = *(const f32x4*)(sp + 4);
                win[i][0] = a.x; win[i][1] = a.y; win[i][2] = a.z; win[i][3] = a.w; win[i][4] = bq.x; win[i][5] = bq.y; win[i][6] = bq.z; win[i][7] = bq.w; }
            else {
#pragma unroll
                for (int e = 0; e < 8; ++e) win[i][e] = 0.f; }
        }
        float w4[4][8], bb[8];
#pragma unroll
        for (int j = 0; j < 4; ++j) { const f32x4 a = *(const f32x4*)(cw + j * XBC_LD + c0), bq = *(const f32x4*)(cw + j * XBC_LD + c0 + 4);
            w4[j][0] = a.x; w4[j][1] = a.y; w4[j][2] = a.z; w4[j][3] = a.w; w4[j][4] = bq.x; w4[j][5] = bq.y; w4[j][6] = bq.z; w4[j][7] = bq.w; }
        { const f32x4 a = *(const f32x4*)(cb + c0), bq = *(const f32x4*)(cb + c0 + 4); bb[0] = a.x; bb[1] = a.y; bb[2] = a.z; bb[3] = a.w; bb[4] = bq.x; bb[5] = bq.y; bb[6] = bq.z; bb[7] = bq.w; }
#pragma unroll
        for (int t = 0; t < 8; ++t) { float y[8];
#pragma unroll
            for (int e = 0; e < 8; ++e) { float a = bb[e];
#pragma unroll
                for (int j = 0; j < 4; ++j) a += win[t + j][e] * w4[j][e];
                y[e] = siluf(a); }
            u32x4 w; w.x = cvt_pk_bf16(y[0], y[1]); w.y = cvt_pk_bf16(y[2], y[3]); w.z = cvt_pk_bf16(y[4], y[5]); w.w = cvt_pk_bf16(y[6], y[7]);
            *(u32x4*)(XBC + (size_t)(r0 + t) * XBC_LD + c0) = w; }
        if (samp || tl0 + 8 == 2048) {
            float* dst = samp ? (p->out + O_CONVS + (size_t)((r0 - MP) >> 3) * 3 * XBC_LD) : (p->out + O_CONVP + (size_t)(r0 >> 11) * 3 * XBC_LD);
#pragma unroll
            for (int i = 0; i < 3; ++i) { *(f32x4*)(dst + (size_t)i * XBC_LD + c0) = (f32x4){win[8 + i][0], win[8 + i][1], win[8 + i][2], win[8 + i][3]};
                *(f32x4*)(dst + (size_t)i * XBC_LD + c0 + 4) = (f32x4){win[8 + i][4], win[8 + i][5], win[8 + i][6], win[8 + i][7]}; }
        }
    }
}

#define MFMA16(a, b, c) __builtin_amdgcn_mfma_f32_16x16x32_bf16(a, b, c, 0, 0, 0)
#define LBAR() do { asm volatile("s_waitcnt lgkmcnt(0)" ::: "memory"); __builtin_amdgcn_s_barrier(); asm volatile("" ::: "memory"); } while (0)
#define LDSF(off) (*(LAS float*)(lds + (off)))
#define LDSH(off) (*(LAS unsigned short*)(lds + (off)))
#define LDSV8(off) (*(const LAS bf16x8*)(lds + (off)))

constexpr int SP_CM = 0, SP_BM = 17408, SP_BMT = 34816, SP_XT = 53248, SP_WM = 62464, SP_HB = 71680, SP_DT = 89088, SP_CUM = 89344;
__device__ __forceinline__ void ssd_prompt_unit(KPtr p, ldsp lds, int b, int h) {
    const int tid = fresh_tid(), lane = tid & 63, wid = __builtin_amdgcn_readfirstlane(tid >> 6), l15 = lane & 15, quad = lane >> 4;
    const int g = h >> 3, tq = wid >> 1, half = wid & 1;
    const bf16_t* XBC = (const bf16_t*)(p->ws + WS_XBC); const bf16_t* PROJ = (const bf16_t*)(p->ws + WS_BIG); const float* GATES = (const float*)(p->ws + WS_GATES);
    bf16_t* YPRE = (bf16_t*)(p->ws + WS_YPRE);
    const float dtb = p->in[14][h], aneg = -__expf(p->in[15][h]), dsk = p->in[16][h];
    const size_t rowbase = (size_t)b * 2048;
    for (int i = tid; i < 17408 / 4; i += 512) *(LAS unsigned*)(lds + SP_HB + i * 4) = 0u;
    f32x4 Hst[4];
#pragma unroll
    for (int i = 0; i < 4; ++i) Hst[i] = (f32x4){0.f, 0.f, 0.f, 0.f};
    u32x4 pa[3], pb[3]; float dtraw = 0.f;
    int spr[3], sgrp[3];
#pragma unroll
    for (int i = 0; i < 3; ++i) { int v = (i < 2) ? tid + 512 * i : (tid >= 256 ? tid + 768 : 1279); spr[i] = v & 31; sgrp[i] = v >> 5; }
#define SSD_COL(gi) ((gi) < 8 ? h * 64 + (gi) * 8 : ((gi) < 24 ? 1024 + g * 128 + ((gi) - 8) * 8 : 1280 + g * 128 + ((gi) - 24) * 8))
#pragma unroll
    for (int i = 0; i < 3; ++i) { const bf16_t* src_ = XBC + (rowbase + 2 * spr[i]) * XBC_LD + SSD_COL(sgrp[i]); pa[i] = *(const u32x4*)src_; pb[i] = *(const u32x4*)(src_ + XBC_LD); }
    if (wid == 0) dtraw = GATES[(rowbase + lane) * 32 + h];
    for (int ch = 0; ch < 32; ++ch) {
        const size_t crow = rowbase + (size_t)ch * 64;
        if (wid == 0) { const float dt = softplusf(dtraw + dtb); float cum = dt * aneg;
#pragma unroll
            for (int o = 1; o < 64; o <<= 1) { const float t2 = __shfl_up(cum, o); if (lane >= o) cum += t2; }
            LDSF(SP_DT + lane * 4) = dt; LDSF(SP_CUM + lane * 4) = cum; }
        LBAR();
        const float cum63 = LDSF(SP_CUM + 63 * 4);
#pragma unroll
        for (int i = 0; i < 3; ++i) { if (i < 2 || tid >= 256) { const int gi = sgrp[i], sp = spr[i]; const unsigned wa[4] = {pa[i].x, pa[i].y, pa[i].z, pa[i].w}, wb[4] = {pb[i].x, pb[i].y, pb[i].z, pb[i].w};
            if (gi < 8) { const int p0 = gi * 8;
#pragma unroll
                for (int e = 0; e < 4; ++e) { *(LAS unsigned*)(lds + SP_XT + (p0 + 2 * e) * 144 + sp * 4) = (wa[e] & 0xffffu) | (wb[e] << 16); *(LAS unsigned*)(lds + SP_XT + (p0 + 2 * e + 1) * 144 + sp * 4) = (wa[e] >> 16) | (wb[e] & 0xffff0000u); } }
            else if (gi < 24) { const int n0 = (gi - 8) * 8; *(LAS u32x4*)(lds + SP_BM + (2 * sp) * 272 + n0 * 2) = pa[i]; *(LAS u32x4*)(lds + SP_BM + (2 * sp + 1) * 272 + n0 * 2) = pb[i];
                const f32x2 cs = *(const LAS f32x2*)(lds + SP_CUM + sp * 8), ds = *(const LAS f32x2*)(lds + SP_DT + sp * 8);
                const float wea = __expf(cum63 - cs.x) * ds.x, web = __expf(cum63 - cs.y) * ds.y;
#pragma unroll
                for (int e = 0; e < 4; ++e) { *(LAS unsigned*)(lds + SP_BMT + (n0 + 2 * e) * 144 + sp * 4) = cvt_pk_bf16(bflo(wa[e]) * wea, bflo(wb[e]) * web); *(LAS unsigned*)(lds + SP_BMT + (n0 + 2 * e + 1) * 144 + sp * 4) = cvt_pk_bf16(bfhi(wa[e]) * wea, bfhi(wb[e]) * web); } }
            else { *(LAS u32x4*)(lds + SP_CM + (2 * sp) * 272 + (gi - 24) * 16) = pa[i]; *(LAS u32x4*)(lds + SP_CM + (2 * sp + 1) * 272 + (gi - 24) * 16) = pb[i]; } } }
        if (ch + 1 < 32) {
#pragma unroll
            for (int i = 0; i < 3; ++i) { const bf16_t* src_ = XBC + (crow + 64 + 2 * spr[i]) * XBC_LD + SSD_COL(sgrp[i]); pa[i] = *(const u32x4*)src_; pb[i] = *(const u32x4*)(src_ + XBC_LD); }
            if (wid == 0) dtraw = GATES[(crow + 64 + lane) * 32 + h];
        }
        const int t = tq * 16 + l15;
        u32x2 zr[2];
#pragma unroll
        for (int pt2 = 0; pt2 < 2; ++pt2) zr[pt2] = *(const u32x2*)(PROJ + (crow + t) * PROJ_LD + h * 64 + (2 * half + pt2) * 16 + quad * 4);
        LBAR();
        const float cum_t = LDSF(SP_CUM + t * 4);
        {
            f32x4 cbv[2] = {(f32x4){0.f, 0.f, 0.f, 0.f}, (f32x4){0.f, 0.f, 0.f, 0.f}};
#pragma unroll
            for (int ks = 0; ks < 4; ++ks) { const bf16x8 bfr = LDSV8(SP_CM + t * 272 + ks * 64 + quad * 16);
#pragma unroll
                for (int s2 = 0; s2 < 2; ++s2) { const bf16x8 afr = LDSV8(SP_BM + ((2 * half + s2) * 16 + l15) * 272 + ks * 64 + quad * 16); cbv[s2] = MFMA16(afr, bfr, cbv[s2]); } }
#pragma unroll
            for (int s2 = 0; s2 < 2; ++s2) { const int s0 = (2 * half + s2) * 16 + quad * 4; const f32x4 cs = *(const LAS f32x4*)(lds + SP_CUM + s0 * 4), ds = *(const LAS f32x4*)(lds + SP_DT + s0 * 4);
                float wv[4];
#pragma unroll
                for (int j = 0; j < 4; ++j) wv[j] = (s0 + j <= t) ? cbv[s2][j] * __expf(cum_t - cs[j]) * ds[j] : 0.f;
                u32x2 o; o.x = cvt_pk_bf16(wv[0], wv[1]); o.y = cvt_pk_bf16(wv[2], wv[3]); *(LAS u32x2*)(lds + SP_WM + t * 144 + s0 * 2) = o; }
        }
        LBAR();
        {
            f32x4 ya[2] = {(f32x4){0.f, 0.f, 0.f, 0.f}, (f32x4){0.f, 0.f, 0.f, 0.f}};
#pragma unroll
            for (int ks = 0; ks < 4; ++ks) { const bf16x8 bfr = LDSV8(SP_CM + t * 272 + ks * 64 + quad * 16);
#pragma unroll
                for (int p2 = 0; p2 < 2; ++p2) { const bf16x8 afr = LDSV8(SP_HB + ((2 * half + p2) * 16 + l15) * 272 + ks * 64 + quad * 16); ya[p2] = MFMA16(afr, bfr, ya[p2]); } }
            const float ec = __expf(cum_t); ya[0] = ya[0] * ec; ya[1] = ya[1] * ec;
#pragma unroll
            for (int ks = 0; ks < 2; ++ks) { const bf16x8 bfr = LDSV8(SP_WM + t * 144 + ks * 64 + quad * 16);
#pragma unroll
                for (int p2 = 0; p2 < 2; ++p2) { const bf16x8 afr = LDSV8(SP_XT + ((2 * half + p2) * 16 + l15) * 144 + ks * 64 + quad * 16); ya[p2] = MFMA16(afr, bfr, ya[p2]); } }
#pragma unroll
            for (int p2 = 0; p2 < 2; ++p2) { const int p0 = (2 * half + p2) * 16 + quad * 4; float yv[4]; const float zz[4] = {bflo(zr[p2].x), bfhi(zr[p2].x), bflo(zr[p2].y), bfhi(zr[p2].y)};
#pragma unroll
                for (int j = 0; j < 4; ++j) { const float xv = bf2f(LDSH(SP_XT + (p0 + j) * 144 + t * 2)); yv[j] = (ya[p2][j] + dsk * xv) * siluf(zz[j]); }
                u32x2 o; o.x = cvt_pk_bf16(yv[0], yv[1]); o.y = cvt_pk_bf16(yv[2], yv[3]); *(u32x2*)(YPRE + (crow + t) * YP_LD + h * 64 + p0) = o; }
        }
        {
            const float eend = __expf(cum63);
#pragma unroll
            for (int i = 0; i < 4; ++i) Hst[i] = Hst[i] * eend;
#pragma unroll
            for (int ks = 0; ks < 2; ++ks) { const bf16x8 afr = LDSV8(SP_BMT + (wid * 16 + l15) * 144 + ks * 64 + quad * 16);
#pragma unroll
                for (int pt = 0; pt < 4; ++pt) { const bf16x8 bfr = LDSV8(SP_XT + (pt * 16 + l15) * 144 + ks * 64 + quad * 16); Hst[pt] = MFMA16(afr, bfr, Hst[pt]); } }
        }
        LBAR();
#pragma unroll
        for (int pt = 0; pt < 4; ++pt) { u32x2 o; o.x = cvt_pk_bf16(Hst[pt][0], Hst[pt][1]); o.y = cvt_pk_bf16(Hst[pt][2], Hst[pt][3]);
            *(LAS u32x2*)(lds + SP_HB + (pt * 16 + l15) * 272 + (wid * 16 + quad * 4) * 2) = o; }
    }
    float* so = p->out + O_SSMP + (size_t)(b * 16 + h) * 64 * 128;
#pragma unroll
    for (int pt = 0; pt < 4; ++pt) *(f32x4*)(so + (size_t)(pt * 16 + l15) * 128 + wid * 16 + quad * 4) = Hst[pt];
    __syncthreads();
}

constexpr int ML_QM = 0, ML_KM = 17408, ML_KMT = 34816, ML_VT = 53248, ML_SM = 64768, ML_CBT = 73984, ML_AV = 95744, ML_MV = 96000, ML_EM = 96256, ML_SI = 96512, ML_SC = 96768;
__device__ __forceinline__ void mlstm_prompt_unit(KPtr p, ldsp lds, int b, int head, int vq) {
    const int tid = fresh_tid(), lane = tid & 63, wid = __builtin_amdgcn_readfirstlane(tid >> 6), l15 = lane & 15, quad = lane >> 4;
    const int tq = wid >> 1, half = wid & 1;
    const bf16_t* PROJ = (const bf16_t*)(p->ws + WS_BIG); const float* GATES = (const float*)(p->ws + WS_GATES); bf16_t* YPRE = (bf16_t*)(p->ws + WS_YPRE);
    const float bi = p->in[18][head], bfg = p->in[19][head];
    const float qscale = 0.08838834764831845f;
    const size_t rowbase = (size_t)b * 2048;
    for (int i = tid; i < 21760 / 4; i += 512) *(LAS unsigned*)(lds + ML_CBT + i * 4) = 0u;
    for (int i = tid; i < 16 * 144 / 4; i += 512) { const int off = i * 4; *(LAS unsigned*)(lds + ML_VT + 64 * 144 + off) = (off < 128) ? 0x3F803F80u : 0u; }
    f32x4 Cst[5];
#pragma unroll
    for (int i = 0; i < 5; ++i) Cst[i] = (f32x4){0.f, 0.f, 0.f, 0.f};
    float mprev = 0.f, igr = 0.f, fgr = 0.f;
    u32x4 pa[3], pb[3]; int spr[3], sgrp[3];
#pragma unroll
    for (int i = 0; i < 3; ++i) { int v = (i < 2) ? tid + 512 * i : (tid >= 256 ? tid + 768 : 1279); spr[i] = v & 31; sgrp[i] = v >> 5; }
#define ML_COL(gi) ((gi) < 16 ? 2560 + head * 128 + (gi) * 8 : ((gi) < 32 ? 3072 + head * 128 + ((gi) - 16) * 8 : 3584 + head * 256 + vq * 64 + ((gi) - 32) * 8))
#pragma unroll
    for (int i = 0; i < 3; ++i) { const bf16_t* src_ = PROJ + (rowbase + 2 * spr[i]) * PROJ_LD + ML_COL(sgrp[i]); pa[i] = *(const u32x4*)src_; pb[i] = *(const u32x4*)(src_ + PROJ_LD); }
    if (wid == 0) { igr = GATES[(rowbase + lane) * 32 + 16 + head]; fgr = GATES[(rowbase + lane) * 32 + 20 + head]; }
    for (int ch = 0; ch < 32; ++ch) {
        const size_t crow = rowbase + (size_t)ch * 64;
        if (wid == 0) {
            const float iv = igr + bi, x = fgr + bfg; const float logf = fminf(x, 0.f) - __logf(1.f + __expf(-fabsf(x)));
            float bc = logf;
#pragma unroll
            for (int o = 1; o < 64; o <<= 1) { const float t2 = __shfl_up(bc, o); if (lane >= o) bc += t2; }
            const float a = iv - bc; float pm = a;
#pragma unroll
            for (int o = 1; o < 64; o <<= 1) { const float t2 = __shfl_up(pm, o); if (lane >= o) pm = fmaxf(pm, t2); }
            const float M = fmaxf(pm, mprev);
            LDSF(ML_AV + lane * 4) = a; LDSF(ML_MV + lane * 4) = M; LDSF(ML_EM + lane * 4) = __expf(-(bc + M)); LDSF(ML_SI + lane * 4) = __expf(mprev - M) * qscale;
            const float M63 = __shfl(M, 63), bc63 = __shfl(bc, 63);
            if (lane == 0) { LDSF(ML_SC) = M63; LDSF(ML_SC + 4) = __expf(mprev - M63); }
            mprev = bc63 + M63;
        }
        LBAR();
        const float M63 = LDSF(ML_SC), scaleC = LDSF(ML_SC + 4);
#pragma unroll
        for (int i = 0; i < 3; ++i) { if (i < 2 || tid >= 256) { const int gi = sgrp[i], sp = spr[i]; const unsigned wa[4] = {pa[i].x, pa[i].y, pa[i].z, pa[i].w}, wb[4] = {pb[i].x, pb[i].y, pb[i].z, pb[i].w};
            if (gi < 16) { *(LAS u32x4*)(lds + ML_QM + (2 * sp) * 272 + gi * 16) = pa[i]; *(LAS u32x4*)(lds + ML_QM + (2 * sp + 1) * 272 + gi * 16) = pb[i]; }
            else if (gi < 32) { const int d0 = (gi - 16) * 8; *(LAS u32x4*)(lds + ML_KM + (2 * sp) * 272 + d0 * 2) = pa[i]; *(LAS u32x4*)(lds + ML_KM + (2 * sp + 1) * 272 + d0 * 2) = pb[i];
                const f32x2 av = *(const LAS f32x2*)(lds + ML_AV + sp * 8); const float wea = __expf(av.x - M63), web = __expf(av.y - M63);
#pragma unroll
                for (int e = 0; e < 4; ++e) { *(LAS unsigned*)(lds + ML_KMT + (d0 + 2 * e) * 144 + sp * 4) = cvt_pk_bf16(bflo(wa[e]) * wea, bflo(wb[e]) * web); *(LAS unsigned*)(lds + ML_KMT + (d0 + 2 * e + 1) * 144 + sp * 4) = cvt_pk_bf16(bfhi(wa[e]) * wea, bfhi(wb[e]) * web); } }
            else { const int v0 = (gi - 32) * 8;
#pragma unroll
                for (int e = 0; e < 4; ++e) { *(LAS unsigned*)(lds + ML_VT + (v0 + 2 * e) * 144 + sp * 4) = (wa[e] & 0xffffu) | (wb[e] << 16); *(LAS unsigned*)(lds + ML_VT + (v0 + 2 * e + 1) * 144 + sp * 4) = (wa[e] >> 16) | (wb[e] & 0xffff0000u); } } } }
        if (ch + 1 < 32) {
#pragma unroll
            for (int i = 0; i < 3; ++i) { const bf16_t* src_ = PROJ + (crow + 64 + 2 * spr[i]) * PROJ_LD + ML_COL(sgrp[i]); pa[i] = *(const u32x4*)src_; pb[i] = *(const u32x4*)(src_ + PROJ_LD); }
            if (wid == 0) { igr = GATES[(crow + 64 + lane) * 32 + 16 + head]; fgr = GATES[(crow + 64 + lane) * 32 + 20 + head]; }
        }
        LBAR();
        const int t = tq * 16 + l15;
        const float M_t = LDSF(ML_MV + t * 4);
        {
            f32x4 sv[2] = {(f32x4){0.f, 0.f, 0.f, 0.f}, (f32x4){0.f, 0.f, 0.f, 0.f}};
#pragma unroll
            for (int ks = 0; ks < 4; ++ks) { const bf16x8 bfr = LDSV8(ML_QM + t * 272 + ks * 64 + quad * 16);
#pragma unroll
                for (int s2 = 0; s2 < 2; ++s2) { const bf16x8 afr = LDSV8(ML_KM + ((2 * half + s2) * 16 + l15) * 272 + ks * 64 + quad * 16); sv[s2] = MFMA16(afr, bfr, sv[s2]); } }
#pragma unroll
            for (int s2 = 0; s2 < 2; ++s2) { const int s0 = (2 * half + s2) * 16 + quad * 4; const f32x4 as = *(const LAS f32x4*)(lds + ML_AV + s0 * 4); float wv[4];
#pragma unroll
                for (int j = 0; j < 4; ++j) wv[j] = (s0 + j <= t) ? sv[s2][j] * qscale * __expf(as[j] - M_t) : 0.f;
                u32x2 o; o.x = cvt_pk_bf16(wv[0], wv[1]); o.y = cvt_pk_bf16(wv[2], wv[3]); *(LAS u32x2*)(lds + ML_SM + t * 144 + s0 * 2) = o; }
        }
        LBAR();
        {
            f32x4 na[3] = {(f32x4){0.f, 0.f, 0.f, 0.f}, (f32x4){0.f, 0.f, 0.f, 0.f}, (f32x4){0.f, 0.f, 0.f, 0.f}};
#pragma unroll
            for (int ks = 0; ks < 4; ++ks) { const bf16x8 bfr = LDSV8(ML_QM + t * 272 + ks * 64 + quad * 16);
#pragma unroll
                for (int v2 = 0; v2 < 3; ++v2) { const int vt = v2 < 2 ? 2 * half + v2 : 4; const bf16x8 afr = LDSV8(ML_CBT + (vt * 16 + l15) * 272 + ks * 64 + quad * 16); na[v2] = MFMA16(afr, bfr, na[v2]); } }
            const float si = LDSF(ML_SI + t * 4);
#pragma unroll
            for (int v2 = 0; v2 < 3; ++v2) na[v2] = na[v2] * si;
#pragma unroll
            for (int ks = 0; ks < 2; ++ks) { const bf16x8 bfr = LDSV8(ML_SM + t * 144 + ks * 64 + quad * 16);
#pragma unroll
                for (int v2 = 0; v2 < 3; ++v2) { const int vt = v2 < 2 ? 2 * half + v2 : 4; const bf16x8 afr = LDSV8(ML_VT + (vt * 16 + l15) * 144 + ks * 64 + quad * 16); na[v2] = MFMA16(afr, bfr, na[v2]); } }
            const float den = __shfl(na[2][0], l15);
            const float dn = __builtin_amdgcn_rcpf(fmaxf(fabsf(den), LDSF(ML_EM + t * 4)));
#pragma unroll
            for (int v2 = 0; v2 < 2; ++v2) { const int v0 = (2 * half + v2) * 16 + quad * 4; u32x2 o; o.x = cvt_pk_bf16(na[v2][0] * dn, na[v2][1] * dn); o.y = cvt_pk_bf16(na[v2][2] * dn, na[v2][3] * dn);
                *(u32x2*)(YPRE + (crow + t) * YP_LD + 1024 + head * 256 + vq * 64 + v0) = o; }
        }
        {
#pragma unroll
            for (int i = 0; i < 5; ++i) Cst[i] = Cst[i] * scaleC;
#pragma unroll
            for (int ks = 0; ks < 2; ++ks) { const bf16x8 afr = LDSV8(ML_KMT + (wid * 16 + l15) * 144 + ks * 64 + quad * 16);
#pragma unroll
                for (int vt = 0; vt < 5; ++vt) { const bf16x8 bfr = LDSV8(ML_VT + (vt * 16 + l15) * 144 + ks * 64 + quad * 16); Cst[vt] = MFMA16(afr, bfr, Cst[vt]); } }
        }
        LBAR();
#pragma unroll
        for (int vt = 0; vt < 5; ++vt) { u32x2 o; o.x = cvt_pk_bf16(Cst[vt][0], Cst[vt][1]); o.y = cvt_pk_bf16(Cst[vt][2], Cst[vt][3]);
            *(LAS u32x2*)(lds + ML_CBT + (vt * 16 + l15) * 272 + (wid * 16 + quad * 4) * 2) = o; }
    }
    float* co = p->out + O_MCP + (size_t)(b * 4 + head) * 128 * 256;
#pragma unroll
    for (int vt = 0; vt < 4; ++vt)
#pragma unroll
        for (int j = 0; j < 4; ++j) co[(size_t)(wid * 16 + quad * 4 + j) * 256 + vq * 64 + vt * 16 + l15] = Cst[vt][j];
    if (vq == 0) {
        if (l15 == 0) *(f32x4*)(p->out + O_MNP + (size_t)(b * 4 + head) * 128 + wid * 16 + quad * 4) = Cst[4];
        if (tid == 0) p->out[O_MMP + b * 4 + head] = mprev;
    }
    __syncthreads();
}

constexpr int SS_X = 0, SS_B = 2048, SS_C = 6272, SS_DT = 10496, SS_CUM = 10528, SS_W = 10560;
__device__ __forceinline__ void ssd_sample_unit(KPtr p, ldsp lds, int b, int h) {
    const int tid = fresh_tid(); const int g = h >> 3;
    const bf16_t* XBC = (const bf16_t*)(p->ws + WS_XBC); const bf16_t* PROJ = (const bf16_t*)(p->ws + WS_BIG); const float* GATES = (const float*)(p->ws + WS_GATES); bf16_t* YPRE = (bf16_t*)(p->ws + WS_YPRE);
    const float dtb = p->in[14][h], aneg = -__expf(p->in[15][h]), dsk = p->in[16][h];
    const size_t r0 = (size_t)MP + (size_t)b * 8;
    const int pp = tid >> 3, ns = tid & 7;
    const float* hp = p->in[3] + ((size_t)(b * 16 + h) * 64 + pp) * 128 + ns * 16;
    f32x4 h0[4];
#pragma unroll
    for (int i = 0; i < 4; ++i) h0[i] = *(const f32x4*)(hp + 4 * i);
    if (tid < 320) {
        const int kind = tid < 64 ? 0 : (tid < 192 ? 1 : 2), i = kind == 0 ? tid : (kind == 1 ? tid - 64 : tid - 192);
        const int t = kind == 0 ? (i >> 3) : (i >> 4), c8 = kind == 0 ? (i & 7) * 8 : (i & 15) * 8;
        const int col = kind == 0 ? h * 64 + c8 : (kind == 1 ? 1024 : 1280) + g * 128 + c8;
        const int off = kind == 0 ? SS_X + (t * 64 + c8) * 4 : (kind == 1 ? SS_B : SS_C) + (t * 132 + c8) * 4;
        const u32x4 w = *(const u32x4*)(XBC + (r0 + t) * XBC_LD + col);
        *(LAS f32x4*)(lds + off) = (f32x4){bflo(w.x), bfhi(w.x), bflo(w.y), bfhi(w.y)}; *(LAS f32x4*)(lds + off + 16) = (f32x4){bflo(w.z), bfhi(w.z), bflo(w.w), bfhi(w.w)}; }
    if (tid < 8) LDSF(SS_DT + tid * 4) = softplusf(GATES[(r0 + tid) * 32 + h] + dtb);
    const float zv = bf2f(PROJ[(r0 + ns) * PROJ_LD + h * 64 + pp]);
    __syncthreads();
    if (tid < 8) { float c = 0.f; for (int u = 0; u <= tid; ++u) c += LDSF(SS_DT + u * 4) * aneg; LDSF(SS_CUM + tid * 4) = c; }
    __syncthreads();
    if (tid < 64) { const int t = tid >> 3, s = tid & 7; float cbv = 0.f;
        for (int n = 0; n < 128; ++n) cbv += LDSF(SS_C + (t * 132 + n) * 4) * LDSF(SS_B + (s * 132 + n) * 4);
        LDSF(SS_W + tid * 4) = (s <= t) ? cbv * __expf(LDSF(SS_CUM + t * 4) - LDSF(SS_CUM + s * 4)) * LDSF(SS_DT + s * 4) : 0.f; }
    float part[8];
#pragma unroll
    for (int t = 0; t < 8; ++t) { float a = 0.f;
#pragma unroll
        for (int i = 0; i < 4; ++i) { const f32x4 cv = *(const LAS f32x4*)(lds + SS_C + (t * 132 + ns * 16 + i * 4) * 4); a += cv.x * h0[i].x + cv.y * h0[i].y + cv.z * h0[i].z + cv.w * h0[i].w; }
        a += __shfl_xor(a, 1); a += __shfl_xor(a, 2); a += __shfl_xor(a, 4); part[t] = a; }
    __syncthreads();
    {
        float yi = part[0];
#pragma unroll
        for (int t = 1; t < 8; ++t) yi = (ns == t) ? part[t] : yi;
        const int t = ns; float y = yi * __expf(LDSF(SS_CUM + t * 4));
#pragma unroll
        for (int s = 0; s < 8; ++s) y += LDSF(SS_W + (t * 8 + s) * 4) * LDSF(SS_X + (s * 64 + pp) * 4);
        y += dsk * LDSF(SS_X + (t * 64 + pp) * 4);
        YPRE[(r0 + t) * YP_LD + h * 64 + pp] = f2bf(y * siluf(zv));
    }
    const float cum7 = LDSF(SS_CUM + 7 * 4), e7 = __expf(cum7);
    f32x4 hn[4];
#pragma unroll
    for (int i = 0; i < 4; ++i) hn[i] = h0[i] * e7;
#pragma unroll
    for (int s = 0; s < 8; ++s) { const float wx = __expf(cum7 - LDSF(SS_CUM + s * 4)) * LDSF(SS_DT + s * 4) * LDSF(SS_X + (s * 64 + pp) * 4);
#pragma unroll
        for (int i = 0; i < 4; ++i) { const f32x4 bv = *(const LAS f32x4*)(lds + SS_B + (s * 132 + ns * 16 + i * 4) * 4); hn[i] = hn[i] + bv * wx; } }
    float* ho = p->out + O_SSMS + ((size_t)(b * 16 + h) * 64 + pp) * 128 + ns * 16;
#pragma unroll
    for (int i = 0; i < 4; ++i) *(f32x4*)(ho + 4 * i) = hn[i];
    __syncthreads();
}

constexpr int MS_Q = 0, MS_K = 4224, MS_V = 8448, MS_I = 12544, MS_LF = 12576, MS_A = 12608, MS_M = 12640, MS_EM = 12672, MS_SI = 12704, MS_WE = 12736, MS_DEN = 12768, MS_SC = 12800, MS_S = 12864, MS_N0 = 13120, MS_RED = 16384;
__device__ __forceinline__ void mlstm_sample_unit(KPtr p, ldsp lds, int b, int head, int vh) {
    const int tid = fresh_tid(), lane = tid & 63, wid = __builtin_amdgcn_readfirstlane(tid >> 6);
    const bf16_t* PROJ = (const bf16_t*)(p->ws + WS_BIG); const float* GATES = (const float*)(p->ws + WS_GATES); bf16_t* YPRE = (bf16_t*)(p->ws + WS_YPRE);
    const float bi = p->in[18][head], bfg = p->in[19][head]; const float qscale = 0.08838834764831845f;
    const size_t r0 = (size_t)MP + (size_t)b * 8;
    const float mprev = p->in[7][b * 4 + head];
    const int dsg = tid >> 5, vq4 = tid & 31;
    const float* cp = p->in[5] + ((size_t)(b * 4 + head) * 128 + dsg * 8) * 256 + vh * 128 + vq4 * 4;
    f32x4 Cr[8];
#pragma unroll
    for (int i = 0; i < 8; ++i) Cr[i] = *(const f32x4*)(cp + (size_t)i * 256);
    if (tid < 384) {
        const int kind = tid >> 7, i = tid & 127, t = i >> 4, c8 = (i & 15) * 8;
        const int col = kind == 0 ? 2560 + head * 128 + c8 : (kind == 1 ? 3072 + head * 128 + c8 : 3584 + head * 256 + vh * 128 + c8);
        const int off = (kind == 0 ? MS_Q : (kind == 1 ? MS_K : MS_V)) + (t * (kind == 2 ? 128 : 132) + c8) * 4; const float sc = kind == 0 ? qscale : 1.f;
        const u32x4 w = *(const u32x4*)(PROJ + (r0 + t) * PROJ_LD + col);
        *(LAS f32x4*)(lds + off) = (f32x4){bflo(w.x), bfhi(w.x), bflo(w.y), bfhi(w.y)} * sc; *(LAS f32x4*)(lds + off + 16) = (f32x4){bflo(w.z), bfhi(w.z), bflo(w.w), bfhi(w.w)} * sc; }
    if (tid < 128) LDSF(MS_N0 + tid * 4) = p->in[6][(size_t)(b * 4 + head) * 128 + tid];
    if (tid < 8) { const float x = GATES[(r0 + tid) * 32 + 20 + head] + bfg; LDSF(MS_I + tid * 4) = GATES[(r0 + tid) * 32 + 16 + head] + bi;
        LDSF(MS_LF + tid * 4) = fminf(x, 0.f) - __logf(1.f + __expf(-fabsf(x))); }
    __syncthreads();
    if (tid < 8) { float bc = 0.f, am = -3.0e38f, a = 0.f;
        for (int s = 0; s <= tid; ++s) { bc += LDSF(MS_LF + s * 4); a = LDSF(MS_I + s * 4) - bc; am = fmaxf(am, a); }
        const float M = fmaxf(am, mprev);
        LDSF(MS_A + tid * 4) = a; LDSF(MS_M + tid * 4) = M; LDSF(MS_EM + tid * 4) = __expf(-(bc + M)); LDSF(MS_SI + tid * 4) = __expf(mprev - M);
        if (tid == 7) { LDSF(MS_SC) = __expf(mprev - M); LDSF(MS_SC + 4) = bc + M; } }
    __syncthreads();
    if (tid < 8) LDSF(MS_WE + tid * 4) = __expf(LDSF(MS_A + tid * 4) - LDSF(MS_M + 7 * 4));
    if (tid < 64) { const int t = tid >> 3, s = tid & 7; float a = 0.f;
        for (int d = 0; d < 128; ++d) a += LDSF(MS_Q + (t * 132 + d) * 4) * LDSF(MS_K + (s * 132 + d) * 4);
        LDSF(MS_S + tid * 4) = (s <= t) ? a * __expf(LDSF(MS_A + s * 4) - LDSF(MS_M + t * 4)) : 0.f; }
    {
#pragma unroll
        for (int t = 0; t < 8; ++t) { f32x4 a = (f32x4){0.f, 0.f, 0.f, 0.f};
#pragma unroll
            for (int dd = 0; dd < 8; ++dd) { const float qv = LDSF(MS_Q + (t * 132 + dsg * 8 + dd) * 4); a = a + Cr[dd] * qv; }
            a.x += __shfl_xor(a.x, 32); a.y += __shfl_xor(a.y, 32); a.z += __shfl_xor(a.z, 32); a.w += __shfl_xor(a.w, 32);
            if (lane < 32) *(LAS f32x4*)(lds + MS_RED + ((wid * 8 + t) * 128 + vq4 * 4) * 4) = a; }
    }
    __syncthreads();
    if (tid < 8) { float d = 0.f, qn = 0.f; for (int s = 0; s < 8; ++s) d += LDSF(MS_S + (tid * 8 + s) * 4);
        for (int dd = 0; dd < 128; ++dd) qn += LDSF(MS_Q + (tid * 132 + dd) * 4) * LDSF(MS_N0 + dd * 4);
        LDSF(MS_DEN + tid * 4) = d + LDSF(MS_SI + tid * 4) * qn; }
    __syncthreads();
    { const int t = tid >> 6, v2 = (tid & 63) * 2; const float si = LDSF(MS_SI + t * 4); const float dn = 1.f / fmaxf(fabsf(LDSF(MS_DEN + t * 4)), LDSF(MS_EM + t * 4)); float r[2];
#pragma unroll
        for (int e = 0; e < 2; ++e) { const int v = v2 + e; float ni = 0.f;
#pragma unroll
            for (int w = 0; w < 8; ++w) ni += LDSF(MS_RED + ((w * 8 + t) * 128 + v) * 4);
            float num = ni * si;
#pragma unroll
            for (int s = 0; s < 8; ++s) num += LDSF(MS_S + (t * 8 + s) * 4) * LDSF(MS_V + (s * 128 + v) * 4);
            r[e] = num * dn; }
        *(unsigned*)(YPRE + (r0 + t) * YP_LD + 1024 + head * 256 + vh * 128 + v2) = cvt_pk_bf16(r[0], r[1]); }
    const float scaleC = LDSF(MS_SC);
#pragma unroll
    for (int i = 0; i < 8; ++i) Cr[i] = Cr[i] * scaleC;
#pragma unroll
    for (int s = 0; s < 8; ++s) { const float we = LDSF(MS_WE + s * 4); const f32x4 vv = *(const LAS f32x4*)(lds + MS_V + (s * 128 + vq4 * 4) * 4) * we;
#pragma unroll
        for (int i = 0; i < 8; ++i) Cr[i] = Cr[i] + vv * LDSF(MS_K + (s * 132 + dsg * 8 + i) * 4); }
    float* co = p->out + O_MCS + ((size_t)(b * 4 + head) * 128 + dsg * 8) * 256 + vh * 128 + vq4 * 4;
#pragma unroll
    for (int i = 0; i < 8; ++i) *(f32x4*)(co + (size_t)i * 256) = Cr[i];
    if (vh == 0) {
        if (tid < 128) { float n = scaleC * LDSF(MS_N0 + tid * 4); for (int s = 0; s < 8; ++s) n += LDSF(MS_WE + s * 4) * LDSF(MS_K + (s * 132 + tid) * 4); p->out[O_MNS + (size_t)(b * 4 + head) * 128 + tid] = n; }
        if (tid == 0) p->out[O_MMS + b * 4 + head] = LDSF(MS_SC + 4);
    }
    __syncthreads();
}

__device__ __forceinline__ void norm_phase(KPtr p, int G) {
    const int tid_ = fresh_tid(); const int lane = tid_ & 63, wave = tid_ >> 6; const int gw = blockIdx.x * 8 + wave, NGW = G * 8;
    const bf16_t* YPRE = (const bf16_t*)(p->ws + WS_YPRE); const bf16_t* PROJ = (const bf16_t*)(p->ws + WS_BIG); bf16_t* A2 = (bf16_t*)(p->ws + WS_A2);
    const float* gs = p->in[17]; const float* gm = p->in[20];
    for (int r = gw; r < MT; r += NGW) {
        const bf16_t* yr = YPRE + (size_t)r * YP_LD; bf16_t* ar = A2 + (size_t)r * YP_LD;
#pragma unroll
        for (int i = 0; i < 4; ++i) {
            const int c0 = i * 512 + lane * 8; const u32x4 w = *(const u32x4*)(yr + c0);
            float v[8] = {bflo(w.x), bfhi(w.x), bflo(w.y), bfhi(w.y), bflo(w.z), bfhi(w.z), bflo(w.w), bfhi(w.w)};
            float s = 0.f;
#pragma unroll
            for (int e = 0; e < 8; ++e) s += v[e] * v[e];
            float rstd; float gg[8];
            if (i < 2) { rstd = rsqrtf(wave_sum(s) * (1.f / 512.f) + EPSN);
                const f32x4 a = *(const f32x4*)(gs + c0), bq = *(const f32x4*)(gs + c0 + 4); gg[0] = a.x; gg[1] = a.y; gg[2] = a.z; gg[3] = a.w; gg[4] = bq.x; gg[5] = bq.y; gg[6] = bq.z; gg[7] = bq.w; }
            else {
#pragma unroll
                for (int o = 1; o < 32; o <<= 1) s += __shfl_xor(s, o);
                rstd = rsqrtf(s * (1.f / 256.f) + EPSN);
                const int cm = c0 - 1024; const f32x4 a = *(const f32x4*)(gm + cm), bq = *(const f32x4*)(gm + cm + 4); const u32x4 og = *(const u32x4*)(PROJ + (size_t)r * PROJ_LD + 4608 + cm);
                const float ov[8] = {bflo(og.x), bfhi(og.x), bflo(og.y), bfhi(og.y), bflo(og.z), bfhi(og.z), bflo(og.w), bfhi(og.w)};
                gg[0] = a.x; gg[1] = a.y; gg[2] = a.z; gg[3] = a.w; gg[4] = bq.x; gg[5] = bq.y; gg[6] = bq.z; gg[7] = bq.w;
#pragma unroll
                for (int e = 0; e < 8; ++e) gg[e] *= sigmoidf_(ov[e]); }
            u32x4 o; o.x = cvt_pk_bf16(v[0] * rstd * gg[0], v[1] * rstd * gg[1]); o.y = cvt_pk_bf16(v[2] * rstd * gg[2], v[3] * rstd * gg[3]);
            o.z = cvt_pk_bf16(v[4] * rstd * gg[4], v[5] * rstd * gg[5]); o.w = cvt_pk_bf16(v[6] * rstd * gg[6], v[7] * rstd * gg[7]);
            *(u32x4*)(ar + c0) = o;
        }
    }
}

template <bool FIRST, bool LASTP, bool PART = false>
__device__ __forceinline__ void row_phase(KPtr p, int wg0, int nwg, int r_lo, int r_hi, const float* gpost, const float* gpre) {
    const int tid_ = fresh_tid(); const int lane = tid_ & 63, wave = tid_ >> 6; const int gw = ((int)blockIdx.x - wg0) * 8 + wave, NGW = nwg * 8;
    const bf16_t* R1 = (const bf16_t*)(p->ws + WS_R1); bf16_t* U = (bf16_t*)(p->ws + WS_U);
    if ((int)blockIdx.x < wg0) return;
    for (int r = r_lo + gw; r < r_hi; r += NGW) {
        const float* xs = FIRST ? (r < MP ? p->in[0] + (size_t)r * DM : p->in[1] + (size_t)(r - MP) * DM) : p->out + (size_t)r * DM;
        float* xo = p->out + (size_t)r * DM;
        const u32x2* rr = (const u32x2*)(R1 + (size_t)r * DM) + lane;
        f32x4 rv[4], xv[4]; float s = 0.f;
#pragma unroll
        for (int j = 0; j < 4; ++j) { if (PART) { const f32x4* pp = (const f32x4*)(p->ws + WS_A2) + (size_t)(r - MP) * 256 + lane + 64 * j; rv[j] = pp[0] + pp[(size_t)MS * 256]; }
            else { const u32x2 w = rr[64 * j]; rv[j] = (f32x4){bflo(w.x), bfhi(w.x), bflo(w.y), bfhi(w.y)}; } xv[j] = ((const f32x4*)xs)[lane + 64 * j];
            s += (rv[j].x * rv[j].x + rv[j].y * rv[j].y) + (rv[j].z * rv[j].z + rv[j].w * rv[j].w); }
        const float rstd = rsqrtf(wave_sum(s) * (1.f / DM) + EPSN);
        float s2 = 0.f;
#pragma unroll
        for (int j = 0; j < 4; ++j) { const f32x4 gg = ((const f32x4*)gpost)[lane + 64 * j]; xv[j] = xv[j] + rv[j] * rstd * gg; ((f32x4*)xo)[lane + 64 * j] = xv[j];
            s2 += (xv[j].x * xv[j].x + xv[j].y * xv[j].y) + (xv[j].z * xv[j].z + xv[j].w * xv[j].w); }
        if (!LASTP) { const float rstd2 = rsqrtf(wave_sum(s2) * (1.f / DM) + EPSN); u32x2* uo = (u32x2*)(U + (size_t)r * DM) + lane;
#pragma unroll
            for (int j = 0; j < 4; ++j) { const f32x4 gg = ((const f32x4*)gpre)[lane + 64 * j]; u32x2 w; w.x = cvt_pk_bf16(xv[j].x * rstd2 * gg.x, xv[j].y * rstd2 * gg.y); w.y = cvt_pk_bf16(xv[j].z * rstd2 * gg.z, xv[j].w * rstd2 * gg.w); uo[64 * j] = w; } }
    }
}

constexpr int AT_K = 0, AT_V = 33792;
__device__ __forceinline__ void attn_prompt_unit(KPtr p, ldsp lds, int unit) {
    const int tid = fresh_tid(), lane = tid & 63, wid = __builtin_amdgcn_readfirstlane(tid >> 6), l15 = lane & 15, quad = lane >> 4;
    const int qb = unit & 15, head = (unit >> 4) & 3, b = unit >> 6;
    const bf16_t* QX = (const bf16_t*)(p->ws + WS_QX); const bf16_t* KM = (const bf16_t*)(p->ws + WS_KM); const bf16_t* VMT = (const bf16_t*)(p->ws + WS_VMT); bf16_t* O = (bf16_t*)(p->ws + WS_O);
    const size_t qrow = (size_t)b * 2048 + qb * 128 + wid * 16 + l15;
    bf16x8 qf[8];
#pragma unroll
    for (int ks = 0; ks < 8; ++ks) qf[ks] = *(const bf16x8*)(QX + qrow * DM + head * 256 + ks * 32 + quad * 8);
    f32x4 oa[16];
#pragma unroll
    for (int i = 0; i < 16; ++i) oa[i] = (f32x4){0.f, 0.f, 0.f, 0.f};
    float mrun = -3.0e38f, lrun = 0.f;
    for (int kt = 0; kt < 4; ++kt) {
        __syncthreads();
#pragma unroll
        for (int i = 0; i < 4; ++i) { const int v = tid + 512 * i; const int kr = v >> 5, kc = v & 31;
            *(LAS u32x4*)(lds + AT_K + kr * 528 + kc * 16) = *(const u32x4*)(KM + ((size_t)b * 256 + kt * 64 + kr) * DM + head * 256 + kc * 8);
            const int vr = v >> 3, vc = v & 7;
            *(LAS u32x4*)(lds + AT_V + vr * 144 + vc * 16) = *(const u32x4*)(VMT + ((size_t)(b * 4 + head) * 256 + vr) * 256 + kt * 64 + vc * 8); }
        __syncthreads();
        f32x4 sT[4];
#pragma unroll
        for (int k16 = 0; k16 < 4; ++k16) { sT[k16] = (f32x4){0.f, 0.f, 0.f, 0.f};
#pragma unroll
            for (int ks = 0; ks < 8; ++ks) { const bf16x8 afr = LDSV8(AT_K + (k16 * 16 + l15) * 528 + ks * 64 + quad * 16); sT[k16] = MFMA16(afr, qf[ks], sT[k16]); } }
        float mx = mrun;
#pragma unroll
        for (int k16 = 0; k16 < 4; ++k16)
#pragma unroll
            for (int j = 0; j < 4; ++j) mx = fmaxf(mx, sT[k16][j]);
        mx = fmaxf(mx, __shfl_xor(mx, 16)); mx = fmaxf(mx, __shfl_xor(mx, 32));
        const float alpha = __expf(mrun - mx); mrun = mx; float ls = 0.f;
#pragma unroll
        for (int k16 = 0; k16 < 4; ++k16)
#pragma unroll
            for (int j = 0; j < 4; ++j) { const float e = __expf(sT[k16][j] - mx); sT[k16][j] = e; ls += e; }
        lrun = lrun * alpha + ls;
#pragma unroll
        for (int i = 0; i < 16; ++i) oa[i] = oa[i] * alpha;
#pragma unroll
        for (int k2 = 0; k2 < 2; ++k2) {
            u32x4 pw; pw.x = cvt_pk_bf16(sT[2 * k2][0], sT[2 * k2][1]); pw.y = cvt_pk_bf16(sT[2 * k2][2], sT[2 * k2][3]); pw.z = cvt_pk_bf16(sT[2 * k2 + 1][0], sT[2 * k2 + 1][1]); pw.w = cvt_pk_bf16(sT[2 * k2 + 1][2], sT[2 * k2 + 1][3]);
            const bf16x8 pf = __builtin_bit_cast(bf16x8, pw);
#pragma unroll
            for (int dt = 0; dt < 16; ++dt) { const u32x2 v0 = *(const LAS u32x2*)(lds + AT_V + (dt * 16 + l15) * 144 + (k2 * 32 + quad * 4) * 2), v1 = *(const LAS u32x2*)(lds + AT_V + (dt * 16 + l15) * 144 + (k2 * 32 + 16 + quad * 4) * 2);
                u32x4 vw; vw.x = v0.x; vw.y = v0.y; vw.z = v1.x; vw.w = v1.y; oa[dt] = MFMA16(__builtin_bit_cast(bf16x8, vw), pf, oa[dt]); }
        }
    }
    lrun += __shfl_xor(lrun, 16); lrun += __shfl_xor(lrun, 32);
    const float inv = 1.f / lrun;
#pragma unroll
    for (int dt = 0; dt < 16; ++dt) { u32x2 o; o.x = cvt_pk_bf16(oa[dt][0] * inv, oa[dt][1] * inv); o.y = cvt_pk_bf16(oa[dt][2] * inv, oa[dt][3] * inv);
        *(u32x2*)(O + qrow * DM + head * 256 + dt * 16 + quad * 4) = o; }
}
constexpr int AS_S = 0, AS_P = 8192, AS_O = 16384;
__device__ __forceinline__ void attn_sample_unit(KPtr p, ldsp lds, int unit) {
    const int tid = fresh_tid(), lane = tid & 63, wid = __builtin_amdgcn_readfirstlane(tid >> 6), l15 = lane & 15, quad = lane >> 4;
    const int head = unit & 3, b = unit >> 2;
    const bf16_t* QX = (const bf16_t*)(p->ws + WS_QX); bf16_t* O = (bf16_t*)(p->ws + WS_O);
    const float* CK = p->in[8] + (size_t)b * 256 * 1024 + head * 256; const float* CV = p->in[9] + (size_t)b * 256 * 1024 + head * 256;
    const size_t r0 = (size_t)MP + (size_t)b * 8;
    bf16x8 qf[8];
#pragma unroll
    for (int ks = 0; ks < 8; ++ks) { u32x4 w = (u32x4){0u, 0u, 0u, 0u}; if (l15 < 8) w = *(const u32x4*)(QX + (r0 + l15) * DM + head * 256 + ks * 32 + quad * 8); qf[ks] = __builtin_bit_cast(bf16x8, w); }
    __syncthreads();
    {
        f32x4 ka[2][8], kb[2][8];
#pragma unroll
        for (int ps = 0; ps < 2; ++ps) { const float* kp = CK + (size_t)(ps * 128 + wid * 16 + l15) * 1024 + quad * 8;
#pragma unroll
            for (int ks = 0; ks < 8; ++ks) { ka[ps][ks] = *(const f32x4*)(kp + ks * 32); kb[ps][ks] = *(const f32x4*)(kp + ks * 32 + 4); } }
#pragma unroll
        for (int ps = 0; ps < 2; ++ps) { const int m0 = ps * 128 + wid * 16;
            f32x4 sc = (f32x4){0.f, 0.f, 0.f, 0.f};
#pragma unroll
            for (int ks = 0; ks < 8; ++ks) { u32x4 w; w.x = cvt_pk_bf16(ka[ps][ks].x, ka[ps][ks].y); w.y = cvt_pk_bf16(ka[ps][ks].z, ka[ps][ks].w); w.z = cvt_pk_bf16(kb[ps][ks].x, kb[ps][ks].y); w.w = cvt_pk_bf16(kb[ps][ks].z, kb[ps][ks].w);
                sc = MFMA16(__builtin_bit_cast(bf16x8, w), qf[ks], sc); }
            if (l15 < 8) *(LAS f32x4*)(lds + AS_S + (l15 * 256 + m0 + quad * 4) * 4) = sc; }
    }
    const float* vp = CV + (size_t)(wid * 32) * 1024 + lane * 4;
    f32x4 vA[8], vB[8];
#pragma unroll
    for (int i = 0; i < 8; ++i) vA[i] = *(const f32x4*)(vp + (size_t)i * 1024);
    LBAR();
    {
        const f32x4 s4 = *(const LAS f32x4*)(lds + AS_S + (wid * 256 + lane * 4) * 4);
        const float mx = wave_max(fmaxf(fmaxf(s4.x, s4.y), fmaxf(s4.z, s4.w)));
        const float e0 = __expf(s4.x - mx), e1 = __expf(s4.y - mx), e2 = __expf(s4.z - mx), e3 = __expf(s4.w - mx);
        const float inv = 1.f / wave_sum(e0 + e1 + e2 + e3);
        LDSF(AS_P + ((lane * 4 + 0) * 8 + wid) * 4) = e0 * inv; LDSF(AS_P + ((lane * 4 + 1) * 8 + wid) * 4) = e1 * inv;
        LDSF(AS_P + ((lane * 4 + 2) * 8 + wid) * 4) = e2 * inv; LDSF(AS_P + ((lane * 4 + 3) * 8 + wid) * 4) = e3 * inv;
    }
    LBAR();
    {
        f32x4 acc[8];
#pragma unroll
        for (int t = 0; t < 8; ++t) acc[t] = (f32x4){0.f, 0.f, 0.f, 0.f};
#define AS_PV(vv, mb) do { _Pragma("unroll") for (int i = 0; i < 8; ++i) { const int m = wid * 32 + (mb) + i; const f32x4 pa = *(const LAS f32x4*)(lds + AS_P + m * 32), pb = *(const LAS f32x4*)(lds + AS_P + m * 32 + 16); \
                acc[0] = acc[0] + vv[i] * pa.x; acc[1] = acc[1] + vv[i] * pa.y; acc[2] = acc[2] + vv[i] * pa.z; acc[3] = acc[3] + vv[i] * pa.w; \
                acc[4] = acc[4] + vv[i] * pb.x; acc[5] = acc[5] + vv[i] * pb.y; acc[6] = acc[6] + vv[i] * pb.z; acc[7] = acc[7] + vv[i] * pb.w; } } while (0)
#define AS_LD(vv, mb) do { _Pragma("unroll") for (int i = 0; i < 8; ++i) vv[i] = *(const f32x4*)(vp + (size_t)((mb) + i) * 1024); } while (0)
        AS_LD(vB, 8);  AS_PV(vA, 0);
        AS_LD(vA, 16); AS_PV(vB, 8);
        AS_LD(vB, 24); AS_PV(vA, 16);
        AS_PV(vB, 24);
#undef AS_PV
#undef AS_LD
#pragma unroll
        for (int t = 0; t < 8; ++t) *(LAS f32x4*)(lds + AS_O + ((wid * 8 + t) * 256 + lane * 4) * 4) = acc[t];
    }
    __syncthreads();
    { const int t = tid >> 6, d4 = (tid & 63) * 4; f32x4 a = (f32x4){0.f, 0.f, 0.f, 0.f};
#pragma unroll
        for (int w = 0; w < 8; ++w) a = a + *(const LAS f32x4*)(lds + AS_O + ((w * 8 + t) * 256 + d4) * 4);
        u32x2 o; o.x = cvt_pk_bf16(a.x, a.y); o.y = cvt_pk_bf16(a.z, a.w); *(u32x2*)(O + (r0 + t) * DM + head * 256 + d4) = o; }
}


#ifndef DUMP_AT
#define DUMP_AT -1
#define DUMP_OFF 0
#define DUMP_LD 1024
#define DUMP_COL0 0
#endif
#ifndef DUMP_COL1
#define DUMP_COL1 -1
#endif
__device__ __forceinline__ void dump_phase(KPtr p, int G) {
    const bf16_t* B = (const bf16_t*)(p->ws + (size_t)DUMP_OFF);
    for (size_t i = (size_t)blockIdx.x * 512 + threadIdx.x; i < (size_t)MT * 1024; i += (size_t)G * 512) { const size_t r = i >> 10, c = i & 1023; float v = bf2f(B[r * DUMP_LD + DUMP_COL0 + c]); if (DUMP_COL1 >= 0) v += 1.7f * bf2f(B[r * DUMP_LD + DUMP_COL1 + c]); p->out[i] = v; }
}
#define DUMP(n) do { if (DUMP_AT == (n)) { dump_phase(kparams(), G); return; } } while (0)

__global__ void __launch_bounds__(512, 2) hymba_fwd(Params pv) {
    extern __shared__ __attribute__((aligned(16))) unsigned char lds_raw[];
    ldsp lds = (ldsp)lds_raw;
    cg::grid_group grid = cg::this_grid();
    const int G = gridDim.x;
    volatile LAS unsigned* bst = (volatile LAS unsigned*)(lds + LDS_BYTES - 64);
    { unsigned* bar0 = (unsigned*)kparams()->ws; if (threadIdx.x == 0) { bst[0] = 0u; bst[1] = 0u; xb_add(bar0 + XB_XCNT(xb_xcc_id()), 1u); } }
    __syncthreads();
#define GSYNC() xcd_barrier((unsigned*)kparams()->ws, bst)
#ifndef PHMASK
#define PHMASK 0xffffffffu
#endif
#define PH(n) ((PHMASK >> (n)) & 1u)
    if (PH(0)) { KPtr p = kparams(); p0_prologue(p, lds, G); }
    if (kparams()->ws == nullptr) grid.sync();
    GSYNC();
    DUMP(0);
    if (PH(1)) {
        KPtr p = kparams(); unsigned char* ws = p->ws;
        pg8::Gemm g0{(const bf16_t*)(ws + WS_UM), (const bf16_t*)(ws + WS_WKVT), NMEMROWS, 2048, 1024}; pg8::StaticOrder S0; S0.init(NMEMROWS, 2048, G, G - 1 - (int)blockIdx.x);
        EpiKV E0{p->out + O_MK, p->out + O_MV, (bf16_t*)(ws + WS_KM), (bf16_t*)(ws + WS_VMT)};
        pg8::gemm_phase<EpiKV, pg8::StaticOrder, true, true>(lds, g0, S0, E0);
        __syncthreads();
        pg8::Gemm g1{(const bf16_t*)(ws + WS_U), (const bf16_t*)(ws + WS_W1T), MT, N1PAD, 1024}; pg8::StaticOrder S1; S1.init(MT, N1PAD, G, (int)blockIdx.x);
        EpiG1 E1{(bf16_t*)(ws + WS_BIG), (float*)(ws + WS_GATES)};
        pg8::gemm_phase<EpiG1, pg8::StaticOrder, true, true>(lds, g1, S1, E1);
    }
    GSYNC();
    DUMP(1);
    if (PH(2)) { KPtr p = kparams(); conv_phase(p, G); }
    GSYNC();
    DUMP(2);
    if (PH(3)) { KPtr p = kparams(); for (int u = blockIdx.x; u < 128; u += G) ssd_prompt_unit(p, lds, u >> 4, u & 15); }
    if (PH(4)) { KPtr p = kparams(); for (int u = blockIdx.x; u < 256; u += G) { if (u >= 128) { const int v = u - 128; mlstm_prompt_unit(p, lds, v >> 4, (v >> 2) & 3, v & 3); } } }
    if (PH(6)) { KPtr p = kparams(); unsigned* q = (unsigned*)p->ws + 8256; volatile LAS unsigned* slot = (volatile LAS unsigned*)(lds + LDS_BYTES - 32);
        for (;;) { if (threadIdx.x == 0) slot[0] = atomicAdd(q, 1u); __syncthreads(); const unsigned v = slot[0]; __syncthreads(); if (v >= 1024u) break; mlstm_sample_unit(p, lds, (int)(v >> 3), (int)((v >> 1) & 3), (int)(v & 1)); } }
    if (PH(5)) { KPtr p = kparams(); unsigned* q = (unsigned*)p->ws + 8192; volatile LAS unsigned* slot = (volatile LAS unsigned*)(lds + LDS_BYTES - 32);
        for (;;) { if (threadIdx.x == 0) slot[0] = atomicAdd(q, 1u); __syncthreads(); const unsigned v = slot[0]; __syncthreads(); if (v >= 2048u) break; ssd_sample_unit(p, lds, (int)(v >> 4), (int)(v & 15)); } }
    GSYNC();
    DUMP(3);
    if (PH(7)) { KPtr p = kparams(); norm_phase(p, G); }
    GSYNC();
    DUMP(4);
    if (PH(8)) { KPtr p = kparams(); unsigned char* ws = p->ws;
        pg8::Gemm g{(const bf16_t*)(ws + WS_A2), (const bf16_t*)(ws + WS_W2T), MP, 1024, 2048}; pg8::StaticOrder S; S.init(MP, 1024, G, (int)blockIdx.x);
        EpiB E{(bf16_t*)(ws + WS_R1), 1024, 1.f};
        pg8::gemm_phase<EpiB, pg8::StaticOrder, true, true>(lds, g, S, E);
    }
    GSYNC();
    {
        KPtr p = kparams(); unsigned char* ws = p->ws;
        if (blockIdx.x < 16) { if (PH(8)) {
            pg8::Gemm g{(const bf16_t*)(ws + WS_A2) + (size_t)MP * 2048, (const bf16_t*)(ws + WS_W2T), MS, 1024, 2048}; pg8::StaticOrder S; S.init(MS, 1024, 16, (int)blockIdx.x);
            EpiB E{(bf16_t*)(ws + WS_R1) + (size_t)MP * 1024, 1024, 1.f};
            pg8::gemm_phase<EpiB, pg8::StaticOrder, true, true>(lds, g, S, E); }
            asm volatile("s_waitcnt vmcnt(0)" ::: "memory"); __syncthreads();
            if (threadIdx.x == 0) { __builtin_amdgcn_fence(__ATOMIC_RELEASE, "agent"); asm volatile("s_waitcnt vmcnt(0)" ::: "memory"); (void)xb_add((unsigned*)ws + 8320, 1u); } }
        else if (PH(9)) {
            row_phase<true, false>(p, 16, G - 16, 0, MP, p->in[22], p->in[26]);
            if (threadIdx.x == 0) { unsigned* cw = (unsigned*)ws + 8320; while (xb_ld(cw) < 16u) __builtin_amdgcn_s_sleep(1);
                __builtin_amdgcn_fence(__ATOMIC_ACQUIRE, "agent"); asm volatile("s_waitcnt vmcnt(0)" ::: "memory"); }
            __syncthreads();
            row_phase<true, false>(p, 16, G - 16, MP, MT, p->in[22], p->in[26]); }
    }
    GSYNC();
    DUMP(6);
    if (PH(8)) { KPtr p = kparams(); unsigned char* ws = p->ws;
        pg8::Gemm g{(const bf16_t*)(ws + WS_U), (const bf16_t*)(ws + WS_WXQT), MT, 1024, 1024}; pg8::StaticOrder S; S.init(MT, 1024, G, (int)blockIdx.x);
        EpiB E{(bf16_t*)(ws + WS_QX), 1024, 0.0625f};
        pg8::gemm_phase<EpiB, pg8::StaticOrder, true, true>(lds, g, S, E);
    }
    GSYNC();
    DUMP(7);
    if ((blockIdx.x & 1) && PH(11)) { KPtr p = kparams(); for (int u = blockIdx.x; u < 512; u += G) { attn_sample_unit(p, lds, u); __syncthreads(); } }
    if (PH(10)) { KPtr p = kparams(); for (int u = blockIdx.x; u < 512; u += G) { attn_prompt_unit(p, lds, u); __syncthreads(); } }
    if (!(blockIdx.x & 1) && PH(11)) { KPtr p = kparams(); for (int u = blockIdx.x; u < 512; u += G) { attn_sample_unit(p, lds, u); __syncthreads(); } }
    GSYNC();
    DUMP(8);
    if (PH(8)) { KPtr p = kparams(); unsigned char* ws = p->ws;
        pg8::Gemm g{(const bf16_t*)(ws + WS_O), (const bf16_t*)(ws + WS_WXOT), MP, 1024, 1024}; pg8::StaticOrder S; S.init(MP, 1024, G, (int)blockIdx.x);
        EpiB E{(bf16_t*)(ws + WS_R1), 1024, 1.f};
        pg8::gemm_phase<EpiB, pg8::StaticOrder, true, true>(lds, g, S, E);
    }
    GSYNC();
    {
        KPtr p = kparams(); unsigned char* ws = p->ws;
        if (blockIdx.x < 16) { if (PH(8)) {
            pg8::Gemm g{(const bf16_t*)(ws + WS_O) + (size_t)MP * 1024, (const bf16_t*)(ws + WS_WXOT), MS, 1024, 1024}; pg8::StaticOrder S; S.init(MS, 1024, 16, (int)blockIdx.x);
            EpiB E{(bf16_t*)(ws + WS_R1) + (size_t)MP * 1024, 1024, 1.f};
            pg8::gemm_phase<EpiB, pg8::StaticOrder, true, true>(lds, g, S, E); }
            asm volatile("s_waitcnt vmcnt(0)" ::: "memory"); __syncthreads();
            if (threadIdx.x == 0) { __builtin_amdgcn_fence(__ATOMIC_RELEASE, "agent"); asm volatile("s_waitcnt vmcnt(0)" ::: "memory"); (void)xb_add((unsigned*)ws + 8384, 1u); } }
        else if (PH(9)) {
            row_phase<false, false>(p, 16, G - 16, 0, MP, p->in[29], p->in[30]);
            if (threadIdx.x == 0) { unsigned* cw = (unsigned*)ws + 8384; while (xb_ld(cw) < 16u) __builtin_amdgcn_s_sleep(1);
                __builtin_amdgcn_fence(__ATOMIC_ACQUIRE, "agent"); asm volatile("s_waitcnt vmcnt(0)" ::: "memory"); }
            __syncthreads();
            row_phase<false, false>(p, 16, G - 16, MP, MT, p->in[29], p->in[30]); }
    }
    GSYNC();
    DUMP(10);
    if (PH(12)) { KPtr p = kparams(); unsigned char* ws = p->ws;
        pg8::Gemm g{(const bf16_t*)(ws + WS_U), (const bf16_t*)(ws + WS_WGUT), MT, 5632, 1024}; pg8::StaticOrder S; S.init(MT, 5632, G, (int)blockIdx.x);
        EpiSwi E{(bf16_t*)(ws + WS_HID)};
        pg8::gemm_phase<EpiSwi, pg8::StaticOrder, true, true>(lds, g, S, E);
    }
    GSYNC();
    DUMP(11);
    if (PH(8)) { KPtr p = kparams(); unsigned char* ws = p->ws;
        pg8::Gemm g{(const bf16_t*)(ws + WS_HID), (const bf16_t*)(ws + WS_WDT), MP, 1024, 2816}; pg8::StaticOrder S; S.init(MP, 1024, G, (int)blockIdx.x);
        EpiB E{(bf16_t*)(ws + WS_R1), 1024, 1.f};
        pg8::gemm_phase<EpiB, pg8::StaticOrder, true, true>(lds, g, S, E);
    }
    GSYNC();
    {
        KPtr p = kparams(); unsigned char* ws = p->ws;
        if (blockIdx.x < 32) { if (PH(8)) { const int kh = (int)blockIdx.x >> 4;
            pg8::Gemm g{(const bf16_t*)(ws + WS_HID) + (size_t)MP * 2816 + kh * 1408, (const bf16_t*)(ws + WS_WDT) + kh * 1408, MS, 1024, 1408, 2816}; pg8::StaticOrder S; S.init(MS, 1024, 16, (int)blockIdx.x & 15);
            EpiP32 E{(float*)(ws + WS_A2) + (size_t)kh * MS * 1024, 1024};
            pg8::gemm_phase<EpiP32, pg8::StaticOrder, true, true>(lds, g, S, E); }
            asm volatile("s_waitcnt vmcnt(0)" ::: "memory"); __syncthreads();
            if (threadIdx.x == 0) { __builtin_amdgcn_fence(__ATOMIC_RELEASE, "agent"); asm volatile("s_waitcnt vmcnt(0)" ::: "memory"); (void)xb_add((unsigned*)ws + 8448, 1u); } }
        else if (PH(9)) {
            row_phase<false, true>(p, 32, G - 32, 0, MP, p->in[34], p->in[34]);
            if (threadIdx.x == 0) { unsigned* cw = (unsigned*)ws + 8448; while (xb_ld(cw) < 32u) __builtin_amdgcn_s_sleep(1);
                __builtin_amdgcn_fence(__ATOMIC_ACQUIRE, "agent"); asm volatile("s_waitcnt vmcnt(0)" ::: "memory"); }
            __syncthreads();
            row_phase<false, true, true>(p, 32, G - 32, MP, MT, p->in[34], p->in[34]); }
    }
}

extern "C" void kernel_launch(void* const* d_in, const int* in_sizes, int n_in, void* d_out, int out_size, void* d_ws, size_t ws_size, hipStream_t stream) {
    static int grid = 0;
    if (grid == 0) {
        if (n_in != 35 || ws_size < WS_END) { fprintf(stderr, "kernel_launch: unexpected n_in %d / ws %zu\n", n_in, ws_size); grid = -1; return; }
        int dev = 0, cus = 0, per_cu = 0;
        (void)hipGetDevice(&dev); (void)hipDeviceGetAttribute(&cus, hipDeviceAttributeMultiprocessorCount, dev);
        if (hipFuncSetAttribute((const void*)hymba_fwd, hipFuncAttributeMaxDynamicSharedMemorySize, LDS_BYTES) != hipSuccess) { fprintf(stderr, "kernel_launch: hipFuncSetAttribute failed\n"); grid = -1; return; }
        if (hipOccupancyMaxActiveBlocksPerMultiprocessor(&per_cu, (const void*)hymba_fwd, 512, LDS_BYTES) != hipSuccess || per_cu < 1) { fprintf(stderr, "kernel_launch: occupancy query says %d\n", per_cu); per_cu = 1; }
        (void)hipGetLastError();
        grid = cus * 1;
    }
    if (grid < 0) return;
    if (hipMemsetAsync(d_ws, 0, 65536, stream) != hipSuccess) { fprintf(stderr, "kernel_launch: memset failed\n"); return; }
    Params p{};
    for (int i = 0; i < 35; ++i) p.in[i] = (const float*)d_in[i];
    p.out = (float*)d_out; p.ws = (unsigned char*)d_ws;
    void* args[] = {&p};
    hipError_t e = hipLaunchCooperativeKernel((const void*)hymba_fwd, dim3(grid), dim3(512), args, LDS_BYTES, stream);
    if (e != hipSuccess) fprintf(stderr, "cooperative launch failed: %s (grid %d)\n", hipGetErrorString(e), grid);
}
```

```cpp
#include <hip/hip_runtime.h>
#include <hip/hip_cooperative_groups.h>
#include <cstdio>
#include <cstdint>
namespace cg = cooperative_groups;

#define LAS __attribute__((address_space(3)))
typedef unsigned short bf16_t;
typedef short bf16x8 __attribute__((ext_vector_type(8)));
typedef float f32x4 __attribute__((ext_vector_type(4)));
typedef float f32x2 __attribute__((ext_vector_type(2)));
typedef unsigned u32x4 __attribute__((ext_vector_type(4)));
typedef unsigned u32x2 __attribute__((ext_vector_type(2)));
typedef LAS unsigned char* ldsp;

typedef __bf16 bf16v2_t __attribute__((ext_vector_type(2)));
__device__ __forceinline__ unsigned cvt_pk_bf16(float lo, float hi) { f32x2 v = {lo, hi}; bf16v2_t b = __builtin_convertvector(v, bf16v2_t); return __builtin_bit_cast(unsigned, b); }
__device__ __forceinline__ float bf2f(unsigned short b) { return __uint_as_float(((unsigned)b) << 16); }
__device__ __forceinline__ float bflo(unsigned w) { return __uint_as_float(w << 16); }
__device__ __forceinline__ float bfhi(unsigned w) { return __uint_as_float(w & 0xffff0000u); }
__device__ __forceinline__ unsigned short f2bf(float f) { return (unsigned short)(cvt_pk_bf16(f, 0.f) & 0xffffu); }
__device__ __forceinline__ float wave_sum(float v) {
#pragma unroll
    for (int o = 1; o < 64; o <<= 1) v += __shfl_xor(v, o);
    return v;
}
__device__ __forceinline__ float wave_max(float v) {
#pragma unroll
    for (int o = 1; o < 64; o <<= 1) v = fmaxf(v, __shfl_xor(v, o));
    return v;
}
__device__ __forceinline__ float softplusf(float x) { return x > 20.f ? x : __logf(1.f + __expf(x)); }
__device__ __forceinline__ float siluf(float x) { return x * __builtin_amdgcn_rcpf(1.f + __expf(-x)); }
__device__ __forceinline__ float sigmoidf_(float x) { return __builtin_amdgcn_rcpf(1.f + __expf(-x)); }
#define LDS_WAIT() asm volatile("s_waitcnt lgkmcnt(0)" ::: "memory")
__device__ __forceinline__ int fresh_tid() { int t = threadIdx.x; asm volatile("" : "+v"(t)); return t; }

namespace pg8 {
constexpr int BM = 256, BK = 64, HALF = 128, HTB = HALF * BK * 2, STAGE_BYTES = 8 * HTB, NXCD = 8, WGM = 8;
__host__ __device__ __forceinline__ int lds_byte(int r, int c) { const int st = (r >> 4) * 2 + (c >> 5), rr = r & 15, cc = c & 31, ob = rr * 64 + cc * 2; return st * 1024 + (ob ^ (((ob >> 9) & 1) << 5)); }
__host__ __device__ __forceinline__ void stage_rc(int b, int& R, int& C) { const int st = b / 1024, sb = b % 1024, swz = sb ^ (((sb >> 9) & 1) << 5); R = (st >> 1) * 16 + swz / 64; C = (st & 1) * 32 + (swz % 64) / 2; }
__host__ __device__ __forceinline__ int perm32(int rho) { const int n = rho >> 4, i = rho & 15; return 8 * (i >> 2) + 4 * n + (i & 3); }
struct Unit { int pm, pn; };
struct Gemm { const bf16_t* A; const bf16_t* Bt; int M, N, K; int ld; };
struct StaticOrder {
    int nM, nN, nwg, G, c;
    __host__ __device__ void init(int M, int N, int G_, int c_) { nM = M / BM; nN = N / BM; nwg = nM * nN; G = G_; c = c_; }
    __host__ __device__ bool next(int i, Unit& u) const {
        const long L = (long)i * G + c; if (L >= nwg) return false;
        int wgid = (int)L; { const int q = nwg / NXCD, r = nwg % NXCD, xcd = wgid % NXCD, off = wgid / NXCD; wgid = (xcd < r ? xcd * (q + 1) : r * (q + 1) + (xcd - r) * q) + off; }
        const int nig = WGM * nN, gid = wgid / nig, fm = gid * WGM, gsz = (nM - fm) < WGM ? (nM - fm) : WGM;
        u.pm = fm + ((wgid % nig) % gsz); u.pn = (wgid % nig) / gsz; return true;
    }
    __device__ __forceinline__ void a_ready(const Unit&) const {}
    __device__ __forceinline__ void done(const Unit&) const {}
};
template <class Epi, class Sched, bool ALIGN_EPI = false, bool SP2 = false>
__device__ __forceinline__ void gemm_phase(ldsp lds, const Gemm g, const Sched& S, const Epi& E) {
    const int tid = fresh_tid(), wid = __builtin_amdgcn_readfirstlane(tid >> 6), lane = tid & 63, wr = wid >> 2, wc = wid & 3, fr = lane & 15, fq = lane >> 4;
    const int nt = g.K / BK, K = g.ld ? g.ld : g.K;
    unsigned voffA[2], voffB[2];
#pragma unroll
    for (int i = 0; i < 2; ++i) { int R, C; stage_rc(tid * 16 + i * 8192, R, C); const int Rb = Epi::PERM ? ((R & ~31) + perm32(R & 31)) : R;
        voffA[i] = (unsigned)(R * K + C) * 2u; voffB[i] = (unsigned)(Rb * K + C) * 2u; }
    const size_t kstep = (size_t)(BK * 2);
    const size_t hstep = (size_t)HALF * K * 2;
    const size_t tstep = 2 * hstep;
    const unsigned ldsw = (unsigned)wid * 1024u;
    const int aoff = lds_byte(wr * 64 + fr, fq * 8), boff = lds_byte(wc * 32 + fr, fq * 8);
#define PG8_SA(b, h) (((b) * 2 + (h)) * HTB)
#define PG8_SB(b, h) ((4 + (b) * 2 + (h)) * HTB)
#define PG8_STAGE(bufoff, gbase, voff) do { _Pragma("unroll") for (int _i = 0; _i < 2; ++_i) \
        __builtin_amdgcn_global_load_lds((const unsigned*)((const char*)(gbase) + (voff)[_i]), (LAS unsigned*)(lds + (bufoff) + ldsw + _i * 8192), 16, 0, 0); } while (0)
#define PG8_LDA(dst, b, h) do { _Pragma("unroll") for (int m = 0; m < 4; ++m) _Pragma("unroll") for (int k = 0; k < 2; ++k) dst[m][k] = *(const LAS bf16x8*)(lds + PG8_SA(b, h) + aoff + m * 2048 + k * 1024); } while (0)
#define PG8_LDB(dst, b, h) do { _Pragma("unroll") for (int n = 0; n < 2; ++n) _Pragma("unroll") for (int k = 0; k < 2; ++k) dst[n][k] = *(const LAS bf16x8*)(lds + PG8_SB(b, h) + boff + n * 2048 + k * 1024); } while (0)
#define PG8_MMA(ai, bj, At, Bt) do { __builtin_amdgcn_s_setprio(1); _Pragma("unroll") for (int m = 0; m < 4; ++m) _Pragma("unroll") for (int n = 0; n < 2; ++n) _Pragma("unroll") for (int k = 0; k < 2; ++k) \
        acc[ai][bj][m][n] = __builtin_amdgcn_mfma_f32_16x16x32_bf16(Bt[n][k], At[m][k], acc[ai][bj][m][n], 0, 0, 0); __builtin_amdgcn_s_setprio(0); } while (0)
#define PG8_WAIT_V(n) asm volatile("s_waitcnt vmcnt(" #n ")" ::: "memory")
#define PG8_WAIT_L(n) asm volatile("s_waitcnt lgkmcnt(" #n ")" ::: "memory")
#define PG8_BAR __builtin_amdgcn_s_barrier()
#define PG8_SCHED __builtin_amdgcn_sched_barrier(0)
    Unit cur, nxt; int ui = 0;
    if (!S.next(0, cur)) return;
    f32x4 acc[2][2][4][2];
#pragma unroll
    for (int a = 0; a < 2; ++a)
#pragma unroll
        for (int b = 0; b < 2; ++b)
#pragma unroll
            for (int m = 0; m < 4; ++m)
#pragma unroll
                for (int n = 0; n < 2; ++n) acc[a][b][m][n] = (f32x4){0.f, 0.f, 0.f, 0.f};
    bf16x8 At[4][2], B0[2][2], B1[2][2];
    const char* cA = (const char*)g.A + (size_t)cur.pm * tstep; const char* cB = (const char*)g.Bt + (size_t)cur.pn * tstep;
    S.a_ready(cur);
    if constexpr (SP2) {
        PG8_STAGE(PG8_SB(0, 0), cB, voffB); PG8_STAGE(PG8_SB(0, 1), cB + hstep, voffB); PG8_STAGE(PG8_SA(0, 0), cA, voffA); PG8_STAGE(PG8_SA(0, 1), cA + hstep, voffA);
        if (wr == 1) PG8_BAR;
        PG8_WAIT_V(2); PG8_BAR;
        PG8_STAGE(PG8_SB(1, 0), cB + kstep, voffB); PG8_STAGE(PG8_SA(1, 0), cA + kstep, voffA); PG8_STAGE(PG8_SB(1, 1), cB + hstep + kstep, voffB);
        PG8_WAIT_V(6); PG8_BAR;
    } else {
        PG8_STAGE(PG8_SB(0, 0), cB, voffB); PG8_STAGE(PG8_SA(0, 0), cA, voffA); PG8_STAGE(PG8_SB(0, 1), cB + hstep, voffB); PG8_STAGE(PG8_SA(0, 1), cA + hstep, voffA);
        if (wr == 1) PG8_BAR;
        PG8_WAIT_V(4); PG8_BAR;
        PG8_STAGE(PG8_SB(1, 0), cB + kstep, voffB); PG8_STAGE(PG8_SA(1, 0), cA + kstep, voffA); PG8_STAGE(PG8_SB(1, 1), cB + hstep + kstep, voffB);
        PG8_WAIT_V(6); PG8_BAR;
    }
    for (;;) {
        const bool has_next = S.next(ui + 1, nxt);
        const char* nA = has_next ? (const char*)g.A + (size_t)nxt.pm * tstep : cA; const char* nB = has_next ? (const char*)g.Bt + (size_t)nxt.pn * tstep : cB;
        for (int t = 0; t < nt; t += 2) {
            const bool last = (t == nt - 2);
            const char* a1 = cA + (size_t)(t + 1) * kstep;
            const char* a2 = last ? nA : cA + (size_t)(t + 2) * kstep; const char* b2 = last ? nB : cB + (size_t)(t + 2) * kstep;
            const char* a3 = a2 + kstep; const char* b3 = b2 + kstep;
            if (last && has_next) S.a_ready(nxt);
            if constexpr (SP2) {
            PG8_LDB(B0, 0, 0); PG8_LDB(B1, 0, 1); PG8_SCHED; PG8_LDA(At, 0, 0); PG8_STAGE(PG8_SA(1, 1), a1 + hstep, voffA);
            PG8_WAIT_V(8); PG8_WAIT_L(0); PG8_BAR; PG8_MMA(0, 0, At, B0); PG8_MMA(0, 1, At, B1); PG8_BAR; PG8_SCHED;
            PG8_LDA(At, 0, 1); PG8_STAGE(PG8_SB(0, 0), b2, voffB); PG8_STAGE(PG8_SB(0, 1), b2 + hstep, voffB); PG8_STAGE(PG8_SA(0, 0), a2, voffA);
            PG8_WAIT_V(8); PG8_WAIT_L(0); PG8_BAR; PG8_MMA(1, 0, At, B0); PG8_MMA(1, 1, At, B1); PG8_BAR; PG8_SCHED;
            PG8_LDB(B0, 1, 0); PG8_LDB(B1, 1, 1); PG8_SCHED; PG8_LDA(At, 1, 0); PG8_STAGE(PG8_SA(0, 1), a2 + hstep, voffA);
            PG8_WAIT_V(8); PG8_WAIT_L(0); PG8_BAR; PG8_MMA(0, 0, At, B0); PG8_MMA(0, 1, At, B1); PG8_BAR; PG8_SCHED;
            PG8_LDA(At, 1, 1); PG8_STAGE(PG8_SB(1, 0), b3, voffB); PG8_STAGE(PG8_SB(1, 1), b3 + hstep, voffB); PG8_STAGE(PG8_SA(1, 0), a3, voffA);
            PG8_WAIT_V(8); PG8_WAIT_L(0); PG8_BAR; PG8_MMA(1, 0, At, B0); PG8_MMA(1, 1, At, B1); PG8_BAR; PG8_SCHED;
            } else {
            PG8_LDB(B0, 0, 0); PG8_SCHED; PG8_LDA(At, 0, 0); PG8_STAGE(PG8_SA(1, 1), a1 + hstep, voffA);
            PG8_WAIT_L(8); PG8_BAR; PG8_WAIT_L(0); PG8_MMA(0, 0, At, B0); PG8_BAR; PG8_SCHED;
            PG8_LDB(B1, 0, 1); PG8_STAGE(PG8_SB(0, 0), b2, voffB);
            PG8_BAR; PG8_WAIT_L(0); PG8_MMA(0, 1, At, B1); PG8_BAR;
            PG8_LDA(At, 0, 1); PG8_STAGE(PG8_SA(0, 0), a2, voffA);
            PG8_BAR; PG8_WAIT_L(0); PG8_MMA(1, 0, At, B0); PG8_BAR; PG8_SCHED;
            PG8_STAGE(PG8_SB(0, 1), b2 + hstep, voffB);
            PG8_WAIT_V(6); PG8_BAR; PG8_MMA(1, 1, At, B1); PG8_BAR;
            PG8_LDB(B0, 1, 0); PG8_SCHED; PG8_LDA(At, 1, 0); PG8_STAGE(PG8_SA(0, 1), a2 + hstep, voffA);
            PG8_WAIT_L(8); PG8_BAR; PG8_WAIT_L(0); PG8_MMA(0, 0, At, B0); PG8_BAR; PG8_SCHED;
            PG8_LDB(B1, 1, 1); PG8_STAGE(PG8_SB(1, 0), b3, voffB);
            PG8_BAR; PG8_WAIT_L(0); PG8_MMA(0, 1, At, B1); PG8_BAR;
            PG8_LDA(At, 1, 1); PG8_STAGE(PG8_SA(1, 0), a3, voffA);
            PG8_BAR; PG8_WAIT_L(0); PG8_MMA(1, 0, At, B0); PG8_BAR; PG8_SCHED;
            PG8_STAGE(PG8_SB(1, 1), b3 + hstep, voffB);
            PG8_WAIT_V(6); PG8_BAR; PG8_MMA(1, 1, At, B1); PG8_BAR;
            }
        }
        if constexpr (ALIGN_EPI) { if (wr == 0) PG8_BAR; }
        E(acc, cur, wr, wc, fr, fq);
        if (!has_next) break;
#pragma unroll
        for (int a = 0; a < 2; ++a)
#pragma unroll
            for (int b = 0; b < 2; ++b)
#pragma unroll
                for (int m = 0; m < 4; ++m)
#pragma unroll
                    for (int n = 0; n < 2; ++n) acc[a][b][m][n] = (f32x4){0.f, 0.f, 0.f, 0.f};
        cur = nxt; cA = nA; cB = nB; ++ui;
        if constexpr (ALIGN_EPI) { if (wr == 1) PG8_BAR; }
    }
    PG8_WAIT_V(0);
    if constexpr (!ALIGN_EPI) { if (wr == 0) PG8_BAR; }
    PG8_BAR;
#undef PG8_SA
#undef PG8_SB
#undef PG8_STAGE
#undef PG8_LDA
#undef PG8_LDB
#undef PG8_MMA
#undef PG8_WAIT_V
#undef PG8_WAIT_L
#undef PG8_BAR
#undef PG8_SCHED
}
}

constexpr int DM = 1024, MP = 16384, MS = 1024, MT = 17408, NMEMROWS = 2048;
constexpr int PROJ_LD = 5632, N1PAD = 5888, XBC_LD = 1536, YP_LD = 2048, FFH = 2816;
constexpr float EPSN = 1e-6f;
constexpr size_t MiB = 1u << 20;
constexpr size_t WS_W1T = 1 * MiB, WS_W2T = 13 * MiB, WS_WKVT = 17 * MiB, WS_WXQT = 21 * MiB, WS_WXOT = 23 * MiB, WS_WGUT = 25 * MiB, WS_WDT = 36 * MiB;
constexpr size_t WS_U = 42 * MiB, WS_UM = 76 * MiB, WS_KM = 80 * MiB, WS_VMT = 84 * MiB, WS_GATES = 88 * MiB, WS_BIG = 91 * MiB;
constexpr size_t WS_XBC = 278 * MiB, WS_YPRE = 329 * MiB, WS_A2 = 397 * MiB, WS_END = 465 * MiB;
constexpr size_t WS_QX = WS_BIG, WS_O = WS_BIG + 34 * MiB, WS_HID = WS_BIG + 68 * MiB, WS_R1 = WS_XBC;
constexpr size_t O_YP = 0, O_YS = 16777216, O_MK = 17825792, O_MV = 19922944, O_SSMP = 22020096, O_CONVP = 23068672, O_MCP = 23105536, O_MNP = 24154112, O_MMP = 24158208,
                 O_SSMS = 24158240, O_CONVS = 40935456, O_MCS = 41525280, O_MNS = 58302496, O_MMS = 58368032;
constexpr int LDS_BYTES = 147456;

struct Params { const float* in[35]; float* out; unsigned char* ws; };
typedef const __attribute__((address_space(4))) Params* KPtr;
__device__ __forceinline__ KPtr kparams() { KPtr k = (KPtr)__builtin_amdgcn_kernarg_segment_ptr(); asm volatile("" : "+s"(k)); return k; }

struct EpiG1 {
    static constexpr bool PERM = true;
    bf16_t* proj; float* gates;
    __device__ __forceinline__ void operator()(const f32x4 (&acc)[2][2][4][2], const pg8::Unit& u, int wr, int wc, int fr, int fq) const {
        const int row0 = u.pm * 256 + wr * 64 + fr;
        if (u.pn < 22) {
            const int col0 = u.pn * 256 + wc * 32 + 8 * fq;
#pragma unroll
            for (int ai = 0; ai < 2; ++ai)
#pragma unroll
                for (int m = 0; m < 4; ++m) { bf16_t* rowp = proj + (size_t)(row0 + ai * 128 + m * 16) * PROJ_LD + col0;
#pragma unroll
                    for (int bj = 0; bj < 2; ++bj) { const f32x4 v0 = acc[ai][bj][m][0], v1 = acc[ai][bj][m][1]; u32x4 w;
                        w.x = cvt_pk_bf16(v0[0], v0[1]); w.y = cvt_pk_bf16(v0[2], v0[3]); w.z = cvt_pk_bf16(v1[0], v1[1]); w.w = cvt_pk_bf16(v1[2], v1[3]);
                        *(u32x4*)(rowp + bj * 128) = w; } }
        } else if (wc == 0) {
#pragma unroll
            for (int ai = 0; ai < 2; ++ai)
#pragma unroll
                for (int m = 0; m < 4; ++m) { float* rp = gates + (size_t)(row0 + ai * 128 + m * 16) * 32 + 8 * fq;
                    *(f32x4*)rp = acc[ai][0][m][0]; *(f32x4*)(rp + 4) = acc[ai][0][m][1]; }
        }
    }
};
struct EpiKV {
    static constexpr bool PERM = true;
    float* outk; float* outv; bf16_t* km; bf16_t* vmt;
    __device__ __forceinline__ void operator()(const f32x4 (&acc)[2][2][4][2], const pg8::Unit& u, int wr, int wc, int fr, int fq) const {
        const int row0 = u.pm * 256 + wr * 64 + fr;
#pragma unroll
        for (int ai = 0; ai < 2; ++ai)
#pragma unroll
            for (int m = 0; m < 4; ++m) { const int row = row0 + ai * 128 + m * 16;
#pragma unroll
                for (int bj = 0; bj < 2; ++bj) { const int c = u.pn * 256 + bj * 128 + wc * 32 + 8 * fq; const f32x4 v0 = acc[ai][bj][m][0], v1 = acc[ai][bj][m][1];
                    if (u.pn < 4) {
                        *(f32x4*)(outk + (size_t)row * 1024 + c) = v0; *(f32x4*)(outk + (size_t)row * 1024 + c + 4) = v1;
                        u32x4 w; w.x = cvt_pk_bf16(v0[0], v0[1]); w.y = cvt_pk_bf16(v0[2], v0[3]); w.z = cvt_pk_bf16(v1[0], v1[1]); w.w = cvt_pk_bf16(v1[2], v1[3]);
                        *(u32x4*)(km + (size_t)row * 1024 + c) = w;
                    } else {
                        const int c2 = c - 1024;
                        *(f32x4*)(outv + (size_t)row * 1024 + c2) = v0; *(f32x4*)(outv + (size_t)row * 1024 + c2 + 4) = v1;
                        const int b = row >> 8, mt = row & 255, h = c2 >> 8, d = c2 & 255;
                        bf16_t* vp = vmt + ((size_t)(b * 4 + h) * 256 + d) * 256 + mt;
#pragma unroll
                        for (int j = 0; j < 4; ++j) { vp[(size_t)j * 256] = f2bf(v0[j]); vp[(size_t)(j + 4) * 256] = f2bf(v1[j]); }
                    } } }
    }
};
struct EpiB {
    static constexpr bool PERM = true;
    bf16_t* O; int ldc; float scale;
    __device__ __forceinline__ void operator()(const f32x4 (&acc)[2][2][4][2], const pg8::Unit& u, int wr, int wc, int fr, int fq) const {
        const int row0 = u.pm * 256 + wr * 64 + fr, col0 = u.pn * 256 + wc * 32 + 8 * fq;
#pragma unroll
        for (int ai = 0; ai < 2; ++ai)
#pragma unroll
            for (int m = 0; m < 4; ++m) { bf16_t* rowp = O + (size_t)(row0 + ai * 128 + m * 16) * ldc + col0;
#pragma unroll
                for (int bj = 0; bj < 2; ++bj) { const f32x4 v0 = acc[ai][bj][m][0] * scale, v1 = acc[ai][bj][m][1] * scale; u32x4 w;
                    w.x = cvt_pk_bf16(v0[0], v0[1]); w.y = cvt_pk_bf16(v0[2], v0[3]); w.z = cvt_pk_bf16(v1[0], v1[1]); w.w = cvt_pk_bf16(v1[2], v1[3]);
                    *(u32x4*)(rowp + bj * 128) = w; } }
    }
};
struct EpiP32 {
    static constexpr bool PERM = true;
    float* C; int ldc;
    __device__ __forceinline__ void operator()(const f32x4 (&acc)[2][2][4][2], const pg8::Unit& u, int wr, int wc, int fr, int fq) const {
        const int row0 = u.pm * 256 + wr * 64 + fr, col0 = u.pn * 256 + wc * 32 + 8 * fq;
#pragma unroll
        for (int ai = 0; ai < 2; ++ai)
#pragma unroll
            for (int m = 0; m < 4; ++m) { float* rowp = C + (size_t)(row0 + ai * 128 + m * 16) * ldc + col0;
#pragma unroll
                for (int bj = 0; bj < 2; ++bj) { *(f32x4*)(rowp + bj * 128) = acc[ai][bj][m][0]; *(f32x4*)(rowp + bj * 128 + 4) = acc[ai][bj][m][1]; } }
    }
};
struct EpiSwi {
    static constexpr bool PERM = true;
    bf16_t* hid;
    __device__ __forceinline__ void operator()(const f32x4 (&acc)[2][2][4][2], const pg8::Unit& u, int wr, int wc, int fr, int fq) const {
        const int row0 = u.pm * 256 + wr * 64 + fr, col0 = u.pn * 128 + wc * 32 + 8 * fq;
#pragma unroll
        for (int ai = 0; ai < 2; ++ai)
#pragma unroll
            for (int m = 0; m < 4; ++m) { bf16_t* rowp = hid + (size_t)(row0 + ai * 128 + m * 16) * FFH + col0;
                float r[8];
#pragma unroll
                for (int n = 0; n < 2; ++n)
#pragma unroll
                    for (int j = 0; j < 4; ++j) { const float gt = acc[ai][0][m][n][j], up = acc[ai][1][m][n][j]; r[n * 4 + j] = siluf(gt) * up; }
                u32x4 w; w.x = cvt_pk_bf16(r[0], r[1]); w.y = cvt_pk_bf16(r[2], r[3]); w.z = cvt_pk_bf16(r[4], r[5]); w.w = cvt_pk_bf16(r[6], r[7]);
                *(u32x4*)rowp = w; }
    }
};


#define XB_TMO      128
#define XB_XCNT(j)  (256  + 64 * (j))
#define XB_XSUB(j)  (1280 + 64 * (j))
#define XB_XGEN(j)  (2304 + 64 * (j))
#define XB_TOP      3328
#define XB_TOPGEN   3392
#define XB_SPIN_CAP (1u << 22)
__device__ __forceinline__ unsigned xb_ld(unsigned* p)              { return __hip_atomic_load(p, __ATOMIC_RELAXED, __HIP_MEMORY_SCOPE_AGENT); }
__device__ __forceinline__ unsigned xb_add(unsigned* p, unsigned v) { return __hip_atomic_fetch_add(p, v, __ATOMIC_RELAXED, __HIP_MEMORY_SCOPE_AGENT); }
__device__ __forceinline__ unsigned xb_xcc_id() { return (unsigned)__builtin_amdgcn_s_getreg((3 << 11) | 20) & 0xFu; }
#define XB_SPIN(cond, bar) do { unsigned _sp = 0; while (cond) { __builtin_amdgcn_s_sleep(1); \
    if ((++_sp & 255u) == 0u) { if (xb_ld(&(bar)[XB_TMO])) break; if (_sp > XB_SPIN_CAP) { atomicAdd(&(bar)[XB_TMO], 1u); break; } } } } while (0)
__device__ __forceinline__ void xcd_barrier_complete(unsigned* bar, unsigned x, unsigned& nloc, unsigned& nx) {
    const unsigned G = gridDim.x * gridDim.y * gridDim.z;
    unsigned sum, cnt, mine, sp = 0u;
    for (;;) {
        sum = 0u; cnt = 0u; mine = 0u;
#pragma unroll
        for (unsigned j = 0; j < 16; ++j) { const unsigned c = xb_ld(&bar[XB_XCNT(j)]); sum += c; cnt += (c > 0u) ? 1u : 0u; mine = (j == x) ? c : mine; }
        if (sum == G) break;
        __builtin_amdgcn_s_sleep(1);
        if ((++sp & 255u) == 0u) { if (xb_ld(&bar[XB_TMO])) break; if (sp > XB_SPIN_CAP) { atomicAdd(&bar[XB_TMO], 1u); break; } }
    }
    nloc = mine > 0u ? mine : 1u; nx = cnt > 0u ? cnt : 1u;
}
__device__ __forceinline__ void xcd_barrier(unsigned* bar, volatile LAS unsigned* st) {
    asm volatile("s_waitcnt vmcnt(0)" ::: "memory");
    __syncthreads();
    if (threadIdx.x == 0) {
        const unsigned x = xb_xcc_id();
        __builtin_amdgcn_s_waitcnt(0);
        unsigned nloc = st[0], nx = st[1];
        if (nloc == 0u) { xcd_barrier_complete(bar, x, nloc, nx); st[0] = nloc; st[1] = nx; }
        const unsigned old = xb_add(&bar[XB_XSUB(x)], 1u);
        const unsigned gen = old / nloc;
        if (old + 1u == (gen + 1u) * nloc) {
            __builtin_amdgcn_fence(__ATOMIC_RELEASE, "agent");
            asm volatile("s_waitcnt vmcnt(0)" ::: "memory");
            const unsigned og = xb_add(&bar[XB_TOP], 1u);
            const unsigned tg = og / nx;
            if (og + 1u == (tg + 1u) * nx) xb_add(&bar[XB_TOPGEN], 1u);
            else XB_SPIN(xb_ld(&bar[XB_TOPGEN]) == tg, bar);
            __builtin_amdgcn_fence(__ATOMIC_ACQUIRE, "agent");
            xb_add(&bar[XB_XGEN(x)], 1u);
            asm volatile("s_waitcnt vmcnt(0)" ::: "memory");
        } else {
            XB_SPIN(xb_ld(&bar[XB_XGEN(x)]) == gen, bar);
            __builtin_amdgcn_fence(__ATOMIC_ACQUIRE, "agent");
            asm volatile("s_waitcnt vmcnt(0)" ::: "memory");
        }
    }
    __syncthreads();
}

__device__ __forceinline__ void tr_item(const float* __restrict__ W, int ldn, int c0, int k0, bf16_t* WT, int Kp, int r0, LAS float* scr, int lane) {
#pragma unroll 16
    for (int i = 0; i < 32; ++i) { const int kk = 2 * i + (lane >> 5); scr[kk * 33 + (lane & 31)] = W[(size_t)(k0 + kk) * ldn + c0 + (lane & 31)]; }
    LDS_WAIT();
    const int c = lane & 7;
#pragma unroll
    for (int j = 0; j < 4; ++j) { const int n = (lane >> 3) + 8 * j; const LAS float* s = scr + (8 * c) * 33 + n;
        u32x4 o; o.x = cvt_pk_bf16(s[0 * 33], s[1 * 33]); o.y = cvt_pk_bf16(s[2 * 33], s[3 * 33]); o.z = cvt_pk_bf16(s[4 * 33], s[5 * 33]); o.w = cvt_pk_bf16(s[6 * 33], s[7 * 33]);
        *(u32x4*)(WT + (size_t)(r0 + n) * Kp + k0 + 8 * c) = o; }
    LDS_WAIT();
}
__device__ __forceinline__ void rms_row_to_bf16(const float* xrow, const float* g, bf16_t* orow, int lane) {
    const f32x4* xr = (const f32x4*)xrow + lane; const f32x4* gr = (const f32x4*)g + lane;
    f32x4 v[4]; float s = 0.f;
#pragma unroll
    for (int j = 0; j < 4; ++j) { v[j] = xr[64 * j]; s += (v[j].x * v[j].x + v[j].y * v[j].y) + (v[j].z * v[j].z + v[j].w * v[j].w); }
    const float rstd = rsqrtf(wave_sum(s) * (1.f / DM) + EPSN);
    u32x2* o8 = (u32x2*)orow + lane;
#pragma unroll
    for (int j = 0; j < 4; ++j) { const f32x4 gg = gr[64 * j]; u32x2 w; w.x = cvt_pk_bf16(v[j].x * rstd * gg.x, v[j].y * rstd * gg.y); w.y = cvt_pk_bf16(v[j].z * rstd * gg.z, v[j].w * rstd * gg.w); o8[64 * j] = w; }
}
__device__ __forceinline__ void p0_prologue(KPtr p, ldsp lds, int G) {
    const int tid = fresh_tid(), lane = tid & 63, wave = __builtin_amdgcn_readfirstlane(tid >> 6);
    LAS float* scr = (LAS float*)(lds + wave * 16384);
    const int gw = blockIdx.x * 8 + wave, NGW = G * 8;
    unsigned char* ws = p->ws;
    bf16_t* W1T = (bf16_t*)(ws + WS_W1T); bf16_t* W2T = (bf16_t*)(ws + WS_W2T); bf16_t* WKVT = (bf16_t*)(ws + WS_WKVT); bf16_t* WXQT = (bf16_t*)(ws + WS_WXQT);
    bf16_t* WXOT = (bf16_t*)(ws + WS_WXOT); bf16_t* WGUT = (bf16_t*)(ws + WS_WGUT); bf16_t* WDT = (bf16_t*)(ws + WS_WDT);
    constexpr int I0 = 80 * 16, I1 = 64 * 16, I2 = 32 * 16, I3 = 32 * 32, I4 = 32 * 16, I8 = 88 * 16, I10 = 44 * 32;
    constexpr int NITEMS = I0 + I1 + I2 + I3 + 4 * I4 + 2 * I8 + I10;
    for (int it = gw; it < NITEMS; it += NGW) {
        int r = it;
        if (r < I0) { const int kb = r / 80, nb = r % 80; tr_item(p->in[11], 5656, nb * 32, kb * 64, W1T, 1024, nb * 32, scr, lane); continue; } r -= I0;
        if (r < I1) { const int kb = r / 64, nb = r % 64; tr_item(p->in[11], 5656, 2576 + nb * 32, kb * 64, W1T, 1024, 2560 + nb * 32, scr, lane); continue; } r -= I1;
        if (r < I2) { const int kb = r / 32, nb = r % 32; tr_item(p->in[11], 5656, 4632 + nb * 32, kb * 64, W1T, 1024, 4608 + nb * 32, scr, lane); continue; } r -= I2;
        if (r < I3) { const int kb = r / 32, nb = r % 32; tr_item(p->in[21], 1024, nb * 32, kb * 64, W2T, 2048, nb * 32, scr, lane); continue; } r -= I3;
        if (r < I4) { const int kb = r / 32, nb = r % 32; tr_item(p->in[24], 1024, nb * 32, kb * 64, WKVT, 1024, nb * 32, scr, lane); continue; } r -= I4;
        if (r < I4) { const int kb = r / 32, nb = r % 32; tr_item(p->in[25], 1024, nb * 32, kb * 64, WKVT, 1024, 1024 + nb * 32, scr, lane); continue; } r -= I4;
        if (r < I4) { const int kb = r / 32, nb = r % 32; tr_item(p->in[27], 1024, nb * 32, kb * 64, WXQT, 1024, nb * 32, scr, lane); continue; } r -= I4;
        if (r < I4) { const int kb = r / 32, nb = r % 32; tr_item(p->in[28], 1024, nb * 32, kb * 64, WXOT, 1024, nb * 32, scr, lane); continue; } r -= I4;
        if (r < I8) { const int kb = r / 88, nb = r % 88, n0 = nb * 32; tr_item(p->in[31], FFH, n0, kb * 64, WGUT, 1024, 256 * (n0 >> 7) + (n0 & 127), scr, lane); continue; } r -= I8;
        if (r < I8) { const int kb = r / 88, nb = r % 88, n0 = nb * 32; tr_item(p->in[32], FFH, n0, kb * 64, WGUT, 1024, 256 * (n0 >> 7) + (n0 & 127) + 128, scr, lane); continue; } r -= I8;
        { const int kb = r / 32, nb = r % 32; tr_item(p->in[33], 1024, nb * 32, kb * 64, WDT, FFH, nb * 32, scr, lane); }
    }
    for (int idx = blockIdx.x * 512 + tid; idx < 256 * 1024; idx += G * 512) { const int j = idx >> 10, k = idx & 1023; float v = 0.f;
        if (j < 16) v = p->in[11][(size_t)k * 5656 + 2560 + j]; else if (j < 24) v = p->in[11][(size_t)k * 5656 + 4624 + (j - 16)];
        W1T[(size_t)(5632 + j) * 1024 + k] = f2bf(v); }
    bf16_t* U = (bf16_t*)(ws + WS_U); bf16_t* UM = (bf16_t*)(ws + WS_UM);
    for (int r = gw; r < MT + NMEMROWS; r += NGW) {
        if (r < MP) rms_row_to_bf16(p->in[0] + (size_t)r * DM, p->in[10], U + (size_t)r * DM, lane);
        else if (r < MT) rms_row_to_bf16(p->in[1] + (size_t)(r - MP) * DM, p->in[10], U + (size_t)r * DM, lane);
        else rms_row_to_bf16(p->in[2] + (size_t)(r - MT) * DM, p->in[23], UM + (size_t)(r - MT) * DM, lane);
    }
}

__device__ __forceinline__ void conv_phase(KPtr p, int G) {
    const bf16_t* PROJ = (const bf16_t*)(p->ws + WS_BIG); bf16_t* XBC = (bf16_t*)(p->ws + WS_XBC);
    const float* cw = p->in[12]; const float* cb = p->in[13]; const float* sconv = p->in[4];
    const int NIT = (MT / 8) * 192;
    for (int it = blockIdx.x * 512 + fresh_tid(); it < NIT; it += G * 512) {
        const int rg = it / 192, cg8 = it % 192, c0 = cg8 * 8, r0 = rg * 8;
        const bool samp = r0 >= MP; const int tl0 = samp ? 0 : (r0 & 2047);
        float win[11][8];
#pragma unroll
        for (int i = 0; i < 11; ++i) {
            const int rr = i - 3;
            if (rr >= 0 || tl0 > 0) { const u32x4 w = *(const u32x4*)(PROJ + (size_t)(r0 + rr) * PROJ_LD + 1024 + c0);
                win[i][0] = bflo(w.x); win[i][1] = bfhi(w.x); win[i][2] = bflo(w.y); win[i][3] = bfhi(w.y); win[i][4] = bflo(w.z); win[i][5] = bfhi(w.z); win[i][6] = bflo(w.w); win[i][7] = bfhi(w.w); }
            else if (samp) { const int b = (r0 - MP) >> 3; const float* sp = sconv + ((size_t)b * 3 + i) * XBC_LD + c0; const f32x4 a = *(const f32x4*)sp, bq = *(const f32x4*)(sp + 4);
                win[i][0] = a.x; win[i][1] = a.y; win[i][2] = a.z; win[i][3] = a.w; win[i][4] = bq.x; win[i][5] = bq.y; win[i][6] = bq.z; win[i][7] = bq.w; }
            else {
#pragma unroll
                for (int e = 0; e < 8; ++e) win[i][e] = 0.f; }
        }
        float w4[4][8], bb[8];
#pragma unroll
        for (int j = 0; j < 4; ++j) { const f32x4 a = *(const f32x4*)(cw + j * XBC_LD + c0), bq = *(const f32x4*)(cw + j * XBC_LD + c0 + 4);
            w4[j][0] = a.x; w4[j][1] = a.y; w4[j][2] = a.z; w4[j][3] = a.w; w4[j][4] = bq.x; w4[j][5] = bq.y; w4[j][6] = bq.z; w4[j][7] = bq.w; }
        { const f32x4 a = *(const f32x4*)(cb + c0), bq = *(const f32x4*)(cb + c0 + 4); bb[0] = a.x; bb[1] = a.y; bb[2] = a.z; bb[3] = a.w; bb[4] = bq.x; bb[5] = bq.y; bb[6] = bq.z; bb[7] = bq.w; }
#pragma unroll
        for (int t = 0; t < 8; ++t) { float y[8];
#pragma unroll
            for (int e = 0; e < 8; ++e) { float a = bb[e];
#pragma unroll
                for (int j = 0; j < 4; ++j) a += win[t + j][e] * w4[j][e];
                y[e] = siluf(a); }
            u32x4 w; w.x = cvt_pk_bf16(y[0], y[1]); w.y = cvt_pk_bf16(y[2], y[3]); w.z = cvt_pk_bf16(y[4], y[5]); w.w = cvt_pk_bf16(y[6], y[7]);
            *(u32x4*)(XBC + (size_t)(r0 + t) * XBC_LD + c0) = w; }
        if (samp || tl0 + 8 == 2048) {
            float* dst = samp ? (p->out + O_CONVS + (size_t)((r0 - MP) >> 3) * 3 * XBC_LD) : (p->out + O_CONVP + (size_t)(r0 >> 11) * 3 * XBC_LD);
#pragma unroll
            for (int i = 0; i < 3; ++i) { *(f32x4*)(dst + (size_t)i * XBC_LD + c0) = (f32x4){win[8 + i][0], win[8 + i][1], win[8 + i][2], win[8 + i][3]};
                *(f32x4*)(dst + (size_t)i * XBC_LD + c0 + 4) = (f32x4){win[8 + i][4], win[8 + i][5], win[8 + i][6], win[8 + i][7]}; }
        }
    }
}

#define MFMA16(a, b, c) __builtin_amdgcn_mfma_f32_16x16x32_bf16(a, b, c, 0, 0, 0)
#define LBAR() do { asm volatile("s_waitcnt lgkmcnt(0)" ::: "memory"); __builtin_amdgcn_s_barrier(); asm volatile("" ::: "memory"); } while (0)
#define LDSF(off) (*(LAS float*)(lds + (off)))
#define LDSH(off) (*(LAS unsigned short*)(lds + (off)))
#define LDSV8(off) (*(const LAS bf16x8*)(lds + (off)))

constexpr int SP_CM = 0, SP_BM = 17408, SP_BMT = 34816, SP_XT = 53248, SP_WM = 62464, SP_HB = 71680, SP_DT = 89088, SP_CUM = 89344;
__device__ __forceinline__ void ssd_prompt_unit(KPtr p, ldsp lds, int b, int h) {
    const int tid = fresh_tid(), lane = tid & 63, wid = __builtin_amdgcn_readfirstlane(tid >> 6), l15 = lane & 15, quad = lane >> 4;
    const int g = h >> 3, tq = wid >> 1, half = wid & 1;
    const bf16_t* XBC = (const bf16_t*)(p->ws + WS_XBC); const bf16_t* PROJ = (const bf16_t*)(p->ws + WS_BIG); const float* GATES = (const float*)(p->ws + WS_GATES);
    bf16_t* YPRE = (bf16_t*)(p->ws + WS_YPRE);
    const float dtb = p->in[14][h], aneg = -__expf(p->in[15][h]), dsk = p->in[16][h];
    const size_t rowbase = (size_t)b * 2048;
    for (int i = tid; i < 17408 / 4; i += 512) *(LAS unsigned*)(lds + SP_HB + i * 4) = 0u;
    f32x4 Hst[4];
#pragma unroll
    for (int i = 0; i < 4; ++i) Hst[i] = (f32x4){0.f, 0.f, 0.f, 0.f};
    u32x4 pa[3], pb[3]; float dtraw = 0.f;
    int spr[3], sgrp[3];
#pragma unroll
    for (int i = 0; i < 3; ++i) { int v = (i < 2) ? tid + 512 * i : (tid >= 256 ? tid + 768 : 1279); spr[i] = v & 31; sgrp[i] = v >> 5; }
#define SSD_COL(gi) ((gi) < 8 ? h * 64 + (gi) * 8 : ((gi) < 24 ? 1024 + g * 128 + ((gi) - 8) * 8 : 1280 + g * 128 + ((gi) - 24) * 8))
#pragma unroll
    for (int i = 0; i < 3; ++i) { const bf16_t* src_ = XBC + (rowbase + 2 * spr[i]) * XBC_LD + SSD_COL(sgrp[i]); pa[i] = *(const u32x4*)src_; pb[i] = *(const u32x4*)(src_ + XBC_LD); }
    if (wid == 0) dtraw = GATES[(rowbase + lane) * 32 + h];
    for (int ch = 0; ch < 32; ++ch) {
        const size_t crow = rowbase + (size_t)ch * 64;
        if (wid == 0) { const float dt = softplusf(dtraw + dtb); float cum = dt * aneg;
#pragma unroll
            for (int o = 1; o < 64; o <<= 1) { const float t2 = __shfl_up(cum, o); if (lane >= o) cum += t2; }
            LDSF(SP_DT + lane * 4) = dt; LDSF(SP_CUM + lane * 4) = cum; }
        LBAR();
        const float cum63 = LDSF(SP_CUM + 63 * 4);
#pragma unroll
        for (int i = 0; i < 3; ++i) { if (i < 2 || tid >= 256) { const int gi = sgrp[i], sp = spr[i]; const unsigned wa[4] = {pa[i].x, pa[i].y, pa[i].z, pa[i].w}, wb[4] = {pb[i].x, pb[i].y, pb[i].z, pb[i].w};
            if (gi < 8) { const int p0 = gi * 8;
#pragma unroll
                for (int e = 0; e < 4; ++e) { *(LAS unsigned*)(lds + SP_XT + (p0 + 2 * e) * 144 + sp * 4) = (wa[e] & 0xffffu) | (wb[e] << 16); *(LAS unsigned*)(lds + SP_XT + (p0 + 2 * e + 1) * 144 + sp * 4) = (wa[e] >> 16) | (wb[e] & 0xffff0000u); } }
            else if (gi < 24) { const int n0 = (gi - 8) * 8; *(LAS u32x4*)(lds + SP_BM + (2 * sp) * 272 + n0 * 2) = pa[i]; *(LAS u32x4*)(lds + SP_BM + (2 * sp + 1) * 272 + n0 * 2) = pb[i];
                const f32x2 cs = *(const LAS f32x2*)(lds + SP_CUM + sp * 8), ds = *(const LAS f32x2*)(lds + SP_DT + sp * 8);
                const float wea = __expf(cum63 - cs.x) * ds.x, web = __expf(cum63 - cs.y) * ds.y;
#pragma unroll
                for (int e = 0; e < 4; ++e) { *(LAS unsigned*)(lds + SP_BMT + (n0 + 2 * e) * 144 + sp * 4) = cvt_pk_bf16(bflo(wa[e]) * wea, bflo(wb[e]) * web); *(LAS unsigned*)(lds + SP_BMT + (n0 + 2 * e + 1) * 144 + sp * 4) = cvt_pk_bf16(bfhi(wa[e]) * wea, bfhi(wb[e]) * web); } }
            else { *(LAS u32x4*)(lds + SP_CM + (2 * sp) * 272 + (gi - 24) * 16) = pa[i]; *(LAS u32x4*)(lds + SP_CM + (2 * sp + 1) * 272 + (gi - 24) * 16) = pb[i]; } } }
        if (ch + 1 < 32) {
#pragma unroll
            for (int i = 0; i < 3; ++i) { const bf16_t* src_ = XBC + (crow + 64 + 2 * spr[i]) * XBC_LD + SSD_COL(sgrp[i]); pa[i] = *(const u32x4*)src_; pb[i] = *(const u32x4*)(src_ + XBC_LD); }
            if (wid == 0) dtraw = GATES[(crow + 64 + lane) * 32 + h];
        }
        const int t = tq * 16 + l15;
        u32x2 zr[2];
#pragma unroll
        for (int pt2 = 0; pt2 < 2; ++pt2) zr[pt2] = *(const u32x2*)(PROJ + (crow + t) * PROJ_LD + h * 64 + (2 * half + pt2) * 16 + quad * 4);
        LBAR();
        const float cum_t = LDSF(SP_CUM + t * 4);
        {
            f32x4 cbv[2] = {(f32x4){0.f, 0.f, 0.f, 0.f}, (f32x4){0.f, 0.f, 0.f, 0.f}};
#pragma unroll
            for (int ks = 0; ks < 4; ++ks) { const bf16x8 bfr = LDSV8(SP_CM + t * 272 + ks * 64 + quad * 16);
#pragma unroll
                for (int s2 = 0; s2 < 2; ++s2) { const bf16x8 afr = LDSV8(SP_BM + ((2 * half + s2) * 16 + l15) * 272 + ks * 64 + quad * 16); cbv[s2] = MFMA16(afr, bfr, cbv[s2]); } }
#pragma unroll
            for (int s2 = 0; s2 < 2; ++s2) { const int s0 = (2 * half + s2) * 16 + quad * 4; const f32x4 cs = *(const LAS f32x4*)(lds + SP_CUM + s0 * 4), ds = *(const LAS f32x4*)(lds + SP_DT + s0 * 4);
                float wv[4];
#pragma unroll
                for (int j = 0; j < 4; ++j) wv[j] = (s0 + j <= t) ? cbv[s2][j] * __expf(cum_t - cs[j]) * ds[j] : 0.f;
                u32x2 o; o.x = cvt_pk_bf16(wv[0], wv[1]); o.y = cvt_pk_bf16(wv[2], wv[3]); *(LAS u32x2*)(lds + SP_WM + t * 144 + s0 * 2) = o; }
        }
        LBAR();
        {
            f32x4 ya[2] = {(f32x4){0.f, 0.f, 0.f, 0.f}, (f32x4){0.f, 0.f, 0.f, 0.f}};
#pragma unroll
            for (int ks = 0; ks < 4; ++ks) { const bf16x8 bfr = LDSV8(SP_CM + t * 272 + ks * 64 + quad * 16);
#pragma unroll
                for (int p2 = 0; p2 < 2; ++p2) { const bf16x8 afr = LDSV8(SP_HB + ((2 * half + p2) * 16 + l15) * 272 + ks * 64 + quad * 16); ya[p2] = MFMA16(afr, bfr, ya[p2]); } }
            const float ec = __expf(cum_t); ya[0] = ya[0] * ec; ya[1] = ya[1] * ec;
#pragma unroll
            for (int ks = 0; ks < 2; ++ks) { const bf16x8 bfr = LDSV8(SP_WM + t * 144 + ks * 64 + quad * 16);
#pragma unroll
                for (int p2 = 0; p2 < 2; ++p2) { const bf16x8 afr = LDSV8(SP_XT + ((2 * half + p2) * 16 + l15) * 144 + ks * 64 + quad * 16); ya[p2] = MFMA16(afr, bfr, ya[p2]); } }
#pragma unroll
            for (int p2 = 0; p2 < 2; ++p2) { const int p0 = (2 * half + p2) * 16 + quad * 4; float yv[4]; const float zz[4] = {bflo(zr[p2].x), bfhi(zr[p2].x), bflo(zr[p2].y), bfhi(zr[p2].y)};
#pragma unroll
                for (int j = 0; j < 4; ++j) { const float xv = bf2f(LDSH(SP_XT + (p0 + j) * 144 + t * 2)); yv[j] = (ya[p2][j] + dsk * xv) * siluf(zz[j]); }
                u32x2 o; o.x = cvt_pk_bf16(yv[0], yv[1]); o.y = cvt_pk_bf16(yv[2], yv[3]); *(u32x2*)(YPRE + (crow + t) * YP_LD + h * 64 + p0) = o; }
        }
        {
            const float eend = __expf(cum63);
#pragma unroll
            for (int i = 0; i < 4; ++i) Hst[i] = Hst[i] * eend;
#pragma unroll
            for (int ks = 0; ks < 2; ++ks) { const bf16x8 afr = LDSV8(SP_BMT + (wid * 16 + l15) * 144 + ks * 64 + quad * 16);
#pragma unroll
                for (int pt = 0; pt < 4; ++pt) { const bf16x8 bfr = LDSV8(SP_XT + (pt * 16 + l15) * 144 + ks * 64 + quad * 16); Hst[pt] = MFMA16(afr, bfr, Hst[pt]); } }
        }
        LBAR();
#pragma unroll
        for (int pt = 0; pt < 4; ++pt) { u32x2 o; o.x = cvt_pk_bf16(Hst[pt][0], Hst[pt][1]); o.y = cvt_pk_bf16(Hst[pt][2], Hst[pt][3]);
            *(LAS u32x2*)(lds + SP_HB + (pt * 16 + l15) * 272 + (wid * 16 + quad * 4) * 2) = o; }
    }
    float* so = p->out + O_SSMP + (size_t)(b * 16 + h) * 64 * 128;
#pragma unroll
    for (int pt = 0; pt < 4; ++pt) *(f32x4*)(so + (size_t)(pt * 16 + l15) * 128 + wid * 16 + quad * 4) = Hst[pt];
    __syncthreads();
}

constexpr int ML_QM = 0, ML_KM = 17408, ML_KMT = 34816, ML_VT = 53248, ML_SM = 64768, ML_CBT = 73984, ML_AV = 95744, ML_MV = 96000, ML_EM = 96256, ML_SI = 96512, ML_SC = 96768;
__device__ __forceinline__ void mlstm_prompt_unit(KPtr p, ldsp lds, int b, int head, int vq) {
    const int tid = fresh_tid(), lane = tid & 63, wid = __builtin_amdgcn_readfirstlane(tid >> 6), l15 = lane & 15, quad = lane >> 4;
    const int tq = wid >> 1, half = wid & 1;
    const bf16_t* PROJ = (const bf16_t*)(p->ws + WS_BIG); const float* GATES = (const float*)(p->ws + WS_GATES); bf16_t* YPRE = (bf16_t*)(p->ws + WS_YPRE);
    const float bi = p->in[18][head], bfg = p->in[19][head];
    const float qscale = 0.08838834764831845f;
    const size_t rowbase = (size_t)b * 2048;
    for (int i = tid; i < 21760 / 4; i += 512) *(LAS unsigned*)(lds + ML_CBT + i * 4) = 0u;
    for (int i = tid; i < 16 * 144 / 4; i += 512) { const int off = i * 4; *(LAS unsigned*)(lds + ML_VT + 64 * 144 + off) = (off < 128) ? 0x3F803F80u : 0u; }
    f32x4 Cst[5];
#pragma unroll
    for (int i = 0; i < 5; ++i) Cst[i] = (f32x4){0.f, 0.f, 0.f, 0.f};
    float mprev = 0.f, igr = 0.f, fgr = 0.f;
    u32x4 pa[3], pb[3]; int spr[3], sgrp[3];
#pragma unroll
    for (int i = 0; i < 3; ++i) { int v = (i < 2) ? tid + 512 * i : (tid >= 256 ? tid + 768 : 1279); spr[i] = v & 31; sgrp[i] = v >> 5; }
#define ML_COL(gi) ((gi) < 16 ? 2560 + head * 128 + (gi) * 8 : ((gi) < 32 ? 3072 + head * 128 + ((gi) - 16) * 8 : 3584 + head * 256 + vq * 64 + ((gi) - 32) * 8))
#pragma unroll
    for (int i = 0; i < 3; ++i) { const bf16_t* src_ = PROJ + (rowbase + 2 * spr[i]) * PROJ_LD + ML_COL(sgrp[i]); pa[i] = *(const u32x4*)src_; pb[i] = *(const u32x4*)(src_ + PROJ_LD); }
    if (wid == 0) { igr = GATES[(rowbase + lane) * 32 + 16 + head]; fgr = GATES[(rowbase + lane) * 32 + 20 + head]; }
    for (int ch = 0; ch < 32; ++ch) {
        const size_t crow = rowbase + (size_t)ch * 64;
        if (wid == 0) {
            const float iv = igr + bi, x = fgr + bfg; const float logf = fminf(x, 0.f) - __logf(1.f + __expf(-fabsf(x)));
            float bc = logf;
#pragma unroll
            for (int o = 1; o < 64; o <<= 1) { const float t2 = __shfl_up(bc, o); if (lane >= o) bc += t2; }
            const float a = iv - bc; float pm = a;
#pragma unroll
            for (int o = 1; o < 64; o <<= 1) { const float t2 = __shfl_up(pm, o); if (lane >= o) pm = fmaxf(pm, t2); }
            const float M = fmaxf(pm, mprev);
            LDSF(ML_AV + lane * 4) = a; LDSF(ML_MV + lane * 4) = M; LDSF(ML_EM + lane * 4) = __expf(-(bc + M)); LDSF(ML_SI + lane * 4) = __expf(mprev - M) * qscale;
            const float M63 = __shfl(M, 63), bc63 = __shfl(bc, 63);
            if (lane == 0) { LDSF(ML_SC) = M63; LDSF(ML_SC + 4) = __expf(mprev - M63); }
            mprev = bc63 + M63;
        }
        LBAR();
        const float M63 = LDSF(ML_SC), scaleC = LDSF(ML_SC + 4);
#pragma unroll
        for (int i = 0; i < 3; ++i) { if (i < 2 || tid >= 256) { const int gi = sgrp[i], sp = spr[i]; const unsigned wa[4] = {pa[i].x, pa[i].y, pa[i].z, pa[i].w}, wb[4] = {pb[i].x, pb[i].y, pb[i].z, pb[i].w};
            if (gi < 16) { *(LAS u32x4*)(lds + ML_QM + (2 * sp) * 272 + gi * 16) = pa[i]; *(LAS u32x4*)(lds + ML_QM + (2 * sp + 1) * 272 + gi * 16) = pb[i]; }
            else if (gi < 32) { const int d0 = (gi - 16) * 8; *(LAS u32x4*)(lds + ML_KM + (2 * sp) * 272 + d0 * 2) = pa[i]; *(LAS u32x4*)(lds + ML_KM + (2 * sp + 1) * 272 + d0 * 2) = pb[i];
                const f32x2 av = *(const LAS f32x2*)(lds + ML_AV + sp * 8); const float wea = __expf(av.x - M63), web = __expf(av.y - M63);
#pragma unroll
                for (int e = 0; e < 4; ++e) { *(LAS unsigned*)(lds + ML_KMT + (d0 + 2 * e) * 144 + sp * 4) = cvt_pk_bf16(bflo(wa[e]) * wea, bflo(wb[e]) * web); *(LAS unsigned*)(lds + ML_KMT + (d0 + 2 * e + 1) * 144 + sp * 4) = cvt_pk_bf16(bfhi(wa[e]) * wea, bfhi(wb[e]) * web); } }
            else { const int v0 = (gi - 32) * 8;
#pragma unroll
                for (int e = 0; e < 4; ++e) { *(LAS unsigned*)(lds + ML_VT + (v0 + 2 * e) * 144 + sp * 4) = (wa[e] & 0xffffu) | (wb[e] << 16); *(LAS unsigned*)(lds + ML_VT + (v0 + 2 * e + 1) * 144 + sp * 4) = (wa[e] >> 16) | (wb[e] & 0xffff0000u); } } } }
        if (ch + 1 < 32) {
#pragma unroll
            for (int i = 0; i < 3; ++i) { const bf16_t* src_ = PROJ + (crow + 64 + 2 * spr[i]) * PROJ_LD + ML_COL(sgrp[i]); pa[i] = *(const u32x4*)src_; pb[i] = *(const u32x4*)(src_ + PROJ_LD); }
            if (wid == 0) { igr = GATES[(crow + 64 + lane) * 32 + 16 + head]; fgr = GATES[(crow + 64 + lane) * 32 + 20 + head]; }
        }
        LBAR();
        const int t = tq * 16 + l15;
        const float M_t = LDSF(ML_MV + t * 4);
        {
            f32x4 sv[2] = {(f32x4){0.f, 0.f, 0.f, 0.f}, (f32x4){0.f, 0.f, 0.f, 0.f}};
#pragma unroll
            for (int ks = 0; ks < 4; ++ks) { const bf16x8 bfr = LDSV8(ML_QM + t * 272 + ks * 64 + quad * 16);
#pragma unroll
                for (int s2 = 0; s2 < 2; ++s2) { const bf16x8 afr = LDSV8(ML_KM + ((2 * half + s2) * 16 + l15) * 272 + ks * 64 + quad * 16); sv[s2] = MFMA16(afr, bfr, sv[s2]); } }
#pragma unroll
            for (int s2 = 0; s2 < 2; ++s2) { const int s0 = (2 * half + s2) * 16 + quad * 4; const f32x4 as = *(const LAS f32x4*)(lds + ML_AV + s0 * 4); float wv[4];
#pragma unroll
                for (int j = 0; j < 4; ++j) wv[j] = (s0 + j <= t) ? sv[s2][j] * qscale * __expf(as[j] - M_t) : 0.f;
                u32x2 o; o.x = cvt_pk_bf16(wv[0], wv[1]); o.y = cvt_pk_bf16(wv[2], wv[3]); *(LAS u32x2*)(lds + ML_SM + t * 144 + s0 * 2) = o; }
        }
        LBAR();
        {
            f32x4 na[3] = {(f32x4){0.f, 0.f, 0.f, 0.f}, (f32x4){0.f, 0.f, 0.f, 0.f}, (f32x4){0.f, 0.f, 0.f, 0.f}};
#pragma unroll
            for (int ks = 0; ks < 4; ++ks) { const bf16x8 bfr = LDSV8(ML_QM + t * 272 + ks * 64 + quad * 16);
#pragma unroll
                for (int v2 = 0; v2 < 3; ++v2) { const int vt = v2 < 2 ? 2 * half + v2 : 4; const bf16x8 afr = LDSV8(ML_CBT + (vt * 16 + l15) * 272 + ks * 64 + quad * 16); na[v2] = MFMA16(afr, bfr, na[v2]); } }
            const float si = LDSF(ML_SI + t * 4);
#pragma unroll
            for (int v2 = 0; v2 < 3; ++v2) na[v2] = na[v2] * si;
#pragma unroll
            for (int ks = 0; ks < 2; ++ks) { const bf16x8 bfr = LDSV8(ML_SM + t * 144 + ks * 64 + quad * 16);
#pragma unroll
                for (int v2 = 0; v2 < 3; ++v2) { const int vt = v2 < 2 ? 2 * half + v2 : 4; const bf16x8 afr = LDSV8(ML_VT + (vt * 16 + l15) * 144 + ks * 64 + quad * 16); na[v2] = MFMA16(afr, bfr, na[v2]); } }
            const float den = __shfl(na[2][0], l15);
            const float dn = __builtin_amdgcn_rcpf(fmaxf(fabsf(den), LDSF(ML_EM + t * 4)));
#pragma unroll
            for (int v2 = 0; v2 < 2; ++v2) { const int v0 = (2 * half + v2) * 16 + quad * 4; u32x2 o; o.x = cvt_pk_bf16(na[v2][0] * dn, na[v2][1] * dn); o.y = cvt_pk_bf16(na[v2][2] * dn, na[v2][3] * dn);
                *(u32x2*)(YPRE + (crow + t) * YP_LD + 1024 + head * 256 + vq * 64 + v0) = o; }
        }
        {
#pragma unroll
            for (int i = 0; i < 5; ++i) Cst[i] = Cst[i] * scaleC;
#pragma unroll
            for (int ks = 0; ks < 2; ++ks) { const bf16x8 afr = LDSV8(ML_KMT + (wid * 16 + l15) * 144 + ks * 64 + quad * 16);
#pragma unroll
                for (int vt = 0; vt < 5; ++vt) { const bf16x8 bfr = LDSV8(ML_VT + (vt * 16 + l15) * 144 + ks * 64 + quad * 16); Cst[vt] = MFMA16(afr, bfr, Cst[vt]); } }
        }
        LBAR();
#pragma unroll
        for (int vt = 0; vt < 5; ++vt) { u32x2 o; o.x = cvt_pk_bf16(Cst[vt][0], Cst[vt][1]); o.y = cvt_pk_bf16(Cst[vt][2], Cst[vt][3]);
            *(LAS u32x2*)(lds + ML_CBT + (vt * 16 + l15) * 272 + (wid * 16 + quad * 4) * 2) = o; }
    }
    float* co = p->out + O_MCP + (size_t)(b * 4 + head) * 128 * 256;
#pragma unroll
    for (int vt = 0; vt < 4; ++vt)
#pragma unroll
        for (int j = 0; j < 4; ++j) co[(size_t)(wid * 16 + quad * 4 + j) * 256 + vq * 64 + vt * 16 + l15] = Cst[vt][j];
    if (vq == 0) {
        if (l15 == 0) *(f32x4*)(p->out + O_MNP + (size_t)(b * 4 + head) * 128 + wid * 16 + quad * 4) = Cst[4];
        if (tid == 0) p->out[O_MMP + b * 4 + head] = mprev;
    }
    __syncthreads();
}

constexpr int SS_X = 0, SS_B = 2048, SS_C = 6144, SS_DT = 10240, SS_CUM = 10272, SS_W = 10304;
__device__ __forceinline__ void ssd_sample_unit(KPtr p, ldsp lds, int b, int h) {
    const int tid = fresh_tid(); const int g = h >> 3;
    const bf16_t* XBC = (const bf16_t*)(p->ws + WS_XBC); const bf16_t* PROJ = (const bf16_t*)(p->ws + WS_BIG); const float* GATES = (const float*)(p->ws + WS_GATES); bf16_t* YPRE = (bf16_t*)(p->ws + WS_YPRE);
    const float dtb = p->in[14][h], aneg = -__expf(p->in[15][h]), dsk = p->in[16][h];
    const size_t r0 = (size_t)MP + (size_t)b * 8;
    const int pp = tid >> 3, ns = tid & 7;
    const float* hp = p->in[3] + ((size_t)(b * 16 + h) * 64 + pp) * 128 + ns * 16;
    f32x4 h0[4];
#pragma unroll
    for (int i = 0; i < 4; ++i) h0[i] = *(const f32x4*)(hp + 4 * i);
    if (tid < 320) {
        const int kind = tid < 64 ? 0 : (tid < 192 ? 1 : 2), i = kind == 0 ? tid : (kind == 1 ? tid - 64 : tid - 192);
        const int t = kind == 0 ? (i >> 3) : (i >> 4), c8 = kind == 0 ? (i & 7) * 8 : (i & 15) * 8;
        const int col = kind == 0 ? h * 64 + c8 : (kind == 1 ? 1024 : 1280) + g * 128 + c8;
        const int off = kind == 0 ? SS_X + (t * 64 + c8) * 4 : (kind == 1 ? SS_B : SS_C) + (t * 128 + c8) * 4;
        const u32x4 w = *(const u32x4*)(XBC + (r0 + t) * XBC_LD + col);
        *(LAS f32x4*)(lds + off) = (f32x4){bflo(w.x), bfhi(w.x), bflo(w.y), bfhi(w.y)}; *(LAS f32x4*)(lds + off + 16) = (f32x4){bflo(w.z), bfhi(w.z), bflo(w.w), bfhi(w.w)}; }
    if (tid < 8) { float c = 0.f, dtm = 0.f;
#pragma unroll
        for (int u = 0; u < 8; ++u) { const float d = softplusf(GATES[(r0 + u) * 32 + h] + dtb); c += (u <= tid) ? d * aneg : 0.f; dtm = (u == tid) ? d : dtm; }
        LDSF(SS_DT + tid * 4) = dtm; LDSF(SS_CUM + tid * 4) = c; }
    const float zv = bf2f(PROJ[(r0 + ns) * PROJ_LD + h * 64 + pp]);
    __syncthreads();
    if (tid < 64) { const int t = tid >> 3, s = tid & 7; float cbv = 0.f;
        for (int n = 0; n < 128; ++n) cbv += LDSF(SS_C + (t * 128 + n) * 4) * LDSF(SS_B + (s * 128 + n) * 4);
        LDSF(SS_W + tid * 4) = (s <= t) ? cbv * __expf(LDSF(SS_CUM + t * 4) - LDSF(SS_CUM + s * 4)) * LDSF(SS_DT + s * 4) : 0.f; }
    float part[8];
#pragma unroll
    for (int t = 0; t < 8; ++t) { float a = 0.f;
#pragma unroll
        for (int i = 0; i < 4; ++i) { const f32x4 cv = *(const LAS f32x4*)(lds + SS_C + (t * 128 + ns * 16 + i * 4) * 4); a += cv.x * h0[i].x + cv.y * h0[i].y + cv.z * h0[i].z + cv.w * h0[i].w; }
        a += __shfl_xor(a, 1); a += __shfl_xor(a, 2); a += __shfl_xor(a, 4); part[t] = a; }
    __syncthreads();
    {
        float yi = part[0];
#pragma unroll
        for (int t = 1; t < 8; ++t) yi = (ns == t) ? part[t] : yi;
        const int t = ns; float y = yi * __expf(LDSF(SS_CUM + t * 4));
#pragma unroll
        for (int s = 0; s < 8; ++s) y += LDSF(SS_W + (t * 8 + s) * 4) * LDSF(SS_X + (s * 64 + pp) * 4);
        y += dsk * LDSF(SS_X + (t * 64 + pp) * 4);
        YPRE[(r0 + t) * YP_LD + h * 64 + pp] = f2bf(y * siluf(zv));
    }
    const float cum7 = LDSF(SS_CUM + 7 * 4), e7 = __expf(cum7);
    f32x4 hn[4];
#pragma unroll
    for (int i = 0; i < 4; ++i) hn[i] = h0[i] * e7;
#pragma unroll
    for (int s = 0; s < 8; ++s) { const float wx = __expf(cum7 - LDSF(SS_CUM + s * 4)) * LDSF(SS_DT + s * 4) * LDSF(SS_X + (s * 64 + pp) * 4);
#pragma unroll
        for (int i = 0; i < 4; ++i) { const f32x4 bv = *(const LAS f32x4*)(lds + SS_B + (s * 128 + ns * 16 + i * 4) * 4); hn[i] = hn[i] + bv * wx; } }
    float* ho = p->out + O_SSMS + ((size_t)(b * 16 + h) * 64 + pp) * 128 + ns * 16;
#pragma unroll
    for (int i = 0; i < 4; ++i) *(f32x4*)(ho + 4 * i) = hn[i];
    __syncthreads();
}

constexpr int MS_Q = 0, MS_K = 4096, MS_V = 8192, MS_I = 12288, MS_LF = 12320, MS_A = 12352, MS_M = 12384, MS_EM = 12416, MS_SI = 12448, MS_WE = 12480, MS_DEN = 12512, MS_SC = 12544, MS_S = 12608, MS_N0 = 12864, MS_RED = 16384;
__device__ __forceinline__ void mlstm_sample_unit(KPtr p, ldsp lds, int b, int head, int vh) {
    const int tid = fresh_tid(), lane = tid & 63, wid = __builtin_amdgcn_readfirstlane(tid >> 6);
    const bf16_t* PROJ = (const bf16_t*)(p->ws + WS_BIG); const float* GATES = (const float*)(p->ws + WS_GATES); bf16_t* YPRE = (bf16_t*)(p->ws + WS_YPRE);
    const float bi = p->in[18][head], bfg = p->in[19][head]; const float qscale = 0.08838834764831845f;
    const size_t r0 = (size_t)MP + (size_t)b * 8;
    const float mprev = p->in[7][b * 4 + head];
    const int dsg = tid >> 5, vq4 = tid & 31;
    const float* cp = p->in[5] + ((size_t)(b * 4 + head) * 128 + dsg * 8) * 256 + vh * 128 + vq4 * 4;
    f32x4 Cr[8];
#pragma unroll
    for (int i = 0; i < 8; ++i) Cr[i] = *(const f32x4*)(cp + (size_t)i * 256);
    if (tid < 384) {
        const int kind = tid >> 7, i = tid & 127, t = i >> 4, c8 = (i & 15) * 8;
        const int col = kind == 0 ? 2560 + head * 128 + c8 : (kind == 1 ? 3072 + head * 128 + c8 : 3584 + head * 256 + vh * 128 + c8);
        const int off = (kind == 0 ? MS_Q : (kind == 1 ? MS_K : MS_V)) + (t * 128 + c8) * 4; const float sc = kind == 0 ? qscale : 1.f;
        const u32x4 w = *(const u32x4*)(PROJ + (r0 + t) * PROJ_LD + col);
        *(LAS f32x4*)(lds + off) = (f32x4){bflo(w.x), bfhi(w.x), bflo(w.y), bfhi(w.y)} * sc; *(LAS f32x4*)(lds + off + 16) = (f32x4){bflo(w.z), bfhi(w.z), bflo(w.w), bfhi(w.w)} * sc; }
    if (tid < 128) LDSF(MS_N0 + tid * 4) = p->in[6][(size_t)(b * 4 + head) * 128 + tid];
    if (tid < 8) { const float x = GATES[(r0 + tid) * 32 + 20 + head] + bfg; LDSF(MS_I + tid * 4) = GATES[(r0 + tid) * 32 + 16 + head] + bi;
        LDSF(MS_LF + tid * 4) = fminf(x, 0.f) - __logf(1.f + __expf(-fabsf(x))); }
    __syncthreads();
    if (tid < 8) { float bc = 0.f, am = -3.0e38f, a = 0.f;
        for (int s = 0; s <= tid; ++s) { bc += LDSF(MS_LF + s * 4); a = LDSF(MS_I + s * 4) - bc; am = fmaxf(am, a); }
        const float M = fmaxf(am, mprev);
        LDSF(MS_A + tid * 4) = a; LDSF(MS_M + tid * 4) = M; LDSF(MS_EM + tid * 4) = __expf(-(bc + M)); LDSF(MS_SI + tid * 4) = __expf(mprev - M);
        if (tid == 7) { LDSF(MS_SC) = __expf(mprev - M); LDSF(MS_SC + 4) = bc + M; } }
    __syncthreads();
    if (tid < 8) LDSF(MS_WE + tid * 4) = __expf(LDSF(MS_A + tid * 4) - LDSF(MS_M + 7 * 4));
    if (tid < 64) { const int t = tid >> 3, s = tid & 7; float a = 0.f;
        for (int d = 0; d < 128; ++d) a += LDSF(MS_Q + (t * 128 + d) * 4) * LDSF(MS_K + (s * 128 + d) * 4);
        LDSF(MS_S + tid * 4) = (s <= t) ? a * __expf(LDSF(MS_A + s * 4) - LDSF(MS_M + t * 4)) : 0.f; }
    {
#pragma unroll
        for (int t = 0; t < 8; ++t) { f32x4 a = (f32x4){0.f, 0.f, 0.f, 0.f};
#pragma unroll
            for (int dd = 0; dd < 8; ++dd) { const float qv = LDSF(MS_Q + (t * 128 + dsg * 8 + dd) * 4); a = a + Cr[dd] * qv; }
            a.x += __shfl_xor(a.x, 32); a.y += __shfl_xor(a.y, 32); a.z += __shfl_xor(a.z, 32); a.w += __shfl_xor(a.w, 32);
            if (lane < 32) *(LAS f32x4*)(lds + MS_RED + ((wid * 8 + t) * 128 + vq4 * 4) * 4) = a; }
    }
    __syncthreads();
    if (tid < 8) { float d = 0.f, qn = 0.f; for (int s = 0; s < 8; ++s) d += LDSF(MS_S + (tid * 8 + s) * 4);
        for (int dd = 0; dd < 128; ++dd) qn += LDSF(MS_Q + (tid * 128 + dd) * 4) * LDSF(MS_N0 + dd * 4);
        LDSF(MS_DEN + tid * 4) = d + LDSF(MS_SI + tid * 4) * qn; }
    __syncthreads();
    { const int t = tid >> 6, v2 = (tid & 63) * 2; const float si = LDSF(MS_SI + t * 4); const float dn = 1.f / fmaxf(fabsf(LDSF(MS_DEN + t * 4)), LDSF(MS_EM + t * 4)); float r[2];
#pragma unroll
        for (int e = 0; e < 2; ++e) { const int v = v2 + e; float ni = 0.f;
#pragma unroll
            for (int w = 0; w < 8; ++w) ni += LDSF(MS_RED + ((w * 8 + t) * 128 + v) * 4);
            float num = ni * si;
#pragma unroll
            for (int s = 0; s < 8; ++s) num += LDSF(MS_S + (t * 8 + s) * 4) * LDSF(MS_V + (s * 128 + v) * 4);
            r[e] = num * dn; }
        *(unsigned*)(YPRE + (r0 + t) * YP_LD + 1024 + head * 256 + vh * 128 + v2) = cvt_pk_bf16(r[0], r[1]); }
    const float scaleC = LDSF(MS_SC);
#pragma unroll
    for (int i = 0; i < 8; ++i) Cr[i] = Cr[i] * scaleC;
#pragma unroll
    for (int s = 0; s < 8; ++s) { const float we = LDSF(MS_WE + s * 4); const f32x4 vv = *(const LAS f32x4*)(lds + MS_V + (s * 128 + vq4 * 4) * 4) * we;
#pragma unroll
        for (int i = 0; i < 8; ++i) Cr[i] = Cr[i] + vv * LDSF(MS_K + (s * 128 + dsg * 8 + i) * 4); }
    float* co = p->out + O_MCS + ((size_t)(b * 4 + head) * 128 + dsg * 8) * 256 + vh * 128 + vq4 * 4;
#pragma unroll
    for (int i = 0; i < 8; ++i) *(f32x4*)(co + (size_t)i * 256) = Cr[i];
    if (vh == 0) {
        if (tid < 128) { float n = scaleC * LDSF(MS_N0 + tid * 4); for (int s = 0; s < 8; ++s) n += LDSF(MS_WE + s * 4) * LDSF(MS_K + (s * 128 + tid) * 4); p->out[O_MNS + (size_t)(b * 4 + head) * 128 + tid] = n; }
        if (tid == 0) p->out[O_MMS + b * 4 + head] = LDSF(MS_SC + 4);
    }
    __syncthreads();
}

__device__ __forceinline__ void norm_phase(KPtr p, int G) {
    const int tid_ = fresh_tid(); const int lane = tid_ & 63, wave = tid_ >> 6; const int gw = blockIdx.x * 8 + wave, NGW = G * 8;
    const bf16_t* YPRE = (const bf16_t*)(p->ws + WS_YPRE); const bf16_t* PROJ = (const bf16_t*)(p->ws + WS_BIG); bf16_t* A2 = (bf16_t*)(p->ws + WS_A2);
    const float* gs = p->in[17]; const float* gm = p->in[20];
    for (int r = gw; r < MT; r += NGW) {
        const bf16_t* yr = YPRE + (size_t)r * YP_LD; bf16_t* ar = A2 + (size_t)r * YP_LD;
#pragma unroll
        for (int i = 0; i < 4; ++i) {
            const int c0 = i * 512 + lane * 8; const u32x4 w = *(const u32x4*)(yr + c0);
            float v[8] = {bflo(w.x), bfhi(w.x), bflo(w.y), bfhi(w.y), bflo(w.z), bfhi(w.z), bflo(w.w), bfhi(w.w)};
            float s = 0.f;
#pragma unroll
            for (int e = 0; e < 8; ++e) s += v[e] * v[e];
            float rstd; float gg[8];
            if (i < 2) { rstd = rsqrtf(wave_sum(s) * (1.f / 512.f) + EPSN);
                const f32x4 a = *(const f32x4*)(gs + c0), bq = *(const f32x4*)(gs + c0 + 4); gg[0] = a.x; gg[1] = a.y; gg[2] = a.z; gg[3] = a.w; gg[4] = bq.x; gg[5] = bq.y; gg[6] = bq.z; gg[7] = bq.w; }
            else {
#pragma unroll
                for (int o = 1; o < 32; o <<= 1) s += __shfl_xor(s, o);
                rstd = rsqrtf(s * (1.f / 256.f) + EPSN);
                const int cm = c0 - 1024; const f32x4 a = *(const f32x4*)(gm + cm), bq = *(const f32x4*)(gm + cm + 4); const u32x4 og = *(const u32x4*)(PROJ + (size_t)r * PROJ_LD + 4608 + cm);
                const float ov[8] = {bflo(og.x), bfhi(og.x), bflo(og.y), bfhi(og.y), bflo(og.z), bfhi(og.z), bflo(og.w), bfhi(og.w)};
                gg[0] = a.x; gg[1] = a.y; gg[2] = a.z; gg[3] = a.w; gg[4] = bq.x; gg[5] = bq.y; gg[6] = bq.z; gg[7] = bq.w;
#pragma unroll
                for (int e = 0; e < 8; ++e) gg[e] *= sigmoidf_(ov[e]); }
            u32x4 o; o.x = cvt_pk_bf16(v[0] * rstd * gg[0], v[1] * rstd * gg[1]); o.y = cvt_pk_bf16(v[2] * rstd * gg[2], v[3] * rstd * gg[3]);
            o.z = cvt_pk_bf16(v[4] * rstd * gg[4], v[5] * rstd * gg[5]); o.w = cvt_pk_bf16(v[6] * rstd * gg[6], v[7] * rstd * gg[7]);
            *(u32x4*)(ar + c0) = o;
        }
    }
}

template <bool FIRST, bool LASTP, bool PART = false>
__device__ __forceinline__ void row_phase(KPtr p, int wg0, int nwg, int r_lo, int r_hi, const float* gpost, const float* gpre) {
    const int tid_ = fresh_tid(); const int lane = tid_ & 63, wave = tid_ >> 6; const int gw = ((int)blockIdx.x - wg0) * 8 + wave, NGW = nwg * 8;
    const bf16_t* R1 = (const bf16_t*)(p->ws + WS_R1); bf16_t* U = (bf16_t*)(p->ws + WS_U);
    if ((int)blockIdx.x < wg0) return;
    for (int r = r_lo + gw; r < r_hi; r += NGW) {
        const float* xs = FIRST ? (r < MP ? p->in[0] + (size_t)r * DM : p->in[1] + (size_t)(r - MP) * DM) : p->out + (size_t)r * DM;
        float* xo = p->out + (size_t)r * DM;
        const u32x2* rr = (const u32x2*)(R1 + (size_t)r * DM) + lane;
        f32x4 rv[4], xv[4]; float s = 0.f;
#pragma unroll
        for (int j = 0; j < 4; ++j) { if (PART) { const f32x4* pp = (const f32x4*)(p->ws + WS_A2) + (size_t)(r - MP) * 256 + lane + 64 * j; rv[j] = pp[0] + pp[(size_t)MS * 256]; }
            else { const u32x2 w = rr[64 * j]; rv[j] = (f32x4){bflo(w.x), bfhi(w.x), bflo(w.y), bfhi(w.y)}; } xv[j] = ((const f32x4*)xs)[lane + 64 * j];
            s += (rv[j].x * rv[j].x + rv[j].y * rv[j].y) + (rv[j].z * rv[j].z + rv[j].w * rv[j].w); }
        const float rstd = rsqrtf(wave_sum(s) * (1.f / DM) + EPSN);
        float s2 = 0.f;
#pragma unroll
        for (int j = 0; j < 4; ++j) { const f32x4 gg = ((const f32x4*)gpost)[lane + 64 * j]; xv[j] = xv[j] + rv[j] * rstd * gg; ((f32x4*)xo)[lane + 64 * j] = xv[j];
            s2 += (xv[j].x * xv[j].x + xv[j].y * xv[j].y) + (xv[j].z * xv[j].z + xv[j].w * xv[j].w); }
        if (!LASTP) { const float rstd2 = rsqrtf(wave_sum(s2) * (1.f / DM) + EPSN); u32x2* uo = (u32x2*)(U + (size_t)r * DM) + lane;
#pragma unroll
            for (int j = 0; j < 4; ++j) { const f32x4 gg = ((const f32x4*)gpre)[lane + 64 * j]; u32x2 w; w.x = cvt_pk_bf16(xv[j].x * rstd2 * gg.x, xv[j].y * rstd2 * gg.y); w.y = cvt_pk_bf16(xv[j].z * rstd2 * gg.z, xv[j].w * rstd2 * gg.w); uo[64 * j] = w; } }
    }
}

constexpr int AT_K = 0, AT_V = 33792;
__device__ __forceinline__ void attn_prompt_unit(KPtr p, ldsp lds, int unit) {
    const int tid = fresh_tid(), lane = tid & 63, wid = __builtin_amdgcn_readfirstlane(tid >> 6), l15 = lane & 15, quad = lane >> 4;
    const int qb = unit & 15, head = (unit >> 4) & 3, b = unit >> 6;
    const bf16_t* QX = (const bf16_t*)(p->ws + WS_QX); const bf16_t* KM = (const bf16_t*)(p->ws + WS_KM); const bf16_t* VMT = (const bf16_t*)(p->ws + WS_VMT); bf16_t* O = (bf16_t*)(p->ws + WS_O);
    const size_t qrow = (size_t)b * 2048 + qb * 128 + wid * 16 + l15;
    bf16x8 qf[8];
#pragma unroll
    for (int ks = 0; ks < 8; ++ks) qf[ks] = *(const bf16x8*)(QX + qrow * DM + head * 256 + ks * 32 + quad * 8);
    f32x4 oa[16];
#pragma unroll
    for (int i = 0; i < 16; ++i) oa[i] = (f32x4){0.f, 0.f, 0.f, 0.f};
    float mrun = -3.0e38f, lrun = 0.f;
    for (int kt = 0; kt < 4; ++kt) {
        __syncthreads();
#pragma unroll
        for (int i = 0; i < 4; ++i) { const int v = tid + 512 * i; const int kr = v >> 5, kc = v & 31;
            *(LAS u32x4*)(lds + AT_K + kr * 528 + kc * 16) = *(const u32x4*)(KM + ((size_t)b * 256 + kt * 64 + kr) * DM + head * 256 + kc * 8);
            const int vr = v >> 3, vc = v & 7;
            *(LAS u32x4*)(lds + AT_V + vr * 144 + vc * 16) = *(const u32x4*)(VMT + ((size_t)(b * 4 + head) * 256 + vr) * 256 + kt * 64 + vc * 8); }
        __syncthreads();
        f32x4 sT[4];
#pragma unroll
        for (int k16 = 0; k16 < 4; ++k16) { sT[k16] = (f32x4){0.f, 0.f, 0.f, 0.f};
#pragma unroll
            for (int ks = 0; ks < 8; ++ks) { const bf16x8 afr = LDSV8(AT_K + (k16 * 16 + l15) * 528 + ks * 64 + quad * 16); sT[k16] = MFMA16(afr, qf[ks], sT[k16]); } }
        float mx = mrun;
#pragma unroll
        for (int k16 = 0; k16 < 4; ++k16)
#pragma unroll
            for (int j = 0; j < 4; ++j) mx = fmaxf(mx, sT[k16][j]);
        mx = fmaxf(mx, __shfl_xor(mx, 16)); mx = fmaxf(mx, __shfl_xor(mx, 32));
        const float alpha = __expf(mrun - mx); mrun = mx; float ls = 0.f;
#pragma unroll
        for (int k16 = 0; k16 < 4; ++k16)
#pragma unroll
            for (int j = 0; j < 4; ++j) { const float e = __expf(sT[k16][j] - mx); sT[k16][j] = e; ls += e; }
        lrun = lrun * alpha + ls;
#pragma unroll
        for (int i = 0; i < 16; ++i) oa[i] = oa[i] * alpha;
#pragma unroll
        for (int k2 = 0; k2 < 2; ++k2) {
            u32x4 pw; pw.x = cvt_pk_bf16(sT[2 * k2][0], sT[2 * k2][1]); pw.y = cvt_pk_bf16(sT[2 * k2][2], sT[2 * k2][3]); pw.z = cvt_pk_bf16(sT[2 * k2 + 1][0], sT[2 * k2 + 1][1]); pw.w = cvt_pk_bf16(sT[2 * k2 + 1][2], sT[2 * k2 + 1][3]);
            const bf16x8 pf = __builtin_bit_cast(bf16x8, pw);
#pragma unroll
            for (int dt = 0; dt < 16; ++dt) { const u32x2 v0 = *(const LAS u32x2*)(lds + AT_V + (dt * 16 + l15) * 144 + (k2 * 32 + quad * 4) * 2), v1 = *(const LAS u32x2*)(lds + AT_V + (dt * 16 + l15) * 144 + (k2 * 32 + 16 + quad * 4) * 2);
                u32x4 vw; vw.x = v0.x; vw.y = v0.y; vw.z = v1.x; vw.w = v1.y; oa[dt] = MFMA16(__builtin_bit_cast(bf16x8, vw), pf, oa[dt]); }
        }
    }
    lrun += __shfl_xor(lrun, 16); lrun += __shfl_xor(lrun, 32);
    const float inv = 1.f / lrun;
#pragma unroll
    for (int dt = 0; dt < 16; ++dt) { u32x2 o; o.x = cvt_pk_bf16(oa[dt][0] * inv, oa[dt][1] * inv); o.y = cvt_pk_bf16(oa[dt][2] * inv, oa[dt][3] * inv);
        *(u32x2*)(O + qrow * DM + head * 256 + dt * 16 + quad * 4) = o; }
}
constexpr int AS_S = 0, AS_P = 8192, AS_O = 16384;
__device__ __forceinline__ void attn_sample_unit(KPtr p, ldsp lds, int unit) {
    const int tid = fresh_tid(), lane = tid & 63, wid = __builtin_amdgcn_readfirstlane(tid >> 6), l15 = lane & 15, quad = lane >> 4;
    const int head = unit & 3, b = unit >> 2;
    const bf16_t* QX = (const bf16_t*)(p->ws + WS_QX); bf16_t* O = (bf16_t*)(p->ws + WS_O);
    const float* CK = p->in[8] + (size_t)b * 256 * 1024 + head * 256; const float* CV = p->in[9] + (size_t)b * 256 * 1024 + head * 256;
    const size_t r0 = (size_t)MP + (size_t)b * 8;
    bf16x8 qf[8];
#pragma unroll
    for (int ks = 0; ks < 8; ++ks) { u32x4 w = (u32x4){0u, 0u, 0u, 0u}; if (l15 < 8) w = *(const u32x4*)(QX + (r0 + l15) * DM + head * 256 + ks * 32 + quad * 8); qf[ks] = __builtin_bit_cast(bf16x8, w); }
    __syncthreads();
    {
        f32x4 ka[2][8], kb[2][8];
#pragma unroll
        for (int ps = 0; ps < 2; ++ps) { const float* kp = CK + (size_t)(ps * 128 + wid * 16 + l15) * 1024 + quad * 8;
#pragma unroll
            for (int ks = 0; ks < 8; ++ks) { ka[ps][ks] = *(const f32x4*)(kp + ks * 32); kb[ps][ks] = *(const f32x4*)(kp + ks * 32 + 4); } }
#pragma unroll
        for (int ps = 0; ps < 2; ++ps) { const int m0 = ps * 128 + wid * 16;
            f32x4 sc = (f32x4){0.f, 0.f, 0.f, 0.f};
#pragma unroll
            for (int ks = 0; ks < 8; ++ks) { u32x4 w; w.x = cvt_pk_bf16(ka[ps][ks].x, ka[ps][ks].y); w.y = cvt_pk_bf16(ka[ps][ks].z, ka[ps][ks].w); w.z = cvt_pk_bf16(kb[ps][ks].x, kb[ps][ks].y); w.w = cvt_pk_bf16(kb[ps][ks].z, kb[ps][ks].w);
                sc = MFMA16(__builtin_bit_cast(bf16x8, w), qf[ks], sc); }
            if (l15 < 8) *(LAS f32x4*)(lds + AS_S + (l15 * 256 + m0 + quad * 4) * 4) = sc; }
    }
    const float* vp = CV + (size_t)(wid * 32) * 1024 + lane * 4;
    f32x4 vA[8], vB[8];
#pragma unroll
    for (int i = 0; i < 8; ++i) vA[i] = *(const f32x4*)(vp + (size_t)i * 1024);
    LBAR();
    {
        const f32x4 s4 = *(const LAS f32x4*)(lds + AS_S + (wid * 256 + lane * 4) * 4);
        const float mx = wave_max(fmaxf(fmaxf(s4.x, s4.y), fmaxf(s4.z, s4.w)));
        const float e0 = __expf(s4.x - mx), e1 = __expf(s4.y - mx), e2 = __expf(s4.z - mx), e3 = __expf(s4.w - mx);
        const float inv = 1.f / wave_sum(e0 + e1 + e2 + e3);
        LDSF(AS_P + ((lane * 4 + 0) * 8 + wid) * 4) = e0 * inv; LDSF(AS_P + ((lane * 4 + 1) * 8 + wid) * 4) = e1 * inv;
        LDSF(AS_P + ((lane * 4 + 2) * 8 + wid) * 4) = e2 * inv; LDSF(AS_P + ((lane * 4 + 3) * 8 + wid) * 4) = e3 * inv;
    }
    LBAR();
    {
        f32x4 acc[8];
#pragma unroll
        for (int t = 0; t < 8; ++t) acc[t] = (f32x4){0.f, 0.f, 0.f, 0.f};
#define AS_PV(vv, mb) do { _Pragma("unroll") for (int i = 0; i < 8; ++i) { const int m = wid * 32 + (mb) + i; const f32x4 pa = *(const LAS f32x4*)(lds + AS_P + m * 32), pb = *(const LAS f32x4*)(lds + AS_P + m * 32 + 16); \
                acc[0] = acc[0] + vv[i] * pa.x; acc[1] = acc[1] + vv[i] * pa.y; acc[2] = acc[2] + vv[i] * pa.z; acc[3] = acc[3] + vv[i] * pa.w; \
                acc[4] = acc[4] + vv[i] * pb.x; acc[5] = acc[5] + vv[i] * pb.y; acc[6] = acc[6] + vv[i] * pb.z; acc[7] = acc[7] + vv[i] * pb.w; } } while (0)
#define AS_LD(vv, mb) do { _Pragma("unroll") for (int i = 0; i < 8; ++i) vv[i] = *(const f32x4*)(vp + (size_t)((mb) + i) * 1024); } while (0)
        AS_LD(vB, 8);  AS_PV(vA, 0);
        AS_LD(vA, 16); AS_PV(vB, 8);
        AS_LD(vB, 24); AS_PV(vA, 16);
        AS_PV(vB, 24);
#undef AS_PV
#undef AS_LD
#pragma unroll
        for (int t = 0; t < 8; ++t) *(LAS f32x4*)(lds + AS_O + ((wid * 8 + t) * 256 + lane * 4) * 4) = acc[t];
    }
    __syncthreads();
    { const int t = tid >> 6, d4 = (tid & 63) * 4; f32x4 a = (f32x4){0.f, 0.f, 0.f, 0.f};
#pragma unroll
        for (int w = 0; w < 8; ++w) a = a + *(const LAS f32x4*)(lds + AS_O + ((w * 8 + t) * 256 + d4) * 4);
        u32x2 o; o.x = cvt_pk_bf16(a.x, a.y); o.y = cvt_pk_bf16(a.z, a.w); *(u32x2*)(O + (r0 + t) * DM + head * 256 + d4) = o; }
}


#ifndef DUMP_AT
#define DUMP_AT -1
#define DUMP_OFF 0
#define DUMP_LD 1024
#define DUMP_COL0 0
#endif
#ifndef DUMP_COL1
#define DUMP_COL1 -1
#endif
__device__ __forceinline__ void dump_phase(KPtr p, int G) {
    const bf16_t* B = (const bf16_t*)(p->ws + (size_t)DUMP_OFF);
    for (size_t i = (size_t)blockIdx.x * 512 + threadIdx.x; i < (size_t)MT * 1024; i += (size_t)G * 512) { const size_t r = i >> 10, c = i & 1023; float v = bf2f(B[r * DUMP_LD + DUMP_COL0 + c]); if (DUMP_COL1 >= 0) v += 1.7f * bf2f(B[r * DUMP_LD + DUMP_COL1 + c]); p->out[i] = v; }
}
#define DUMP(n) do { if (DUMP_AT == (n)) { dump_phase(kparams(), G); return; } } while (0)

__global__ void __launch_bounds__(512, 2) hymba_fwd(Params pv) {
    extern __shared__ __attribute__((aligned(16))) unsigned char lds_raw[];
    ldsp lds = (ldsp)lds_raw;
    cg::grid_group grid = cg::this_grid();
    const int G = gridDim.x;
    volatile LAS unsigned* bst = (volatile LAS unsigned*)(lds + LDS_BYTES - 64);
    { unsigned* bar0 = (unsigned*)kparams()->ws; if (threadIdx.x == 0) { bst[0] = 0u; bst[1] = 0u; xb_add(bar0 + XB_XCNT(xb_xcc_id()), 1u); } }
    __syncthreads();
#define GSYNC() xcd_barrier((unsigned*)kparams()->ws, bst)
#ifndef PHMASK
#define PHMASK 0xffffffffu
#endif
#define PH(n) ((PHMASK >> (n)) & 1u)
    if (PH(0)) { KPtr p = kparams(); p0_prologue(p, lds, G); }
    if (kparams()->ws == nullptr) grid.sync();
    GSYNC();
    DUMP(0);
    if (PH(1)) {
        KPtr p = kparams(); unsigned char* ws = p->ws;
        pg8::Gemm g0{(const bf16_t*)(ws + WS_UM), (const bf16_t*)(ws + WS_WKVT), NMEMROWS, 2048, 1024}; pg8::StaticOrder S0; S0.init(NMEMROWS, 2048, G, G - 1 - (int)blockIdx.x);
        EpiKV E0{p->out + O_MK, p->out + O_MV, (bf16_t*)(ws + WS_KM), (bf16_t*)(ws + WS_VMT)};
        pg8::gemm_phase<EpiKV, pg8::StaticOrder, true, true>(lds, g0, S0, E0);
        __syncthreads();
        pg8::Gemm g1{(const bf16_t*)(ws + WS_U), (const bf16_t*)(ws + WS_W1T), MT, N1PAD, 1024}; pg8::StaticOrder S1; S1.init(MT, N1PAD, G, (int)blockIdx.x);
        EpiG1 E1{(bf16_t*)(ws + WS_BIG), (float*)(ws + WS_GATES)};
        pg8::gemm_phase<EpiG1, pg8::StaticOrder, true, true>(lds, g1, S1, E1);
    }
    GSYNC();
    DUMP(1);
    if (PH(2)) { KPtr p = kparams(); conv_phase(p, G); }
    GSYNC();
    DUMP(2);
    if (PH(3)) { KPtr p = kparams(); for (int u = blockIdx.x; u < 128; u += G) ssd_prompt_unit(p, lds, u >> 4, u & 15); }
    if (PH(4)) { KPtr p = kparams(); for (int u = blockIdx.x; u < 256; u += G) { if (u >= 128) { const int v = u - 128; mlstm_prompt_unit(p, lds, v >> 4, (v >> 2) & 3, v & 3); } } }
    if (PH(6)) { KPtr p = kparams(); unsigned* q = (unsigned*)p->ws + 8256; volatile LAS unsigned* slot = (volatile LAS unsigned*)(lds + LDS_BYTES - 32);
        for (;;) { if (threadIdx.x == 0) slot[0] = atomicAdd(q, 1u); __syncthreads(); const unsigned v = slot[0]; __syncthreads(); if (v >= 1024u) break; mlstm_sample_unit(p, lds, (int)(v >> 3), (int)((v >> 1) & 3), (int)(v & 1)); } }
    if (PH(5)) { KPtr p = kparams(); unsigned* q = (unsigned*)p->ws + 8192; volatile LAS unsigned* slot = (volatile LAS unsigned*)(lds + LDS_BYTES - 32);
        for (;;) { if (threadIdx.x == 0) slot[0] = atomicAdd(q, 1u); __syncthreads(); const unsigned v = slot[0]; __syncthreads(); if (v >= 2048u) break; ssd_sample_unit(p, lds, (int)(v >> 4), (int)(v & 15)); } }
    GSYNC();
    DUMP(3);
    if (PH(7)) { KPtr p = kparams(); norm_phase(p, G); }
    GSYNC();
    DUMP(4);
    if (PH(8)) { KPtr p = kparams(); unsigned char* ws = p->ws;
        pg8::Gemm g{(const bf16_t*)(ws + WS_A2), (const bf16_t*)(ws + WS_W2T), MP, 1024, 2048}; pg8::StaticOrder S; S.init(MP, 1024, G, (int)blockIdx.x);
        EpiB E{(bf16_t*)(ws + WS_R1), 1024, 1.f};
        pg8::gemm_phase<EpiB, pg8::StaticOrder, true, true>(lds, g, S, E);
    }
    GSYNC();
    {
        KPtr p = kparams(); unsigned char* ws = p->ws;
        if (blockIdx.x < 16) { if (PH(8)) {
            pg8::Gemm g{(const bf16_t*)(ws + WS_A2) + (size_t)MP * 2048, (const bf16_t*)(ws + WS_W2T), MS, 1024, 2048}; pg8::StaticOrder S; S.init(MS, 1024, 16, (int)blockIdx.x);
            EpiB E{(bf16_t*)(ws + WS_R1) + (size_t)MP * 1024, 1024, 1.f};
            pg8::gemm_phase<EpiB, pg8::StaticOrder, true, true>(lds, g, S, E); }
            asm volatile("s_waitcnt vmcnt(0)" ::: "memory"); __syncthreads();
            if (threadIdx.x == 0) { __builtin_amdgcn_fence(__ATOMIC_RELEASE, "agent"); asm volatile("s_waitcnt vmcnt(0)" ::: "memory"); (void)xb_add((unsigned*)ws + 8320, 1u); } }
        else if (PH(9)) {
            row_phase<true, false>(p, 16, G - 16, 0, MP, p->in[22], p->in[26]);
            if (threadIdx.x == 0) { unsigned* cw = (unsigned*)ws + 8320; while (xb_ld(cw) < 16u) __builtin_amdgcn_s_sleep(1);
                __builtin_amdgcn_fence(__ATOMIC_ACQUIRE, "agent"); asm volatile("s_waitcnt vmcnt(0)" ::: "memory"); }
            __syncthreads();
            row_phase<true, false>(p, 16, G - 16, MP, MT, p->in[22], p->in[26]); }
    }
    GSYNC();
    DUMP(6);
    if (PH(8)) { KPtr p = kparams(); unsigned char* ws = p->ws;
        pg8::Gemm g{(const bf16_t*)(ws + WS_U), (const bf16_t*)(ws + WS_WXQT), MT, 1024, 1024}; pg8::StaticOrder S; S.init(MT, 1024, G, (int)blockIdx.x);
        EpiB E{(bf16_t*)(ws + WS_QX), 1024, 0.0625f};
        pg8::gemm_phase<EpiB, pg8::StaticOrder, true, true>(lds, g, S, E);
    }
    GSYNC();
    DUMP(7);
    if ((blockIdx.x & 1) && PH(11)) { KPtr p = kparams(); for (int u = blockIdx.x; u < 512; u += G) { attn_sample_unit(p, lds, u); __syncthreads(); } }
    if (PH(10)) { KPtr p = kparams(); for (int u = blockIdx.x; u < 512; u += G) { attn_prompt_unit(p, lds, u); __syncthreads(); } }
    if (!(blockIdx.x & 1) && PH(11)) { KPtr p = kparams(); for (int u = blockIdx.x; u < 512; u += G) { attn_sample_unit(p, lds, u); __syncthreads(); } }
    GSYNC();
    DUMP(8);
    if (PH(8)) { KPtr p = kparams(); unsigned char* ws = p->ws;
        pg8::Gemm g{(const bf16_t*)(ws + WS_O), (const bf16_t*)(ws + WS_WXOT), MP, 1024, 1024}; pg8::StaticOrder S; S.init(MP, 1024, G, (int)blockIdx.x);
        EpiB E{(bf16_t*)(ws + WS_R1), 1024, 1.f};
        pg8::gemm_phase<EpiB, pg8::StaticOrder, true, true>(lds, g, S, E);
    }
    GSYNC();
    {
        KPtr p = kparams(); unsigned char* ws = p->ws;
        if (blockIdx.x < 16) { if (PH(8)) {
            pg8::Gemm g{(const bf16_t*)(ws + WS_O) + (size_t)MP * 1024, (const bf16_t*)(ws + WS_WXOT), MS, 1024, 1024}; pg8::StaticOrder S; S.init(MS, 1024, 16, (int)blockIdx.x);
            EpiB E{(bf16_t*)(ws + WS_R1) + (size_t)MP * 1024, 1024, 1.f};
            pg8::gemm_phase<EpiB, pg8::StaticOrder, true, true>(lds, g, S, E); }
            asm volatile("s_waitcnt vmcnt(0)" ::: "memory"); __syncthreads();
            if (threadIdx.x == 0) { __builtin_amdgcn_fence(__ATOMIC_RELEASE, "agent"); asm volatile("s_waitcnt vmcnt(0)" ::: "memory"); (void)xb_add((unsigned*)ws + 8384, 1u); } }
        else if (PH(9)) {
            row_phase<false, false>(p, 16, G - 16, 0, MP, p->in[29], p->in[30]);
            if (threadIdx.x == 0) { unsigned* cw = (unsigned*)ws + 8384; while (xb_ld(cw) < 16u) __builtin_amdgcn_s_sleep(1);
                __builtin_amdgcn_fence(__ATOMIC_ACQUIRE, "agent"); asm volatile("s_waitcnt vmcnt(0)" ::: "memory"); }
            __syncthreads();
            row_phase<false, false>(p, 16, G - 16, MP, MT, p->in[29], p->in[30]); }
    }
    GSYNC();
    DUMP(10);
    if (PH(12)) { KPtr p = kparams(); unsigned char* ws = p->ws;
        pg8::Gemm g{(const bf16_t*)(ws + WS_U), (const bf16_t*)(ws + WS_WGUT), MT, 5632, 1024}; pg8::StaticOrder S; S.init(MT, 5632, G, (int)blockIdx.x);
        EpiSwi E{(bf16_t*)(ws + WS_HID)};
        pg8::gemm_phase<EpiSwi, pg8::StaticOrder, true, true>(lds, g, S, E);
    }
    GSYNC();
    DUMP(11);
    if (PH(8)) { KPtr p = kparams(); unsigned char* ws = p->ws;
        pg8::Gemm g{(const bf16_t*)(ws + WS_HID), (const bf16_t*)(ws + WS_WDT), MP, 1024, 2816}; pg8::StaticOrder S; S.init(MP, 1024, G, (int)blockIdx.x);
        EpiB E{(bf16_t*)(ws + WS_R1), 1024, 1.f};
        pg8::gemm_phase<EpiB, pg8::StaticOrder, true, true>(lds, g, S, E);
    }
    GSYNC();
    {
        KPtr p = kparams(); unsigned char* ws = p->ws;
        if (blockIdx.x < 32) { if (PH(8)) { const int kh = (int)blockIdx.x >> 4;
            pg8::Gemm g{(const bf16_t*)(ws + WS_HID) + (size_t)MP * 2816 + kh * 1408, (const bf16_t*)(ws + WS_WDT) + kh * 1408, MS, 1024, 1408, 2816}; pg8::StaticOrder S; S.init(MS, 1024, 16, (int)blockIdx.x & 15);
            EpiP32 E{(float*)(ws + WS_A2) + (size_t)kh * MS * 1024, 1024};
            pg8::gemm_phase<EpiP32, pg8::StaticOrder, true, true>(lds, g, S, E); }
            asm volatile("s_waitcnt vmcnt(0)" ::: "memory"); __syncthreads();
            if (threadIdx.x == 0) { __builtin_amdgcn_fence(__ATOMIC_RELEASE, "agent"); asm volatile("s_waitcnt vmcnt(0)" ::: "memory"); (void)xb_add((unsigned*)ws + 8448, 1u); } }
        else if (PH(9)) {
            row_phase<false, true>(p, 32, G - 32, 0, MP, p->in[34], p->in[34]);
            if (threadIdx.x == 0) { unsigned* cw = (unsigned*)ws + 8448; while (xb_ld(cw) < 32u) __builtin_amdgcn_s_sleep(1);
                __builtin_amdgcn_fence(__ATOMIC_ACQUIRE, "agent"); asm volatile("s_waitcnt vmcnt(0)" ::: "memory"); }
            __syncthreads();
            row_phase<false, true, true>(p, 32, G - 32, MP, MT, p->in[34], p->in[34]); }
    }
}

extern "C" void kernel_launch(void* const* d_in, const int* in_sizes, int n_in, void* d_out, int out_size, void* d_ws, size_t ws_size, hipStream_t stream) {
    static int grid = 0;
    if (grid == 0) {
        if (n_in != 35 || ws_size < WS_END) { fprintf(stderr, "kernel_launch: unexpected n_in %d / ws %zu\n", n_in, ws_size); grid = -1; return; }
        int dev = 0, cus = 0, per_cu = 0;
        (void)hipGetDevice(&dev); (void)hipDeviceGetAttribute(&cus, hipDeviceAttributeMultiprocessorCount, dev);
        if (hipFuncSetAttribute((const void*)hymba_fwd, hipFuncAttributeMaxDynamicSharedMemorySize, LDS_BYTES) != hipSuccess) { fprintf(stderr, "kernel_launch: hipFuncSetAttribute failed\n"); grid = -1; return; }
        if (hipOccupancyMaxActiveBlocksPerMultiprocessor(&per_cu, (const void*)hymba_fwd, 512, LDS_BYTES) != hipSuccess || per_cu < 1) { fprintf(stderr, "kernel_launch: occupancy query says %d\n", per_cu); per_cu = 1; }
        (void)hipGetLastError();
        grid = cus * 1;
    }
    if (grid < 0) return;
    if (hipMemsetAsync(d_ws, 0, 65536, stream) != hipSuccess) { fprintf(stderr, "kernel_launch: memset failed\n"); return; }
    Params p{};
    for (int i = 0; i < 35; ++i) p.in[i] = (const float*)d_in[i];
    p.out = (float*)d_out; p.ws = (unsigned char*)d_ws;
    void* args[] = {&p};
    hipError_t e = hipLaunchCooperativeKernel((const void*)hymba_fwd, dim3(grid), dim3(512), args, LDS_BYTES, stream);
    if (e != hipSuccess) fprintf(stderr, "cooperative launch failed: %s (grid %d)\n", hipGetErrorString(e), grid);
}
```

```cpp
#include <hip/hip_runtime.h>
#include <hip/hip_cooperative_groups.h>
#include <cstdio>
#include <cstdint>
namespace cg = cooperative_groups;

#define LAS __attribute__((address_space(3)))
typedef unsigned short bf16_t;
typedef short bf16x8 __attribute__((ext_vector_type(8)));
typedef float f32x4 __attribute__((ext_vector_type(4)));
typedef float f32x2 __attribute__((ext_vector_type(2)));
typedef unsigned u32x4 __attribute__((ext_vector_type(4)));
typedef unsigned u32x2 __attribute__((ext_vector_type(2)));
typedef LAS unsigned char* ldsp;

typedef __bf16 bf16v2_t __attribute__((ext_vector_type(2)));
__device__ __forceinline__ unsigned cvt_pk_bf16(float lo, float hi) { f32x2 v = {lo, hi}; bf16v2_t b = __builtin_convertvector(v, bf16v2_t); return __builtin_bit_cast(unsigned, b); }
__device__ __forceinline__ float bf2f(unsigned short b) { return __uint_as_float(((unsigned)b) << 16); }
__device__ __forceinline__ float bflo(unsigned w) { return __uint_as_float(w << 16); }
__device__ __forceinline__ float bfhi(unsigned w) { return __uint_as_float(w & 0xffff0000u); }
__device__ __forceinline__ unsigned short f2bf(float f) { return (unsigned short)(cvt_pk_bf16(f, 0.f) & 0xffffu); }
__device__ __forceinline__ float wave_sum(float v) {
#pragma unroll
    for (int o = 1; o < 64; o <<= 1) v += __shfl_xor(v, o);
    return v;
}
__device__ __forceinline__ float wave_max(float v) {
#pragma unroll
    for (int o = 1; o < 64; o <<= 1) v = fmaxf(v, __shfl_xor(v, o));
    return v;
}
__device__ __forceinline__ float softplusf(float x) { return x > 20.f ? x : __logf(1.f + __expf(x)); }
__device__ __forceinline__ float siluf(float x) { return x * __builtin_amdgcn_rcpf(1.f + __expf(-x)); }
__device__ __forceinline__ float sigmoidf_(float x) { return __builtin_amdgcn_rcpf(1.f + __expf(-x)); }
#define LDS_WAIT() asm volatile("s_waitcnt lgkmcnt(0)" ::: "memory")
__device__ __forceinline__ int fresh_tid() { int t = threadIdx.x; asm volatile("" : "+v"(t)); return t; }

namespace pg8 {
constexpr int BM = 256, BK = 64, HALF = 128, HTB = HALF * BK * 2, STAGE_BYTES = 8 * HTB, NXCD = 8, WGM = 8;
__host__ __device__ __forceinline__ int lds_byte(int r, int c) { const int st = (r >> 4) * 2 + (c >> 5), rr = r & 15, cc = c & 31, ob = rr * 64 + cc * 2; return st * 1024 + (ob ^ (((ob >> 9) & 1) << 5)); }
__host__ __device__ __forceinline__ void stage_rc(int b, int& R, int& C) { const int st = b / 1024, sb = b % 1024, swz = sb ^ (((sb >> 9) & 1) << 5); R = (st >> 1) * 16 + swz / 64; C = (st & 1) * 32 + (swz % 64) / 2; }
__host__ __device__ __forceinline__ int perm32(int rho) { const int n = rho >> 4, i = rho & 15; return 8 * (i >> 2) + 4 * n + (i & 3); }
struct Unit { int pm, pn; };
struct Gemm { const bf16_t* A; const bf16_t* Bt; int M, N, K; int ld; };
struct StaticOrder {
    int nM, nN, nwg, G, c;
    __host__ __device__ void init(int M, int N, int G_, int c_) { nM = M / BM; nN = N / BM; nwg = nM * nN; G = G_; c = c_; }
    __host__ __device__ bool next(int i, Unit& u) const {
        const long L = (long)i * G + c; if (L >= nwg) return false;
        int wgid = (int)L; { const int q = nwg / NXCD, r = nwg % NXCD, xcd = wgid % NXCD, off = wgid / NXCD; wgid = (xcd < r ? xcd * (q + 1) : r * (q + 1) + (xcd - r) * q) + off; }
        const int nig = WGM * nN, gid = wgid / nig, fm = gid * WGM, gsz = (nM - fm) < WGM ? (nM - fm) : WGM;
        u.pm = fm + ((wgid % nig) % gsz); u.pn = (wgid % nig) / gsz; return true;
    }
    __device__ __forceinline__ void a_ready(const Unit&) const {}
    __device__ __forceinline__ void done(const Unit&) const {}
};
template <class Epi, class Sched, bool ALIGN_EPI = false, bool SP2 = false>
__device__ __forceinline__ void gemm_phase(ldsp lds, const Gemm g, const Sched& S, const Epi& E) {
    const int tid = fresh_tid(), wid = __builtin_amdgcn_readfirstlane(tid >> 6), lane = tid & 63, wr = wid >> 2, wc = wid & 3, fr = lane & 15, fq = lane >> 4;
    const int nt = g.K / BK, K = g.ld ? g.ld : g.K;
    unsigned voffA[2], voffB[2];
#pragma unroll
    for (int i = 0; i < 2; ++i) { int R, C; stage_rc(tid * 16 + i * 8192, R, C); const int Rb = Epi::PERM ? ((R & ~31) + perm32(R & 31)) : R;
        voffA[i] = (unsigned)(R * K + C) * 2u; voffB[i] = (unsigned)(Rb * K + C) * 2u; }
    const size_t kstep = (size_t)(BK * 2);
    const size_t hstep = (size_t)HALF * K * 2;
    const size_t tstep = 2 * hstep;
    const unsigned ldsw = (unsigned)wid * 1024u;
    const int aoff = lds_byte(wr * 64 + fr, fq * 8), boff = lds_byte(wc * 32 + fr, fq * 8);
#define PG8_SA(b, h) (((b) * 2 + (h)) * HTB)
#define PG8_SB(b, h) ((4 + (b) * 2 + (h)) * HTB)
#define PG8_STAGE(bufoff, gbase, voff) do { _Pragma("unroll") for (int _i = 0; _i < 2; ++_i) \
        __builtin_amdgcn_global_load_lds((const unsigned*)((const char*)(gbase) + (voff)[_i]), (LAS unsigned*)(lds + (bufoff) + ldsw + _i * 8192), 16, 0, 0); } while (0)
#define PG8_LDA(dst, b, h) do { _Pragma("unroll") for (int m = 0; m < 4; ++m) _Pragma("unroll") for (int k = 0; k < 2; ++k) dst[m][k] = *(const LAS bf16x8*)(lds + PG8_SA(b, h) + aoff + m * 2048 + k * 1024); } while (0)
#define PG8_LDB(dst, b, h) do { _Pragma("unroll") for (int n = 0; n < 2; ++n) _Pragma("unroll") for (int k = 0; k < 2; ++k) dst[n][k] = *(const LAS bf16x8*)(lds + PG8_SB(b, h) + boff + n * 2048 + k * 1024); } while (0)
#define PG8_MMA(ai, bj, At, Bt) do { __builtin_amdgcn_s_setprio(1); _Pragma("unroll") for (int m = 0; m < 4; ++m) _Pragma("unroll") for (int n = 0; n < 2; ++n) _Pragma("unroll") for (int k = 0; k < 2; ++k) \
        acc[ai][bj][m][n] = __builtin_amdgcn_mfma_f32_16x16x32_bf16(Bt[n][k], At[m][k], acc[ai][bj][m][n], 0, 0, 0); __builtin_amdgcn_s_setprio(0); } while (0)
#define PG8_WAIT_V(n) asm volatile("s_waitcnt vmcnt(" #n ")" ::: "memory")
#define PG8_WAIT_L(n) asm volatile("s_waitcnt lgkmcnt(" #n ")" ::: "memory")
#define PG8_BAR __builtin_amdgcn_s_barrier()
#define PG8_SCHED __builtin_amdgcn_sched_barrier(0)
    Unit cur, nxt; int ui = 0;
    if (!S.next(0, cur)) return;
    f32x4 acc[2][2][4][2];
#pragma unroll
    for (int a = 0; a < 2; ++a)
#pragma unroll
        for (int b = 0; b < 2; ++b)
#pragma unroll
            for (int m = 0; m < 4; ++m)
#pragma unroll
                for (int n = 0; n < 2; ++n) acc[a][b][m][n] = (f32x4){0.f, 0.f, 0.f, 0.f};
    bf16x8 At[4][2], B0[2][2], B1[2][2];
    const char* cA = (const char*)g.A + (size_t)cur.pm * tstep; const char* cB = (const char*)g.Bt + (size_t)cur.pn * tstep;
    S.a_ready(cur);
    if constexpr (SP2) {
        PG8_STAGE(PG8_SB(0, 0), cB, voffB); PG8_STAGE(PG8_SB(0, 1), cB + hstep, voffB); PG8_STAGE(PG8_SA(0, 0), cA, voffA); PG8_STAGE(PG8_SA(0, 1), cA + hstep, voffA);
        if (wr == 1) PG8_BAR;
        PG8_WAIT_V(2); PG8_BAR;
        PG8_STAGE(PG8_SB(1, 0), cB + kstep, voffB); PG8_STAGE(PG8_SA(1, 0), cA + kstep, voffA); PG8_STAGE(PG8_SB(1, 1), cB + hstep + kstep, voffB);
        PG8_WAIT_V(6); PG8_BAR;
    } else {
        PG8_STAGE(PG8_SB(0, 0), cB, voffB); PG8_STAGE(PG8_SA(0, 0), cA, voffA); PG8_STAGE(PG8_SB(0, 1), cB + hstep, voffB); PG8_STAGE(PG8_SA(0, 1), cA + hstep, voffA);
        if (wr == 1) PG8_BAR;
        PG8_WAIT_V(4); PG8_BAR;
        PG8_STAGE(PG8_SB(1, 0), cB + kstep, voffB); PG8_STAGE(PG8_SA(1, 0), cA + kstep, voffA); PG8_STAGE(PG8_SB(1, 1), cB + hstep + kstep, voffB);
        PG8_WAIT_V(6); PG8_BAR;
    }
    for (;;) {
        const bool has_next = S.next(ui + 1, nxt);
        const char* nA = has_next ? (const char*)g.A + (size_t)nxt.pm * tstep : cA; const char* nB = has_next ? (const char*)g.Bt + (size_t)nxt.pn * tstep : cB;
        for (int t = 0; t < nt; t += 2) {
            const bool last = (t == nt - 2);
            const char* a1 = cA + (size_t)(t + 1) * kstep;
            const char* a2 = last ? nA : cA + (size_t)(t + 2) * kstep; const char* b2 = last ? nB : cB + (size_t)(t + 2) * kstep;
            const char* a3 = a2 + kstep; const char* b3 = b2 + kstep;
            if (last && has_next) S.a_ready(nxt);
            if constexpr (SP2) {
            PG8_LDB(B0, 0, 0); PG8_LDB(B1, 0, 1); PG8_SCHED; PG8_LDA(At, 0, 0); PG8_STAGE(PG8_SA(1, 1), a1 + hstep, voffA);
            PG8_WAIT_V(8); PG8_WAIT_L(0); PG8_BAR; PG8_MMA(0, 0, At, B0); PG8_MMA(0, 1, At, B1); PG8_BAR; PG8_SCHED;
            PG8_LDA(At, 0, 1); PG8_STAGE(PG8_SB(0, 0), b2, voffB); PG8_STAGE(PG8_SB(0, 1), b2 + hstep, voffB); PG8_STAGE(PG8_SA(0, 0), a2, voffA);
            PG8_WAIT_V(8); PG8_WAIT_L(0); PG8_BAR; PG8_MMA(1, 0, At, B0); PG8_MMA(1, 1, At, B1); PG8_BAR; PG8_SCHED;
            PG8_LDB(B0, 1, 0); PG8_LDB(B1, 1, 1); PG8_SCHED; PG8_LDA(At, 1, 0); PG8_STAGE(PG8_SA(0, 1), a2 + hstep, voffA);
            PG8_WAIT_V(8); PG8_WAIT_L(0); PG8_BAR; PG8_MMA(0, 0, At, B0); PG8_MMA(0, 1, At, B1); PG8_BAR; PG8_SCHED;
            PG8_LDA(At, 1, 1); PG8_STAGE(PG8_SB(1, 0), b3, voffB); PG8_STAGE(PG8_SB(1, 1), b3 + hstep, voffB); PG8_STAGE(PG8_SA(1, 0), a3, voffA);
            PG8_WAIT_V(8); PG8_WAIT_L(0); PG8_BAR; PG8_MMA(1, 0, At, B0); PG8_MMA(1, 1, At, B1); PG8_BAR; PG8_SCHED;
            } else {
            PG8_LDB(B0, 0, 0); PG8_SCHED; PG8_LDA(At, 0, 0); PG8_STAGE(PG8_SA(1, 1), a1 + hstep, voffA);
            PG8_WAIT_L(8); PG8_BAR; PG8_WAIT_L(0); PG8_MMA(0, 0, At, B0); PG8_BAR; PG8_SCHED;
            PG8_LDB(B1, 0, 1); PG8_STAGE(PG8_SB(0, 0), b2, voffB);
            PG8_BAR; PG8_WAIT_L(0); PG8_MMA(0, 1, At, B1); PG8_BAR;
            PG8_LDA(At, 0, 1); PG8_STAGE(PG8_SA(0, 0), a2, voffA);
            PG8_BAR; PG8_WAIT_L(0); PG8_MMA(1, 0, At, B0); PG8_BAR; PG8_SCHED;
            PG8_STAGE(PG8_SB(0, 1), b2 + hstep, voffB);
            PG8_WAIT_V(6); PG8_BAR; PG8_MMA(1, 1, At, B1); PG8_BAR;
            PG8_LDB(B0, 1, 0); PG8_SCHED; PG8_LDA(At, 1, 0); PG8_STAGE(PG8_SA(0, 1), a2 + hstep, voffA);
            PG8_WAIT_L(8); PG8_BAR; PG8_WAIT_L(0); PG8_MMA(0, 0, At, B0); PG8_BAR; PG8_SCHED;
            PG8_LDB(B1, 1, 1); PG8_STAGE(PG8_SB(1, 0), b3, voffB);
            PG8_BAR; PG8_WAIT_L(0); PG8_MMA(0, 1, At, B1); PG8_BAR;
            PG8_LDA(At, 1, 1); PG8_STAGE(PG8_SA(1, 0), a3, voffA);
            PG8_BAR; PG8_WAIT_L(0); PG8_MMA(1, 0, At, B0); PG8_BAR; PG8_SCHED;
            PG8_STAGE(PG8_SB(1, 1), b3 + hstep, voffB);
            PG8_WAIT_V(6); PG8_BAR; PG8_MMA(1, 1, At, B1); PG8_BAR;
            }
        }
        if constexpr (ALIGN_EPI) { if (wr == 0) PG8_BAR; }
        E(acc, cur, wr, wc, fr, fq);
        if (!has_next) break;
#pragma unroll
        for (int a = 0; a < 2; ++a)
#pragma unroll
            for (int b = 0; b < 2; ++b)
#pragma unroll
                for (int m = 0; m < 4; ++m)
#pragma unroll
                    for (int n = 0; n < 2; ++n) acc[a][b][m][n] = (f32x4){0.f, 0.f, 0.f, 0.f};
        cur = nxt; cA = nA; cB = nB; ++ui;
        if constexpr (ALIGN_EPI) { if (wr == 1) PG8_BAR; }
    }
    PG8_WAIT_V(0);
    if constexpr (!ALIGN_EPI) { if (wr == 0) PG8_BAR; }
    PG8_BAR;
#undef PG8_SA
#undef PG8_SB
#undef PG8_STAGE
#undef PG8_LDA
#undef PG8_LDB
#undef PG8_MMA
#undef PG8_WAIT_V
#undef PG8_WAIT_L
#undef PG8_BAR
#undef PG8_SCHED
}
}

constexpr int DM = 1024, MP = 16384, MS = 1024, MT = 17408, NMEMROWS = 2048;
constexpr int PROJ_LD = 5632, N1PAD = 5888, XBC_LD = 1536, YP_LD = 2048, FFH = 2816;
constexpr float EPSN = 1e-6f;
constexpr size_t MiB = 1u << 20;
constexpr size_t WS_W1T = 1 * MiB, WS_W2T = 13 * MiB, WS_WKVT = 17 * MiB, WS_WXQT = 21 * MiB, WS_WXOT = 23 * MiB, WS_WGUT = 25 * MiB, WS_WDT = 36 * MiB;
constexpr size_t WS_U = 42 * MiB, WS_UM = 76 * MiB, WS_KM = 80 * MiB, WS_VMT = 84 * MiB, WS_GATES = 88 * MiB, WS_BIG = 91 * MiB;
constexpr size_t WS_XBC = 278 * MiB, WS_YPRE = 329 * MiB, WS_A2 = 397 * MiB, WS_END = 465 * MiB;
constexpr size_t WS_QX = WS_BIG, WS_O = WS_BIG + 34 * MiB, WS_HID = WS_BIG + 68 * MiB, WS_R1 = WS_XBC;
constexpr size_t O_YP = 0, O_YS = 16777216, O_MK = 17825792, O_MV = 19922944, O_SSMP = 22020096, O_CONVP = 23068672, O_MCP = 23105536, O_MNP = 24154112, O_MMP = 24158208,
                 O_SSMS = 24158240, O_CONVS = 40935456, O_MCS = 41525280, O_MNS = 58302496, O_MMS = 58368032;
constexpr int LDS_BYTES = 147456;

struct Params { const float* in[35]; float* out; unsigned char* ws; };
typedef const __attribute__((address_space(4))) Params* KPtr;
__device__ __forceinline__ KPtr kparams() { KPtr k = (KPtr)__builtin_amdgcn_kernarg_segment_ptr(); asm volatile("" : "+s"(k)); return k; }

struct EpiG1 {
    static constexpr bool PERM = true;
    bf16_t* proj; float* gates;
    __device__ __forceinline__ void operator()(const f32x4 (&acc)[2][2][4][2], const pg8::Unit& u, int wr, int wc, int fr, int fq) const {
        const int row0 = u.pm * 256 + wr * 64 + fr;
        if (u.pn < 22) {
            const int col0 = u.pn * 256 + wc * 32 + 8 * fq;
#pragma unroll
            for (int ai = 0; ai < 2; ++ai)
#pragma unroll
                for (int m = 0; m < 4; ++m) { bf16_t* rowp = proj + (size_t)(row0 + ai * 128 + m * 16) * PROJ_LD + col0;
#pragma unroll
                    for (int bj = 0; bj < 2; ++bj) { const f32x4 v0 = acc[ai][bj][m][0], v1 = acc[ai][bj][m][1]; u32x4 w;
                        w.x = cvt_pk_bf16(v0[0], v0[1]); w.y = cvt_pk_bf16(v0[2], v0[3]); w.z = cvt_pk_bf16(v1[0], v1[1]); w.w = cvt_pk_bf16(v1[2], v1[3]);
                        *(u32x4*)(rowp + bj * 128) = w; } }
        } else if (wc == 0) {
#pragma unroll
            for (int ai = 0; ai < 2; ++ai)
#pragma unroll
                for (int m = 0; m < 4; ++m) { float* rp = gates + (size_t)(row0 + ai * 128 + m * 16) * 32 + 8 * fq;
                    *(f32x4*)rp = acc[ai][0][m][0]; *(f32x4*)(rp + 4) = acc[ai][0][m][1]; }
        }
    }
};
struct EpiKV {
    static constexpr bool PERM = true;
    float* outk; float* outv; bf16_t* km; bf16_t* vmt;
    __device__ __forceinline__ void operator()(const f32x4 (&acc)[2][2][4][2], const pg8::Unit& u, int wr, int wc, int fr, int fq) const {
        const int row0 = u.pm * 256 + wr * 64 + fr;
#pragma unroll
        for (int ai = 0; ai < 2; ++ai)
#pragma unroll
            for (int m = 0; m < 4; ++m) { const int row = row0 + ai * 128 + m * 16;
#pragma unroll
                for (int bj = 0; bj < 2; ++bj) { const int c = u.pn * 256 + bj * 128 + wc * 32 + 8 * fq; const f32x4 v0 = acc[ai][bj][m][0], v1 = acc[ai][bj][m][1];
                    if (u.pn < 4) {
                        *(f32x4*)(outk + (size_t)row * 1024 + c) = v0; *(f32x4*)(outk + (size_t)row * 1024 + c + 4) = v1;
                        u32x4 w; w.x = cvt_pk_bf16(v0[0], v0[1]); w.y = cvt_pk_bf16(v0[2], v0[3]); w.z = cvt_pk_bf16(v1[0], v1[1]); w.w = cvt_pk_bf16(v1[2], v1[3]);
                        *(u32x4*)(km + (size_t)row * 1024 + c) = w;
                    } else {
                        const int c2 = c - 1024;
                        *(f32x4*)(outv + (size_t)row * 1024 + c2) = v0; *(f32x4*)(outv + (size_t)row * 1024 + c2 + 4) = v1;
                        const int b = row >> 8, mt = row & 255, h = c2 >> 8, d = c2 & 255;
                        bf16_t* vp = vmt + ((size_t)(b * 4 + h) * 256 + d) * 256 + mt;
#pragma unroll
                        for (int j = 0; j < 4; ++j) { vp[(size_t)j * 256] = f2bf(v0[j]); vp[(size_t)(j + 4) * 256] = f2bf(v1[j]); }
                    } } }
    }
};
struct EpiB {
    static constexpr bool PERM = true;
    bf16_t* O; int ldc; float scale;
    __device__ __forceinline__ void operator()(const f32x4 (&acc)[2][2][4][2], const pg8::Unit& u, int wr, int wc, int fr, int fq) const {
        const int row0 = u.pm * 256 + wr * 64 + fr, col0 = u.pn * 256 + wc * 32 + 8 * fq;
#pragma unroll
        for (int ai = 0; ai < 2; ++ai)
#pragma unroll
            for (int m = 0; m < 4; ++m) { bf16_t* rowp = O + (size_t)(row0 + ai * 128 + m * 16) * ldc + col0;
#pragma unroll
                for (int bj = 0; bj < 2; ++bj) { const f32x4 v0 = acc[ai][bj][m][0] * scale, v1 = acc[ai][bj][m][1] * scale; u32x4 w;
                    w.x = cvt_pk_bf16(v0[0], v0[1]); w.y = cvt_pk_bf16(v0[2], v0[3]); w.z = cvt_pk_bf16(v1[0], v1[1]); w.w = cvt_pk_bf16(v1[2], v1[3]);
                    *(u32x4*)(rowp + bj * 128) = w; } }
    }
};
struct EpiP32 {
    static constexpr bool PERM = true;
    float* C; int ldc;
    __device__ __forceinline__ void operator()(const f32x4 (&acc)[2][2][4][2], const pg8::Unit& u, int wr, int wc, int fr, int fq) const {
        const int row0 = u.pm * 256 + wr * 64 + fr, col0 = u.pn * 256 + wc * 32 + 8 * fq;
#pragma unroll
        for (int ai = 0; ai < 2; ++ai)
#pragma unroll
            for (int m = 0; m < 4; ++m) { float* rowp = C + (size_t)(row0 + ai * 128 + m * 16) * ldc + col0;
#pragma unroll
                for (int bj = 0; bj < 2; ++bj) { *(f32x4*)(rowp + bj * 128) = acc[ai][bj][m][0]; *(f32x4*)(rowp + bj * 128 + 4) = acc[ai][bj][m][1]; } }
    }
};
struct EpiSwi {
    static constexpr bool PERM = true;
    bf16_t* hid;
    __device__ __forceinline__ void operator()(const f32x4 (&acc)[2][2][4][2], const pg8::Unit& u, int wr, int wc, int fr, int fq) const {
        const int row0 = u.pm * 256 + wr * 64 + fr, col0 = u.pn * 128 + wc * 32 + 8 * fq;
#pragma unroll
        for (int ai = 0; ai < 2; ++ai)
#pragma unroll
            for (int m = 0; m < 4; ++m) { bf16_t* rowp = hid + (size_t)(row0 + ai * 128 + m * 16) * FFH + col0;
                float r[8];
#pragma unroll
                for (int n = 0; n < 2; ++n)
#pragma unroll
                    for (int j = 0; j < 4; ++j) { const float gt = acc[ai][0][m][n][j], up = acc[ai][1][m][n][j]; r[n * 4 + j] = siluf(gt) * up; }
                u32x4 w; w.x = cvt_pk_bf16(r[0], r[1]); w.y = cvt_pk_bf16(r[2], r[3]); w.z = cvt_pk_bf16(r[4], r[5]); w.w = cvt_pk_bf16(r[6], r[7]);
                *(u32x4*)rowp = w; }
    }
};


#define XB_TMO      128
#define XB_XCNT(j)  (256  + 64 * (j))
#define XB_XSUB(j)  (1280 + 64 * (j))
#define XB_XGEN(j)  (2304 + 64 * (j))
#define XB_TOP      3328
#define XB_TOPGEN   3392
#define XB_SPIN_CAP (1u << 22)
__device__ __forceinline__ unsigned xb_ld(unsigned* p)              { return __hip_atomic_load(p, __ATOMIC_RELAXED, __HIP_MEMORY_SCOPE_AGENT); }
__device__ __forceinline__ unsigned xb_add(unsigned* p, unsigned v) { return __hip_atomic_fetch_add(p, v, __ATOMIC_RELAXED, __HIP_MEMORY_SCOPE_AGENT); }
__device__ __forceinline__ unsigned xb_xcc_id() { return (unsigned)__builtin_amdgcn_s_getreg((3 << 11) | 20) & 0xFu; }
#define XB_SPIN(cond, bar) do { unsigned _sp = 0; while (cond) { __builtin_amdgcn_s_sleep(1); \
    if ((++_sp & 255u) == 0u) { if (xb_ld(&(bar)[XB_TMO])) break; if (_sp > XB_SPIN_CAP) { atomicAdd(&(bar)[XB_TMO], 1u); break; } } } } while (0)
__device__ __forceinline__ void xcd_barrier_complete(unsigned* bar, unsigned x, unsigned& nloc, unsigned& nx) {
    const unsigned G = gridDim.x * gridDim.y * gridDim.z;
    unsigned sum, cnt, mine, sp = 0u;
    for (;;) {
        sum = 0u; cnt = 0u; mine = 0u;
#pragma unroll
        for (unsigned j = 0; j < 16; ++j) { const unsigned c = xb_ld(&bar[XB_XCNT(j)]); sum += c; cnt += (c > 0u) ? 1u : 0u; mine = (j == x) ? c : mine; }
        if (sum == G) break;
        __builtin_amdgcn_s_sleep(1);
        if ((++sp & 255u) == 0u) { if (xb_ld(&bar[XB_TMO])) break; if (sp > XB_SPIN_CAP) { atomicAdd(&bar[XB_TMO], 1u); break; } }
    }
    nloc = mine > 0u ? mine : 1u; nx = cnt > 0u ? cnt : 1u;
}
__device__ __forceinline__ void xcd_barrier(unsigned* bar, volatile LAS unsigned* st) {
    asm volatile("s_waitcnt vmcnt(0)" ::: "memory");
    __syncthreads();
    if (threadIdx.x == 0) {
        const unsigned x = xb_xcc_id();
        __builtin_amdgcn_s_waitcnt(0);
        unsigned nloc = st[0], nx = st[1];
        if (nloc == 0u) { xcd_barrier_complete(bar, x, nloc, nx); st[0] = nloc; st[1] = nx; }
        const unsigned old = xb_add(&bar[XB_XSUB(x)], 1u);
        const unsigned gen = old / nloc;
        if (old + 1u == (gen + 1u) * nloc) {
            __builtin_amdgcn_fence(__ATOMIC_RELEASE, "agent");
            asm volatile("s_waitcnt vmcnt(0)" ::: "memory");
            const unsigned og = xb_add(&bar[XB_TOP], 1u);
            const unsigned tg = og / nx;
            if (og + 1u == (tg + 1u) * nx) xb_add(&bar[XB_TOPGEN], 1u);
            else XB_SPIN(xb_ld(&bar[XB_TOPGEN]) == tg, bar);
            __builtin_amdgcn_fence(__ATOMIC_ACQUIRE, "agent");
            xb_add(&bar[XB_XGEN(x)], 1u);
            asm volatile("s_waitcnt vmcnt(0)" ::: "memory");
        } else {
            XB_SPIN(xb_ld(&bar[XB_XGEN(x)]) == gen, bar);
            __builtin_amdgcn_fence(__ATOMIC_ACQUIRE, "agent");
            asm volatile("s_waitcnt vmcnt(0)" ::: "memory");
        }
    }
    __syncthreads();
}

__device__ __forceinline__ void tr_item(const float* __restrict__ W, int ldn, int c0, int k0, bf16_t* WT, int Kp, int r0, LAS float* scr, int lane) {
#pragma unroll 32
    for (int i = 0; i < 32; ++i) { const int kk = 2 * i + (lane >> 5); scr[kk * 33 + (lane & 31)] = W[(size_t)(k0 + kk) * ldn + c0 + (lane & 31)]; }
    LDS_WAIT();
    const int c = lane & 7;
#pragma unroll
    for (int j = 0; j < 4; ++j) { const int n = (lane >> 3) + 8 * j; const LAS float* s = scr + (8 * c) * 33 + n;
        u32x4 o; o.x = cvt_pk_bf16(s[0 * 33], s[1 * 33]); o.y = cvt_pk_bf16(s[2 * 33], s[3 * 33]); o.z = cvt_pk_bf16(s[4 * 33], s[5 * 33]); o.w = cvt_pk_bf16(s[6 * 33], s[7 * 33]);
        *(u32x4*)(WT + (size_t)(r0 + n) * Kp + k0 + 8 * c) = o; }
    LDS_WAIT();
}
__device__ __forceinline__ void rms_row_to_bf16(const float* xrow, const float* g, bf16_t* orow, int lane) {
    const f32x4* xr = (const f32x4*)xrow + lane; const f32x4* gr = (const f32x4*)g + lane;
    f32x4 v[4]; float s = 0.f;
#pragma unroll
    for (int j = 0; j < 4; ++j) { v[j] = xr[64 * j]; s += (v[j].x * v[j].x + v[j].y * v[j].y) + (v[j].z * v[j].z + v[j].w * v[j].w); }
    const float rstd = rsqrtf(wave_sum(s) * (1.f / DM) + EPSN);
    u32x2* o8 = (u32x2*)orow + lane;
#pragma unroll
    for (int j = 0; j < 4; ++j) { const f32x4 gg = gr[64 * j]; u32x2 w; w.x = cvt_pk_bf16(v[j].x * rstd * gg.x, v[j].y * rstd * gg.y); w.y = cvt_pk_bf16(v[j].z * rstd * gg.z, v[j].w * rstd * gg.w); o8[64 * j] = w; }
}
__device__ __forceinline__ void p0_prologue(KPtr p, ldsp lds, int G) {
    const int tid = fresh_tid(), lane = tid & 63, wave = __builtin_amdgcn_readfirstlane(tid >> 6);
    LAS float* scr = (LAS float*)(lds + wave * 16384);
    const int gw = blockIdx.x * 8 + wave, NGW = G * 8;
    unsigned char* ws = p->ws;
    bf16_t* W1T = (bf16_t*)(ws + WS_W1T); bf16_t* W2T = (bf16_t*)(ws + WS_W2T); bf16_t* WKVT = (bf16_t*)(ws + WS_WKVT); bf16_t* WXQT = (bf16_t*)(ws + WS_WXQT);
    bf16_t* WXOT = (bf16_t*)(ws + WS_WXOT); bf16_t* WGUT = (bf16_t*)(ws + WS_WGUT); bf16_t* WDT = (bf16_t*)(ws + WS_WDT);
    constexpr int I0 = 80 * 16, I1 = 64 * 16, I2 = 32 * 16, I3 = 32 * 32, I4 = 32 * 16, I8 = 88 * 16, I10 = 44 * 32;
    constexpr int NITEMS = I0 + I1 + I2 + I3 + 4 * I4 + 2 * I8 + I10;
    for (int it = gw; it < NITEMS; it += NGW) {
        int r = it;
        if (r < I0) { const int kb = r / 80, nb = r % 80; tr_item(p->in[11], 5656, nb * 32, kb * 64, W1T, 1024, nb * 32, scr, lane); continue; } r -= I0;
        if (r < I1) { const int kb = r / 64, nb = r % 64; tr_item(p->in[11], 5656, 2576 + nb * 32, kb * 64, W1T, 1024, 2560 + nb * 32, scr, lane); continue; } r -= I1;
        if (r < I2) { const int kb = r / 32, nb = r % 32; tr_item(p->in[11], 5656, 4632 + nb * 32, kb * 64, W1T, 1024, 4608 + nb * 32, scr, lane); continue; } r -= I2;
        if (r < I3) { const int kb = r / 32, nb = r % 32; tr_item(p->in[21], 1024, nb * 32, kb * 64, W2T, 2048, nb * 32, scr, lane); continue; } r -= I3;
        if (r < I4) { const int kb = r / 32, nb = r % 32; tr_item(p->in[24], 1024, nb * 32, kb * 64, WKVT, 1024, nb * 32, scr, lane); continue; } r -= I4;
        if (r < I4) { const int kb = r / 32, nb = r % 32; tr_item(p->in[25], 1024, nb * 32, kb * 64, WKVT, 1024, 1024 + nb * 32, scr, lane); continue; } r -= I4;
        if (r < I4) { const int kb = r / 32, nb = r % 32; tr_item(p->in[27], 1024, nb * 32, kb * 64, WXQT, 1024, nb * 32, scr, lane); continue; } r -= I4;
        if (r < I4) { const int kb = r / 32, nb = r % 32; tr_item(p->in[28], 1024, nb * 32, kb * 64, WXOT, 1024, nb * 32, scr, lane); continue; } r -= I4;
        if (r < I8) { const int kb = r / 88, nb = r % 88, n0 = nb * 32; tr_item(p->in[31], FFH, n0, kb * 64, WGUT, 1024, 256 * (n0 >> 7) + (n0 & 127), scr, lane); continue; } r -= I8;
        if (r < I8) { const int kb = r / 88, nb = r % 88, n0 = nb * 32; tr_item(p->in[32], FFH, n0, kb * 64, WGUT, 1024, 256 * (n0 >> 7) + (n0 & 127) + 128, scr, lane); continue; } r -= I8;
        { const int kb = r / 32, nb = r % 32; tr_item(p->in[33], 1024, nb * 32, kb * 64, WDT, FFH, nb * 32, scr, lane); }
    }
    for (int idx = blockIdx.x * 512 + tid; idx < 256 * 1024; idx += G * 512) { const int j = idx >> 10, k = idx & 1023; float v = 0.f;
        if (j < 16) v = p->in[11][(size_t)k * 5656 + 2560 + j]; else if (j < 24) v = p->in[11][(size_t)k * 5656 + 4624 + (j - 16)];
        W1T[(size_t)(5632 + j) * 1024 + k] = f2bf(v); }
    bf16_t* U = (bf16_t*)(ws + WS_U); bf16_t* UM = (bf16_t*)(ws + WS_UM);
    for (int r = gw; r < MT + NMEMROWS; r += NGW) {
        if (r < MP) rms_row_to_bf16(p->in[0] + (size_t)r * DM, p->in[10], U + (size_t)r * DM, lane);
        else if (r < MT) rms_row_to_bf16(p->in[1] + (size_t)(r - MP) * DM, p->in[10], U + (size_t)r * DM, lane);
        else rms_row_to_bf16(p->in[2] + (size_t)(r - MT) * DM, p->in[23], UM + (size_t)(r - MT) * DM, lane);
    }
}

__device__ __forceinline__ void conv_phase(KPtr p, int G) {
    const bf16_t* PROJ = (const bf16_t*)(p->ws + WS_BIG); bf16_t* XBC = (bf16_t*)(p->ws + WS_XBC);
    const float* cw = p->in[12]; const float* cb = p->in[13]; const float* sconv = p->in[4];
    const int NIT = (MT / 8) * 192;
    for (int it = blockIdx.x * 512 + fresh_tid(); it < NIT; it += G * 512) {
        const int rg = it / 192, cg8 = it % 192, c0 = cg8 * 8, r0 = rg * 8;
        const bool samp = r0 >= MP; const int tl0 = samp ? 0 : (r0 & 2047);
        float win[11][8];
#pragma unroll
        for (int i = 0; i < 11; ++i) {
            const int rr = i - 3;
            if (rr >= 0 || tl0 > 0) { const u32x4 w = *(const u32x4*)(PROJ + (size_t)(r0 + rr) * PROJ_LD + 1024 + c0);
                win[i][0] = bflo(w.x); win[i][1] = bfhi(w.x); win[i][2] = bflo(w.y); win[i][3] = bfhi(w.y); win[i][4] = bflo(w.z); win[i][5] = bfhi(w.z); win[i][6] = bflo(w.w); win[i][7] = bfhi(w.w); }
            else if (samp) { const int b = (r0 - MP) >> 3; const float* sp = sconv + ((size_t)b * 3 + i) * XBC_LD + c0; const f32x4 a = *(const f32x4*)sp, bq = *(const f32x4*)(sp + 4);
                win[i][0] = a.x; win[i][1] = a.y; win[i][2] = a.z; win[i][3] = a.w; win[i][4] = bq.x; win[i][5] = bq.y; win[i][6] = bq.z; win[i][7] = bq.w; }
            else {
#pragma unroll
                for (int e = 0; e < 8; ++e) win[i][e] = 0.f; }
        }
        float w4[4][8], bb[8];
#pragma unroll
        for (int j = 0; j < 4; ++j) { const f32x4 a = *(const f32x4*)(cw + j * XBC_LD + c0), bq = *(const f32x4*)(cw + j * XBC_LD + c0 + 4);
            w4[j][0] = a.x; w4[j][1] = a.y; w4[j][2] = a.z; w4[j][3] = a.w; w4[j][4] = bq.x; w4[j][5] = bq.y; w4[j][6] = bq.z; w4[j][7] = bq.w; }
        { const f32x4 a = *(const f32x4*)(cb + c0), bq = *(const f32x4*)(cb + c0 + 4); bb[0] = a.x; bb[1] = a.y; bb[2] = a.z; bb[3] = a.w; bb[4] = bq.x; bb[5] = bq.y; bb[6] = bq.z; bb[7] = bq.w; }
#pragma unroll
        for (int t = 0; t < 8; ++t) { float y[8];
#pragma unroll
            for (int e = 0; e < 8; ++e) { float a = bb[e];
#pragma unroll
                for (int j = 0; j < 4; ++j) a += win[t + j][e] * w4[j][e];
                y[e] = siluf(a); }
            u32x4 w; w.x = cvt_pk_bf16(y[0], y[1]); w.y = cvt_pk_bf16(y[2], y[3]); w.z = cvt_pk_bf16(y[4], y[5]); w.w = cvt_pk_bf16(y[6], y[7]);
            *(u32x4*)(XBC + (size_t)(r0 + t) * XBC_LD + c0) = w; }
        if (samp || tl0 + 8 == 2048) {
            float* dst = samp ? (p->out + O_CONVS + (size_t)((r0 - MP) >> 3) * 3 * XBC_LD) : (p->out + O_CONVP + (size_t)(r0 >> 11) * 3 * XBC_LD);
#pragma unroll
            for (int i = 0; i < 3; ++i) { *(f32x4*)(dst + (size_t)i * XBC_LD + c0) = (f32x4){win[8 + i][0], win[8 + i][1], win[8 + i][2], win[8 + i][3]};
                *(f32x4*)(dst + (size_t)i * XBC_LD + c0 + 4) = (f32x4){win[8 + i][4], win[8 + i][5], win[8 + i][6], win[8 + i][7]}; }
        }
    }
}

#define MFMA16(a, b, c) __builtin_amdgcn_mfma_f32_16x16x32_bf16(a, b, c, 0, 0, 0)
#define LBAR() do { asm volatile("s_waitcnt lgkmcnt(0)" ::: "memory"); __builtin_amdgcn_s_barrier(); asm volatile("" ::: "memory"); } while (0)
#define LDSF(off) (*(LAS float*)(lds + (off)))
#define LDSH(off) (*(LAS unsigned short*)(lds + (off)))
#define LDSV8(off) (*(const LAS bf16x8*)(lds + (off)))

constexpr int SP_CM = 0, SP_BM = 17408, SP_BMT = 34816, SP_XT = 53248, SP_WM = 62464, SP_HB = 71680, SP_DT = 89088, SP_CUM = 89344;
__device__ __forceinline__ void ssd_prompt_unit(KPtr p, ldsp lds, int b, int h) {
    const int tid = fresh_tid(), lane = tid & 63, wid = __builtin_amdgcn_readfirstlane(tid >> 6), l15 = lane & 15, quad = lane >> 4;
    const int g = h >> 3, tq = wid >> 1, half = wid & 1;
    const bf16_t* XBC = (const bf16_t*)(p->ws + WS_XBC); const bf16_t* PROJ = (const bf16_t*)(p->ws + WS_BIG); const float* GATES = (const float*)(p->ws + WS_GATES);
    bf16_t* YPRE = (bf16_t*)(p->ws + WS_YPRE);
    const float dtb = p->in[14][h], aneg = -__expf(p->in[15][h]), dsk = p->in[16][h];
    const size_t rowbase = (size_t)b * 2048;
    for (int i = tid; i < 17408 / 4; i += 512) *(LAS unsigned*)(lds + SP_HB + i * 4) = 0u;
    f32x4 Hst[4];
#pragma unroll
    for (int i = 0; i < 4; ++i) Hst[i] = (f32x4){0.f, 0.f, 0.f, 0.f};
    u32x4 pa[3], pb[3]; float dtraw = 0.f;
    int spr[3], sgrp[3];
#pragma unroll
    for (int i = 0; i < 3; ++i) { int v = (i < 2) ? tid + 512 * i : (tid >= 256 ? tid + 768 : 1279); spr[i] = v & 31; sgrp[i] = v >> 5; }
#define SSD_COL(gi) ((gi) < 8 ? h * 64 + (gi) * 8 : ((gi) < 24 ? 1024 + g * 128 + ((gi) - 8) * 8 : 1280 + g * 128 + ((gi) - 24) * 8))
#pragma unroll
    for (int i = 0; i < 3; ++i) { const bf16_t* src_ = XBC + (rowbase + 2 * spr[i]) * XBC_LD + SSD_COL(sgrp[i]); pa[i] = *(const u32x4*)src_; pb[i] = *(const u32x4*)(src_ + XBC_LD); }
    if (wid == 0) dtraw = GATES[(rowbase + lane) * 32 + h];
    for (int ch = 0; ch < 32; ++ch) {
        const size_t crow = rowbase + (size_t)ch * 64;
        if (wid == 0) { const float dt = softplusf(dtraw + dtb); float cum = dt * aneg;
#pragma unroll
            for (int o = 1; o < 64; o <<= 1) { const float t2 = __shfl_up(cum, o); if (lane >= o) cum += t2; }
            LDSF(SP_DT + lane * 4) = dt; LDSF(SP_CUM + lane * 4) = cum; }
        LBAR();
        const float cum63 = LDSF(SP_CUM + 63 * 4);
#pragma unroll
        for (int i = 0; i < 3; ++i) { if (i < 2 || tid >= 256) { const int gi = sgrp[i], sp = spr[i]; const unsigned wa[4] = {pa[i].x, pa[i].y, pa[i].z, pa[i].w}, wb[4] = {pb[i].x, pb[i].y, pb[i].z, pb[i].w};
            if (gi < 8) { const int p0 = gi * 8;
#pragma unroll
                for (int e = 0; e < 4; ++e) { *(LAS unsigned*)(lds + SP_XT + (p0 + 2 * e) * 144 + sp * 4) = (wa[e] & 0xffffu) | (wb[e] << 16); *(LAS unsigned*)(lds + SP_XT + (p0 + 2 * e + 1) * 144 + sp * 4) = (wa[e] >> 16) | (wb[e] & 0xffff0000u); } }
            else if (gi < 24) { const int n0 = (gi - 8) * 8; *(LAS u32x4*)(lds + SP_BM + (2 * sp) * 272 + n0 * 2) = pa[i]; *(LAS u32x4*)(lds + SP_BM + (2 * sp + 1) * 272 + n0 * 2) = pb[i];
                const f32x2 cs = *(const LAS f32x2*)(lds + SP_CUM + sp * 8), ds = *(const LAS f32x2*)(lds + SP_DT + sp * 8);
                const float wea = __expf(cum63 - cs.x) * ds.x, web = __expf(cum63 - cs.y) * ds.y;
#pragma unroll
                for (int e = 0; e < 4; ++e) { *(LAS unsigned*)(lds + SP_BMT + (n0 + 2 * e) * 144 + sp * 4) = cvt_pk_bf16(bflo(wa[e]) * wea, bflo(wb[e]) * web); *(LAS unsigned*)(lds + SP_BMT + (n0 + 2 * e + 1) * 144 + sp * 4) = cvt_pk_bf16(bfhi(wa[e]) * wea, bfhi(wb[e]) * web); } }
            else { *(LAS u32x4*)(lds + SP_CM + (2 * sp) * 272 + (gi - 24) * 16) = pa[i]; *(LAS u32x4*)(lds + SP_CM + (2 * sp + 1) * 272 + (gi - 24) * 16) = pb[i]; } } }
        if (ch + 1 < 32) {
#pragma unroll
            for (int i = 0; i < 3; ++i) { const bf16_t* src_ = XBC + (crow + 64 + 2 * spr[i]) * XBC_LD + SSD_COL(sgrp[i]); pa[i] = *(const u32x4*)src_; pb[i] = *(const u32x4*)(src_ + XBC_LD); }
            if (wid == 0) dtraw = GATES[(crow + 64 + lane) * 32 + h];
        }
        const int t = tq * 16 + l15;
        u32x2 zr[2];
#pragma unroll
        for (int pt2 = 0; pt2 < 2; ++pt2) zr[pt2] = *(const u32x2*)(PROJ + (crow + t) * PROJ_LD + h * 64 + (2 * half + pt2) * 16 + quad * 4);
        LBAR();
        const float cum_t = LDSF(SP_CUM + t * 4);
        {
            f32x4 cbv[2] = {(f32x4){0.f, 0.f, 0.f, 0.f}, (f32x4){0.f, 0.f, 0.f, 0.f}};
#pragma unroll
            for (int ks = 0; ks < 4; ++ks) { const bf16x8 bfr = LDSV8(SP_CM + t * 272 + ks * 64 + quad * 16);
#pragma unroll
                for (int s2 = 0; s2 < 2; ++s2) { const bf16x8 afr = LDSV8(SP_BM + ((2 * half + s2) * 16 + l15) * 272 + ks * 64 + quad * 16); cbv[s2] = MFMA16(afr, bfr, cbv[s2]); } }
#pragma unroll
            for (int s2 = 0; s2 < 2; ++s2) { const int s0 = (2 * half + s2) * 16 + quad * 4; const f32x4 cs = *(const LAS f32x4*)(lds + SP_CUM + s0 * 4), ds = *(const LAS f32x4*)(lds + SP_DT + s0 * 4);
                float wv[4];
#pragma unroll
                for (int j = 0; j < 4; ++j) wv[j] = (s0 + j <= t) ? cbv[s2][j] * __expf(cum_t - cs[j]) * ds[j] : 0.f;
                u32x2 o; o.x = cvt_pk_bf16(wv[0], wv[1]); o.y = cvt_pk_bf16(wv[2], wv[3]); *(LAS u32x2*)(lds + SP_WM + t * 144 + s0 * 2) = o; }
        }
        LBAR();
        {
            f32x4 ya[2] = {(f32x4){0.f, 0.f, 0.f, 0.f}, (f32x4){0.f, 0.f, 0.f, 0.f}};
#pragma unroll
            for (int ks = 0; ks < 4; ++ks) { const bf16x8 bfr = LDSV8(SP_CM + t * 272 + ks * 64 + quad * 16);
#pragma unroll
                for (int p2 = 0; p2 < 2; ++p2) { const bf16x8 afr = LDSV8(SP_HB + ((2 * half + p2) * 16 + l15) * 272 + ks * 64 + quad * 16); ya[p2] = MFMA16(afr, bfr, ya[p2]); } }
            const float ec = __expf(cum_t); ya[0] = ya[0] * ec; ya[1] = ya[1] * ec;
#pragma unroll
            for (int ks = 0; ks < 2; ++ks) { const bf16x8 bfr = LDSV8(SP_WM + t * 144 + ks * 64 + quad * 16);
#pragma unroll
                for (int p2 = 0; p2 < 2; ++p2) { const bf16x8 afr = LDSV8(SP_XT + ((2 * half + p2) * 16 + l15) * 144 + ks * 64 + quad * 16); ya[p2] = MFMA16(afr, bfr, ya[p2]); } }
#pragma unroll
            for (int p2 = 0; p2 < 2; ++p2) { const int p0 = (2 * half + p2) * 16 + quad * 4; float yv[4]; const float zz[4] = {bflo(zr[p2].x), bfhi(zr[p2].x), bflo(zr[p2].y), bfhi(zr[p2].y)};
#pragma unroll
                for (int j = 0; j < 4; ++j) { const float xv = bf2f(LDSH(SP_XT + (p0 + j) * 144 + t * 2)); yv[j] = (ya[p2][j] + dsk * xv) * siluf(zz[j]); }
                u32x2 o; o.x = cvt_pk_bf16(yv[0], yv[1]); o.y = cvt_pk_bf16(yv[2], yv[3]); *(u32x2*)(YPRE + (crow + t) * YP_LD + h * 64 + p0) = o; }
        }
        {
            const float eend = __expf(cum63);
#pragma unroll
            for (int i = 0; i < 4; ++i) Hst[i] = Hst[i] * eend;
#pragma unroll
            for (int ks = 0; ks < 2; ++ks) { const bf16x8 afr = LDSV8(SP_BMT + (wid * 16 + l15) * 144 + ks * 64 + quad * 16);
#pragma unroll
                for (int pt = 0; pt < 4; ++pt) { const bf16x8 bfr = LDSV8(SP_XT + (pt * 16 + l15) * 144 + ks * 64 + quad * 16); Hst[pt] = MFMA16(afr, bfr, Hst[pt]); } }
        }
        LBAR();
#pragma unroll
        for (int pt = 0; pt < 4; ++pt) { u32x2 o; o.x = cvt_pk_bf16(Hst[pt][0], Hst[pt][1]); o.y = cvt_pk_bf16(Hst[pt][2], Hst[pt][3]);
            *(LAS u32x2*)(lds + SP_HB + (pt * 16 + l15) * 272 + (wid * 16 + quad * 4) * 2) = o; }
    }
    float* so = p->out + O_SSMP + (size_t)(b * 16 + h) * 64 * 128;
#pragma unroll
    for (int pt = 0; pt < 4; ++pt) *(f32x4*)(so + (size_t)(pt * 16 + l15) * 128 + wid * 16 + quad * 4) = Hst[pt];
    __syncthreads();
}

constexpr int ML_QM = 0, ML_KM = 17408, ML_KMT = 34816, ML_VT = 53248, ML_SM = 64768, ML_CBT = 73984, ML_AV = 95744, ML_MV = 96000, ML_EM = 96256, ML_SI = 96512, ML_SC = 96768;
__device__ __forceinline__ void mlstm_prompt_unit(KPtr p, ldsp lds, int b, int head, int vq) {
    const int tid = fresh_tid(), lane = tid & 63, wid = __builtin_amdgcn_readfirstlane(tid >> 6), l15 = lane & 15, quad = lane >> 4;
    const int tq = wid >> 1, half = wid & 1;
    const bf16_t* PROJ = (const bf16_t*)(p->ws + WS_BIG); const float* GATES = (const float*)(p->ws + WS_GATES); bf16_t* YPRE = (bf16_t*)(p->ws + WS_YPRE);
    const float bi = p->in[18][head], bfg = p->in[19][head];
    const float qscale = 0.08838834764831845f;
    const size_t rowbase = (size_t)b * 2048;
    for (int i = tid; i < 21760 / 4; i += 512) *(LAS unsigned*)(lds + ML_CBT + i * 4) = 0u;
    for (int i = tid; i < 16 * 144 / 4; i += 512) { const int off = i * 4; *(LAS unsigned*)(lds + ML_VT + 64 * 144 + off) = (off < 128) ? 0x3F803F80u : 0u; }
    f32x4 Cst[5];
#pragma unroll
    for (int i = 0; i < 5; ++i) Cst[i] = (f32x4){0.f, 0.f, 0.f, 0.f};
    float mprev = 0.f, igr = 0.f, fgr = 0.f;
    u32x4 pa[3], pb[3]; int spr[3], sgrp[3];
#pragma unroll
    for (int i = 0; i < 3; ++i) { int v = (i < 2) ? tid + 512 * i : (tid >= 256 ? tid + 768 : 1279); spr[i] = v & 31; sgrp[i] = v >> 5; }
#define ML_COL(gi) ((gi) < 16 ? 2560 + head * 128 + (gi) * 8 : ((gi) < 32 ? 3072 + head * 128 + ((gi) - 16) * 8 : 3584 + head * 256 + vq * 64 + ((gi) - 32) * 8))
#pragma unroll
    for (int i = 0; i < 3; ++i) { const bf16_t* src_ = PROJ + (rowbase + 2 * spr[i]) * PROJ_LD + ML_COL(sgrp[i]); pa[i] = *(const u32x4*)src_; pb[i] = *(const u32x4*)(src_ + PROJ_LD); }
    if (wid == 0) { igr = GATES[(rowbase + lane) * 32 + 16 + head]; fgr = GATES[(rowbase + lane) * 32 + 20 + head]; }
    for (int ch = 0; ch < 32; ++ch) {
        const size_t crow = rowbase + (size_t)ch * 64;
        if (wid == 0) {
            const float iv = igr + bi, x = fgr + bfg; const float logf = fminf(x, 0.f) - __logf(1.f + __expf(-fabsf(x)));
            float bc = logf;
#pragma unroll
            for (int o = 1; o < 64; o <<= 1) { const float t2 = __shfl_up(bc, o); if (lane >= o) bc += t2; }
            const float a = iv - bc; float pm = a;
#pragma unroll
            for (int o = 1; o < 64; o <<= 1) { const float t2 = __shfl_up(pm, o); if (lane >= o) pm = fmaxf(pm, t2); }
            const float M = fmaxf(pm, mprev);
            LDSF(ML_AV + lane * 4) = a; LDSF(ML_MV + lane * 4) = M; LDSF(ML_EM + lane * 4) = __expf(-(bc + M)); LDSF(ML_SI + lane * 4) = __expf(mprev - M) * qscale;
            const float M63 = __shfl(M, 63), bc63 = __shfl(bc, 63);
            if (lane == 0) { LDSF(ML_SC) = M63; LDSF(ML_SC + 4) = __expf(mprev - M63); }
            mprev = bc63 + M63;
        }
        LBAR();
        const float M63 = LDSF(ML_SC), scaleC = LDSF(ML_SC + 4);
#pragma unroll
        for (int i = 0; i < 3; ++i) { if (i < 2 || tid >= 256) { const int gi = sgrp[i], sp = spr[i]; const unsigned wa[4] = {pa[i].x, pa[i].y, pa[i].z, pa[i].w}, wb[4] = {pb[i].x, pb[i].y, pb[i].z, pb[i].w};
            if (gi < 16) { *(LAS u32x4*)(lds + ML_QM + (2 * sp) * 272 + gi * 16) = pa[i]; *(LAS u32x4*)(lds + ML_QM + (2 * sp + 1) * 272 + gi * 16) = pb[i]; }
            else if (gi < 32) { const int d0 = (gi - 16) * 8; *(LAS u32x4*)(lds + ML_KM + (2 * sp) * 272 + d0 * 2) = pa[i]; *(LAS u32x4*)(lds + ML_KM + (2 * sp + 1) * 272 + d0 * 2) = pb[i];
                const f32x2 av = *(const LAS f32x2*)(lds + ML_AV + sp * 8); const float wea = __expf(av.x - M63), web = __expf(av.y - M63);
#pragma unroll
                for (int e = 0; e < 4; ++e) { *(LAS unsigned*)(lds + ML_KMT + (d0 + 2 * e) * 144 + sp * 4) = cvt_pk_bf16(bflo(wa[e]) * wea, bflo(wb[e]) * web); *(LAS unsigned*)(lds + ML_KMT + (d0 + 2 * e + 1) * 144 + sp * 4) = cvt_pk_bf16(bfhi(wa[e]) * wea, bfhi(wb[e]) * web); } }
            else { const int v0 = (gi - 32) * 8;
#pragma unroll
                for (int e = 0; e < 4; ++e) { *(LAS unsigned*)(lds + ML_VT + (v0 + 2 * e) * 144 + sp * 4) = (wa[e] & 0xffffu) | (wb[e] << 16); *(LAS unsigned*)(lds + ML_VT + (v0 + 2 * e + 1) * 144 + sp * 4) = (wa[e] >> 16) | (wb[e] & 0xffff0000u); } } } }
        if (ch + 1 < 32) {
#pragma unroll
            for (int i = 0; i < 3; ++i) { const bf16_t* src_ = PROJ + (crow + 64 + 2 * spr[i]) * PROJ_LD + ML_COL(sgrp[i]); pa[i] = *(const u32x4*)src_; pb[i] = *(const u32x4*)(src_ + PROJ_LD); }
            if (wid == 0) { igr = GATES[(crow + 64 + lane) * 32 + 16 + head]; fgr = GATES[(crow + 64 + lane) * 32 + 20 + head]; }
        }
        LBAR();
        const int t = tq * 16 + l15;
        const float M_t = LDSF(ML_MV + t * 4);
        {
            f32x4 sv[2] = {(f32x4){0.f, 0.f, 0.f, 0.f}, (f32x4){0.f, 0.f, 0.f, 0.f}};
#pragma unroll
            for (int ks = 0; ks < 4; ++ks) { const bf16x8 bfr = LDSV8(ML_QM + t * 272 + ks * 64 + quad * 16);
#pragma unroll
                for (int s2 = 0; s2 < 2; ++s2) { const bf16x8 afr = LDSV8(ML_KM + ((2 * half + s2) * 16 + l15) * 272 + ks * 64 + quad * 16); sv[s2] = MFMA16(afr, bfr, sv[s2]); } }
#pragma unroll
            for (int s2 = 0; s2 < 2; ++s2) { const int s0 = (2 * half + s2) * 16 + quad * 4; const f32x4 as = *(const LAS f32x4*)(lds + ML_AV + s0 * 4); float wv[4];
#pragma unroll
                for (int j = 0; j < 4; ++j) wv[j] = (s0 + j <= t) ? sv[s2][j] * qscale * __expf(as[j] - M_t) : 0.f;
                u32x2 o; o.x = cvt_pk_bf16(wv[0], wv[1]); o.y = cvt_pk_bf16(wv[2], wv[3]); *(LAS u32x2*)(lds + ML_SM + t * 144 + s0 * 2) = o; }
        }
        LBAR();
        {
            f32x4 na[3] = {(f32x4){0.f, 0.f, 0.f, 0.f}, (f32x4){0.f, 0.f, 0.f, 0.f}, (f32x4){0.f, 0.f, 0.f, 0.f}};
#pragma unroll
            for (int ks = 0; ks < 4; ++ks) { const bf16x8 bfr = LDSV8(ML_QM + t * 272 + ks * 64 + quad * 16);
#pragma unroll
                for (int v2 = 0; v2 < 3; ++v2) { const int vt = v2 < 2 ? 2 * half + v2 : 4; const bf16x8 afr = LDSV8(ML_CBT + (vt * 16 + l15) * 272 + ks * 64 + quad * 16); na[v2] = MFMA16(afr, bfr, na[v2]); } }
            const float si = LDSF(ML_SI + t * 4);
#pragma unroll
            for (int v2 = 0; v2 < 3; ++v2) na[v2] = na[v2] * si;
#pragma unroll
            for (int ks = 0; ks < 2; ++ks) { const bf16x8 bfr = LDSV8(ML_SM + t * 144 + ks * 64 + quad * 16);
#pragma unroll
                for (int v2 = 0; v2 < 3; ++v2) { const int vt = v2 < 2 ? 2 * half + v2 : 4; const bf16x8 afr = LDSV8(ML_VT + (vt * 16 + l15) * 144 + ks * 64 + quad * 16); na[v2] = MFMA16(afr, bfr, na[v2]); } }
            const float den = __shfl(na[2][0], l15);
            const float dn = __builtin_amdgcn_rcpf(fmaxf(fabsf(den), LDSF(ML_EM + t * 4)));
#pragma unroll
            for (int v2 = 0; v2 < 2; ++v2) { const int v0 = (2 * half + v2) * 16 + quad * 4; u32x2 o; o.x = cvt_pk_bf16(na[v2][0] * dn, na[v2][1] * dn); o.y = cvt_pk_bf16(na[v2][2] * dn, na[v2][3] * dn);
                *(u32x2*)(YPRE + (crow + t) * YP_LD + 1024 + head * 256 + vq * 64 + v0) = o; }
        }
        {
#pragma unroll
            for (int i = 0; i < 5; ++i) Cst[i] = Cst[i] * scaleC;
#pragma unroll
            for (int ks = 0; ks < 2; ++ks) { const bf16x8 afr = LDSV8(ML_KMT + (wid * 16 + l15) * 144 + ks * 64 + quad * 16);
#pragma unroll
                for (int vt = 0; vt < 5; ++vt) { const bf16x8 bfr = LDSV8(ML_VT + (vt * 16 + l15) * 144 + ks * 64 + quad * 16); Cst[vt] = MFMA16(afr, bfr, Cst[vt]); } }
        }
        LBAR();
#pragma unroll
        for (int vt = 0; vt < 5; ++vt) { u32x2 o; o.x = cvt_pk_bf16(Cst[vt][0], Cst[vt][1]); o.y = cvt_pk_bf16(Cst[vt][2], Cst[vt][3]);
            *(LAS u32x2*)(lds + ML_CBT + (vt * 16 + l15) * 272 + (wid * 16 + quad * 4) * 2) = o; }
    }
    float* co = p->out + O_MCP + (size_t)(b * 4 + head) * 128 * 256;
#pragma unroll
    for (int vt = 0; vt < 4; ++vt)
#pragma unroll
        for (int j = 0; j < 4; ++j) co[(size_t)(wid * 16 + quad * 4 + j) * 256 + vq * 64 + vt * 16 + l15] = Cst[vt][j];
    if (vq == 0) {
        if (l15 == 0) *(f32x4*)(p->out + O_MNP + (size_t)(b * 4 + head) * 128 + wid * 16 + quad * 4) = Cst[4];
        if (tid == 0) p->out[O_MMP + b * 4 + head] = mprev;
    }
    __syncthreads();
}

constexpr int SS_X = 0, SS_B = 2048, SS_C = 6144, SS_DT = 10240, SS_CUM = 10272, SS_W = 10304;
__device__ __forceinline__ void ssd_sample_unit(KPtr p, ldsp lds, int b, int h) {
    const int tid = fresh_tid(); const int g = h >> 3;
    const bf16_t* XBC = (const bf16_t*)(p->ws + WS_XBC); const bf16_t* PROJ = (const bf16_t*)(p->ws + WS_BIG); const float* GATES = (const float*)(p->ws + WS_GATES); bf16_t* YPRE = (bf16_t*)(p->ws + WS_YPRE);
    const float dtb = p->in[14][h], aneg = -__expf(p->in[15][h]), dsk = p->in[16][h];
    const size_t r0 = (size_t)MP + (size_t)b * 8;
    const int pp = tid >> 3, ns = tid & 7;
    const float* hp = p->in[3] + ((size_t)(b * 16 + h) * 64 + pp) * 128 + ns * 16;
    f32x4 h0[4];
#pragma unroll
    for (int i = 0; i < 4; ++i) h0[i] = *(const f32x4*)(hp + 4 * i);
    if (tid < 320) {
        const int kind = tid < 64 ? 0 : (tid < 192 ? 1 : 2), i = kind == 0 ? tid : (kind == 1 ? tid - 64 : tid - 192);
        const int t = kind == 0 ? (i >> 3) : (i >> 4), c8 = kind == 0 ? (i & 7) * 8 : (i & 15) * 8;
        const int col = kind == 0 ? h * 64 + c8 : (kind == 1 ? 1024 : 1280) + g * 128 + c8;
        const int off = kind == 0 ? SS_X + (t * 64 + c8) * 4 : (kind == 1 ? SS_B : SS_C) + (t * 128 + c8) * 4;
        const u32x4 w = *(const u32x4*)(XBC + (r0 + t) * XBC_LD + col);
        *(LAS f32x4*)(lds + off) = (f32x4){bflo(w.x), bfhi(w.x), bflo(w.y), bfhi(w.y)}; *(LAS f32x4*)(lds + off + 16) = (f32x4){bflo(w.z), bfhi(w.z), bflo(w.w), bfhi(w.w)}; }
    if (tid < 8) LDSF(SS_DT + tid * 4) = softplusf(GATES[(r0 + tid) * 32 + h] + dtb);
    const float zv = bf2f(PROJ[(r0 + ns) * PROJ_LD + h * 64 + pp]);
    __syncthreads();
    if (tid < 8) { float c = 0.f; for (int u = 0; u <= tid; ++u) c += LDSF(SS_DT + u * 4) * aneg; LDSF(SS_CUM + tid * 4) = c; }
    __syncthreads();
    if (tid < 64) { const int t = tid >> 3, s = tid & 7; float cbv = 0.f;
        for (int n = 0; n < 128; ++n) cbv += LDSF(SS_C + (t * 128 + n) * 4) * LDSF(SS_B + (s * 128 + n) * 4);
        LDSF(SS_W + tid * 4) = (s <= t) ? cbv * __expf(LDSF(SS_CUM + t * 4) - LDSF(SS_CUM + s * 4)) * LDSF(SS_DT + s * 4) : 0.f; }
    float part[8];
#pragma unroll
    for (int t = 0; t < 8; ++t) { float a = 0.f;
#pragma unroll
        for (int i = 0; i < 4; ++i) { const f32x4 cv = *(const LAS f32x4*)(lds + SS_C + (t * 128 + ns * 16 + i * 4) * 4); a += cv.x * h0[i].x + cv.y * h0[i].y + cv.z * h0[i].z + cv.w * h0[i].w; }
        a += __shfl_xor(a, 1); a += __shfl_xor(a, 2); a += __shfl_xor(a, 4); part[t] = a; }
    __syncthreads();
    {
        float yi = part[0];
#pragma unroll
        for (int t = 1; t < 8; ++t) yi = (ns == t) ? part[t] : yi;
        const int t = ns; float y = yi * __expf(LDSF(SS_CUM + t * 4));
#pragma unroll
        for (int s = 0; s < 8; ++s) y += LDSF(SS_W + (t * 8 + s) * 4) * LDSF(SS_X + (s * 64 + pp) * 4);
        y += dsk * LDSF(SS_X + (t * 64 + pp) * 4);
        YPRE[(r0 + t) * YP_LD + h * 64 + pp] = f2bf(y * siluf(zv));
    }
    const float cum7 = LDSF(SS_CUM + 7 * 4), e7 = __expf(cum7);
    f32x4 hn[4];
#pragma unroll
    for (int i = 0; i < 4; ++i) hn[i] = h0[i] * e7;
#pragma unroll
    for (int s = 0; s < 8; ++s) { const float wx = __expf(cum7 - LDSF(SS_CUM + s * 4)) * LDSF(SS_DT + s * 4) * LDSF(SS_X + (s * 64 + pp) * 4);
#pragma unroll
        for (int i = 0; i < 4; ++i) { const f32x4 bv = *(const LAS f32x4*)(lds + SS_B + (s * 128 + ns * 16 + i * 4) * 4); hn[i] = hn[i] + bv * wx; } }
    float* ho = p->out + O_SSMS + ((size_t)(b * 16 + h) * 64 + pp) * 128 + ns * 16;
#pragma unroll
    for (int i = 0; i < 4; ++i) *(f32x4*)(ho + 4 * i) = hn[i];
    __syncthreads();
}

constexpr int MS_Q = 0, MS_K = 4096, MS_V = 8192, MS_I = 12288, MS_LF = 12320, MS_A = 12352, MS_M = 12384, MS_EM = 12416, MS_SI = 12448, MS_WE = 12480, MS_DEN = 12512, MS_SC = 12544, MS_S = 12608, MS_N0 = 12864, MS_RED = 16384;
__device__ __forceinline__ void mlstm_sample_unit(KPtr p, ldsp lds, int b, int head, int vh) {
    const int tid = fresh_tid(), lane = tid & 63, wid = __builtin_amdgcn_readfirstlane(tid >> 6);
    const bf16_t* PROJ = (const bf16_t*)(p->ws + WS_BIG); const float* GATES = (const float*)(p->ws + WS_GATES); bf16_t* YPRE = (bf16_t*)(p->ws + WS_YPRE);
    const float bi = p->in[18][head], bfg = p->in[19][head]; const float qscale = 0.08838834764831845f;
    const size_t r0 = (size_t)MP + (size_t)b * 8;
    const float mprev = p->in[7][b * 4 + head];
    const int dsg = tid >> 5, vq4 = tid & 31;
    const float* cp = p->in[5] + ((size_t)(b * 4 + head) * 128 + dsg * 8) * 256 + vh * 128 + vq4 * 4;
    f32x4 Cr[8];
#pragma unroll
    for (int i = 0; i < 8; ++i) Cr[i] = *(const f32x4*)(cp + (size_t)i * 256);
    if (tid < 384) {
        const int kind = tid >> 7, i = tid & 127, t = i >> 4, c8 = (i & 15) * 8;
        const int col = kind == 0 ? 2560 + head * 128 + c8 : (kind == 1 ? 3072 + head * 128 + c8 : 3584 + head * 256 + vh * 128 + c8);
        const int off = (kind == 0 ? MS_Q : (kind == 1 ? MS_K : MS_V)) + (t * 128 + c8) * 4; const float sc = kind == 0 ? qscale : 1.f;
        const u32x4 w = *(const u32x4*)(PROJ + (r0 + t) * PROJ_LD + col);
        *(LAS f32x4*)(lds + off) = (f32x4){bflo(w.x), bfhi(w.x), bflo(w.y), bfhi(w.y)} * sc; *(LAS f32x4*)(lds + off + 16) = (f32x4){bflo(w.z), bfhi(w.z), bflo(w.w), bfhi(w.w)} * sc; }
    if (tid < 128) LDSF(MS_N0 + tid * 4) = p->in[6][(size_t)(b * 4 + head) * 128 + tid];
    if (tid < 8) { const float x = GATES[(r0 + tid) * 32 + 20 + head] + bfg; LDSF(MS_I + tid * 4) = GATES[(r0 + tid) * 32 + 16 + head] + bi;
        LDSF(MS_LF + tid * 4) = fminf(x, 0.f) - __logf(1.f + __expf(-fabsf(x))); }
    __syncthreads();
    if (tid < 8) { float bc = 0.f, am = -3.0e38f, a = 0.f;
        for (int s = 0; s <= tid; ++s) { bc += LDSF(MS_LF + s * 4); a = LDSF(MS_I + s * 4) - bc; am = fmaxf(am, a); }
        const float M = fmaxf(am, mprev);
        LDSF(MS_A + tid * 4) = a; LDSF(MS_M + tid * 4) = M; LDSF(MS_EM + tid * 4) = __expf(-(bc + M)); LDSF(MS_SI + tid * 4) = __expf(mprev - M);
        if (tid == 7) { LDSF(MS_SC) = __expf(mprev - M); LDSF(MS_SC + 4) = bc + M; } }
    __syncthreads();
    if (tid < 8) LDSF(MS_WE + tid * 4) = __expf(LDSF(MS_A + tid * 4) - LDSF(MS_M + 7 * 4));
    if (tid < 64) { const int t = tid >> 3, s = tid & 7; float a = 0.f;
        for (int d = 0; d < 128; ++d) a += LDSF(MS_Q + (t * 128 + d) * 4) * LDSF(MS_K + (s * 128 + d) * 4);
        LDSF(MS_S + tid * 4) = (s <= t) ? a * __expf(LDSF(MS_A + s * 4) - LDSF(MS_M + t * 4)) : 0.f; }
    {
#pragma unroll
        for (int t = 0; t < 8; ++t) { f32x4 a = (f32x4){0.f, 0.f, 0.f, 0.f};
#pragma unroll
            for (int dd = 0; dd < 8; ++dd) { const float qv = LDSF(MS_Q + (t * 128 + dsg * 8 + dd) * 4); a = a + Cr[dd] * qv; }
            a.x += __shfl_xor(a.x, 32); a.y += __shfl_xor(a.y, 32); a.z += __shfl_xor(a.z, 32); a.w += __shfl_xor(a.w, 32);
            if (lane < 32) *(LAS f32x4*)(lds + MS_RED + ((wid * 8 + t) * 128 + vq4 * 4) * 4) = a; }
    }
    __syncthreads();
    if (tid < 8) { float d = 0.f, qn = 0.f; for (int s = 0; s < 8; ++s) d += LDSF(MS_S + (tid * 8 + s) * 4);
        for (int dd = 0; dd < 128; ++dd) qn += LDSF(MS_Q + (tid * 128 + dd) * 4) * LDSF(MS_N0 + dd * 4);
        LDSF(MS_DEN + tid * 4) = d + LDSF(MS_SI + tid * 4) * qn; }
    __syncthreads();
    { const int t = tid >> 6, v2 = (tid & 63) * 2; const float si = LDSF(MS_SI + t * 4); const float dn = 1.f / fmaxf(fabsf(LDSF(MS_DEN + t * 4)), LDSF(MS_EM + t * 4)); float r[2];
#pragma unroll
        for (int e = 0; e < 2; ++e) { const int v = v2 + e; float ni = 0.f;
#pragma unroll
            for (int w = 0; w < 8; ++w) ni += LDSF(MS_RED + ((w * 8 + t) * 128 + v) * 4);
            float num = ni * si;
#pragma unroll
            for (int s = 0; s < 8; ++s) num += LDSF(MS_S + (t * 8 + s) * 4) * LDSF(MS_V + (s * 128 + v) * 4);
            r[e] = num * dn; }
        *(unsigned*)(YPRE + (r0 + t) * YP_LD + 1024 + head * 256 + vh * 128 + v2) = cvt_pk_bf16(r[0], r[1]); }
    const float scaleC = LDSF(MS_SC);
#pragma unroll
    for (int i = 0; i < 8; ++i) Cr[i] = Cr[i] * scaleC;
#pragma unroll
    for (int s = 0; s < 8; ++s) { const float we = LDSF(MS_WE + s * 4); const f32x4 vv = *(const LAS f32x4*)(lds + MS_V + (s * 128 + vq4 * 4) * 4) * we;
#pragma unroll
        for (int i = 0; i < 8; ++i) Cr[i] = Cr[i] + vv * LDSF(MS_K + (s * 128 + dsg * 8 + i) * 4); }
    float* co = p->out + O_MCS + ((size_t)(b * 4 + head) * 128 + dsg * 8) * 256 + vh * 128 + vq4 * 4;
#pragma unroll
    for (int i = 0; i < 8; ++i) *(f32x4*)(co + (size_t)i * 256) = Cr[i];
    if (vh == 0) {
        if (tid < 128) { float n = scaleC * LDSF(MS_N0 + tid * 4); for (int s = 0; s < 8; ++s) n += LDSF(MS_WE + s * 4) * LDSF(MS_K + (s * 128 + tid) * 4); p->out[O_MNS + (size_t)(b * 4 + head) * 128 + tid] = n; }
        if (tid == 0) p->out[O_MMS + b * 4 + head] = LDSF(MS_SC + 4);
    }
    __syncthreads();
}

__device__ __forceinline__ void norm_phase(KPtr p, int G) {
    const int tid_ = fresh_tid(); const int lane = tid_ & 63, wave = tid_ >> 6; const int gw = blockIdx.x * 8 + wave, NGW = G * 8;
    const bf16_t* YPRE = (const bf16_t*)(p->ws + WS_YPRE); const bf16_t* PROJ = (const bf16_t*)(p->ws + WS_BIG); bf16_t* A2 = (bf16_t*)(p->ws + WS_A2);
    const float* gs = p->in[17]; const float* gm = p->in[20];
    for (int r = gw; r < MT; r += NGW) {
        const bf16_t* yr = YPRE + (size_t)r * YP_LD; bf16_t* ar = A2 + (size_t)r * YP_LD;
#pragma unroll
        for (int i = 0; i < 4; ++i) {
            const int c0 = i * 512 + lane * 8; const u32x4 w = *(const u32x4*)(yr + c0);
            float v[8] = {bflo(w.x), bfhi(w.x), bflo(w.y), bfhi(w.y), bflo(w.z), bfhi(w.z), bflo(w.w), bfhi(w.w)};
            float s = 0.f;
#pragma unroll
            for (int e = 0; e < 8; ++e) s += v[e] * v[e];
            float rstd; float gg[8];
            if (i < 2) { rstd = rsqrtf(wave_sum(s) * (1.f / 512.f) + EPSN);
                const f32x4 a = *(const f32x4*)(gs + c0), bq = *(const f32x4*)(gs + c0 + 4); gg[0] = a.x; gg[1] = a.y; gg[2] = a.z; gg[3] = a.w; gg[4] = bq.x; gg[5] = bq.y; gg[6] = bq.z; gg[7] = bq.w; }
            else {
#pragma unroll
                for (int o = 1; o < 32; o <<= 1) s += __shfl_xor(s, o);
                rstd = rsqrtf(s * (1.f / 256.f) + EPSN);
                const int cm = c0 - 1024; const f32x4 a = *(const f32x4*)(gm + cm), bq = *(const f32x4*)(gm + cm + 4); const u32x4 og = *(const u32x4*)(PROJ + (size_t)r * PROJ_LD + 4608 + cm);
                const float ov[8] = {bflo(og.x), bfhi(og.x), bflo(og.y), bfhi(og.y), bflo(og.z), bfhi(og.z), bflo(og.w), bfhi(og.w)};
                gg[0] = a.x; gg[1] = a.y; gg[2] = a.z; gg[3] = a.w; gg[4] = bq.x; gg[5] = bq.y; gg[6] = bq.z; gg[7] = bq.w;
#pragma unroll
                for (int e = 0; e < 8; ++e) gg[e] *= sigmoidf_(ov[e]); }
            u32x4 o; o.x = cvt_pk_bf16(v[0] * rstd * gg[0], v[1] * rstd * gg[1]); o.y = cvt_pk_bf16(v[2] * rstd * gg[2], v[3] * rstd * gg[3]);
            o.z = cvt_pk_bf16(v[4] * rstd * gg[4], v[5] * rstd * gg[5]); o.w = cvt_pk_bf16(v[6] * rstd * gg[6], v[7] * rstd * gg[7]);
            *(u32x4*)(ar + c0) = o;
        }
    }
}

template <bool FIRST, bool LASTP, bool PART = false>
__device__ __forceinline__ void row_phase(KPtr p, int wg0, int nwg, int r_lo, int r_hi, const float* gpost, const float* gpre) {
    const int tid_ = fresh_tid(); const int lane = tid_ & 63, wave = tid_ >> 6; const int gw = ((int)blockIdx.x - wg0) * 8 + wave, NGW = nwg * 8;
    const bf16_t* R1 = (const bf16_t*)(p->ws + WS_R1); bf16_t* U = (bf16_t*)(p->ws + WS_U);
    if ((int)blockIdx.x < wg0) return;
    for (int r = r_lo + gw; r < r_hi; r += NGW) {
        const float* xs = FIRST ? (r < MP ? p->in[0] + (size_t)r * DM : p->in[1] + (size_t)(r - MP) * DM) : p->out + (size_t)r * DM;
        float* xo = p->out + (size_t)r * DM;
        const u32x2* rr = (const u32x2*)(R1 + (size_t)r * DM) + lane;
        f32x4 rv[4], xv[4]; float s = 0.f;
#pragma unroll
        for (int j = 0; j < 4; ++j) { if (PART) { const f32x4* pp = (const f32x4*)(p->ws + WS_A2) + (size_t)(r - MP) * 256 + lane + 64 * j; rv[j] = pp[0] + pp[(size_t)MS * 256]; }
            else { const u32x2 w = rr[64 * j]; rv[j] = (f32x4){bflo(w.x), bfhi(w.x), bflo(w.y), bfhi(w.y)}; } xv[j] = ((const f32x4*)xs)[lane + 64 * j];
            s += (rv[j].x * rv[j].x + rv[j].y * rv[j].y) + (rv[j].z * rv[j].z + rv[j].w * rv[j].w); }
        const float rstd = rsqrtf(wave_sum(s) * (1.f / DM) + EPSN);
        float s2 = 0.f;
#pragma unroll
        for (int j = 0; j < 4; ++j) { const f32x4 gg = ((const f32x4*)gpost)[lane + 64 * j]; xv[j] = xv[j] + rv[j] * rstd * gg; ((f32x4*)xo)[lane + 64 * j] = xv[j];
            s2 += (xv[j].x * xv[j].x + xv[j].y * xv[j].y) + (xv[j].z * xv[j].z + xv[j].w * xv[j].w); }
        if (!LASTP) { const float rstd2 = rsqrtf(wave_sum(s2) * (1.f / DM) + EPSN); u32x2* uo = (u32x2*)(U + (size_t)r * DM) + lane;
#pragma unroll
            for (int j = 0; j < 4; ++j) { const f32x4 gg = ((const f32x4*)gpre)[lane + 64 * j]; u32x2 w; w.x = cvt_pk_bf16(xv[j].x * rstd2 * gg.x, xv[j].y * rstd2 * gg.y); w.y = cvt_pk_bf16(xv[j].z * rstd2 * gg.z, xv[j].w * rstd2 * gg.w); uo[64 * j] = w; } }
    }
}

constexpr int AT_K = 0, AT_V = 33792;
__device__ __forceinline__ void attn_prompt_unit(KPtr p, ldsp lds, int unit) {
    const int tid = fresh_tid(), lane = tid & 63, wid = __builtin_amdgcn_readfirstlane(tid >> 6), l15 = lane & 15, quad = lane >> 4;
    const int qb = unit & 15, head = (unit >> 4) & 3, b = unit >> 6;
    const bf16_t* QX = (const bf16_t*)(p->ws + WS_QX); const bf16_t* KM = (const bf16_t*)(p->ws + WS_KM); const bf16_t* VMT = (const bf16_t*)(p->ws + WS_VMT); bf16_t* O = (bf16_t*)(p->ws + WS_O);
    const size_t qrow = (size_t)b * 2048 + qb * 128 + wid * 16 + l15;
    bf16x8 qf[8];
#pragma unroll
    for (int ks = 0; ks < 8; ++ks) qf[ks] = *(const bf16x8*)(QX + qrow * DM + head * 256 + ks * 32 + quad * 8);
    f32x4 oa[16];
#pragma unroll
    for (int i = 0; i < 16; ++i) oa[i] = (f32x4){0.f, 0.f, 0.f, 0.f};
    float mrun = -3.0e38f, lrun = 0.f;
    for (int kt = 0; kt < 4; ++kt) {
        __syncthreads();
#pragma unroll
        for (int i = 0; i < 4; ++i) { const int v = tid + 512 * i; const int kr = v >> 5, kc = v & 31;
            *(LAS u32x4*)(lds + AT_K + kr * 528 + kc * 16) = *(const u32x4*)(KM + ((size_t)b * 256 + kt * 64 + kr) * DM + head * 256 + kc * 8);
            const int vr = v >> 3, vc = v & 7;
            *(LAS u32x4*)(lds + AT_V + vr * 144 + vc * 16) = *(const u32x4*)(VMT + ((size_t)(b * 4 + head) * 256 + vr) * 256 + kt * 64 + vc * 8); }
        __syncthreads();
        f32x4 sT[4];
#pragma unroll
        for (int k16 = 0; k16 < 4; ++k16) { sT[k16] = (f32x4){0.f, 0.f, 0.f, 0.f};
#pragma unroll
            for (int ks = 0; ks < 8; ++ks) { const bf16x8 afr = LDSV8(AT_K + (k16 * 16 + l15) * 528 + ks * 64 + quad * 16); sT[k16] = MFMA16(afr, qf[ks], sT[k16]); } }
        float mx = mrun;
#pragma unroll
        for (int k16 = 0; k16 < 4; ++k16)
#pragma unroll
            for (int j = 0; j < 4; ++j) mx = fmaxf(mx, sT[k16][j]);
        mx = fmaxf(mx, __shfl_xor(mx, 16)); mx = fmaxf(mx, __shfl_xor(mx, 32));
        const float alpha = __expf(mrun - mx); mrun = mx; float ls = 0.f;
#pragma unroll
        for (int k16 = 0; k16 < 4; ++k16)
#pragma unroll
            for (int j = 0; j < 4; ++j) { const float e = __expf(sT[k16][j] - mx); sT[k16][j] = e; ls += e; }
        lrun = lrun * alpha + ls;
#pragma unroll
        for (int i = 0; i < 16; ++i) oa[i] = oa[i] * alpha;
#pragma unroll
        for (int k2 = 0; k2 < 2; ++k2) {
            u32x4 pw; pw.x = cvt_pk_bf16(sT[2 * k2][0], sT[2 * k2][1]); pw.y = cvt_pk_bf16(sT[2 * k2][2], sT[2 * k2][3]); pw.z = cvt_pk_bf16(sT[2 * k2 + 1][0], sT[2 * k2 + 1][1]); pw.w = cvt_pk_bf16(sT[2 * k2 + 1][2], sT[2 * k2 + 1][3]);
            const bf16x8 pf = __builtin_bit_cast(bf16x8, pw);
#pragma unroll
            for (int dt = 0; dt < 16; ++dt) { const u32x2 v0 = *(const LAS u32x2*)(lds + AT_V + (dt * 16 + l15) * 144 + (k2 * 32 + quad * 4) * 2), v1 = *(const LAS u32x2*)(lds + AT_V + (dt * 16 + l15) * 144 + (k2 * 32 + 16 + quad * 4) * 2);
                u32x4 vw; vw.x = v0.x; vw.y = v0.y; vw.z = v1.x; vw.w = v1.y; oa[dt] = MFMA16(__builtin_bit_cast(bf16x8, vw), pf, oa[dt]); }
        }
    }
    lrun += __shfl_xor(lrun, 16); lrun += __shfl_xor(lrun, 32);
    const float inv = 1.f / lrun;
#pragma unroll
    for (int dt = 0; dt < 16; ++dt) { u32x2 o; o.x = cvt_pk_bf16(oa[dt][0] * inv, oa[dt][1] * inv); o.y = cvt_pk_bf16(oa[dt][2] * inv, oa[dt][3] * inv);
        *(u32x2*)(O + qrow * DM + head * 256 + dt * 16 + quad * 4) = o; }
}
constexpr int AS_S = 0, AS_P = 8192, AS_O = 16384;
__device__ __forceinline__ void attn_sample_unit(KPtr p, ldsp lds, int unit) {
    const int tid = fresh_tid(), lane = tid & 63, wid = __builtin_amdgcn_readfirstlane(tid >> 6), l15 = lane & 15, quad = lane >> 4;
    const int head = unit & 3, b = unit >> 2;
    const bf16_t* QX = (const bf16_t*)(p->ws + WS_QX); bf16_t* O = (bf16_t*)(p->ws + WS_O);
    const float* CK = p->in[8] + (size_t)b * 256 * 1024 + head * 256; const float* CV = p->in[9] + (size_t)b * 256 * 1024 + head * 256;
    const size_t r0 = (size_t)MP + (size_t)b * 8;
    bf16x8 qf[8];
#pragma unroll
    for (int ks = 0; ks < 8; ++ks) { u32x4 w = (u32x4){0u, 0u, 0u, 0u}; if (l15 < 8) w = *(const u32x4*)(QX + (r0 + l15) * DM + head * 256 + ks * 32 + quad * 8); qf[ks] = __builtin_bit_cast(bf16x8, w); }
    __syncthreads();
    {
        f32x4 ka[2][8], kb[2][8];
#pragma unroll
        for (int ps = 0; ps < 2; ++ps) { const float* kp = CK + (size_t)(ps * 128 + wid * 16 + l15) * 1024 + quad * 8;
#pragma unroll
            for (int ks = 0; ks < 8; ++ks) { ka[ps][ks] = *(const f32x4*)(kp + ks * 32); kb[ps][ks] = *(const f32x4*)(kp + ks * 32 + 4); } }
#pragma unroll
        for (int ps = 0; ps < 2; ++ps) { const int m0 = ps * 128 + wid * 16;
            f32x4 sc = (f32x4){0.f, 0.f, 0.f, 0.f};
#pragma unroll
            for (int ks = 0; ks < 8; ++ks) { u32x4 w; w.x = cvt_pk_bf16(ka[ps][ks].x, ka[ps][ks].y); w.y = cvt_pk_bf16(ka[ps][ks].z, ka[ps][ks].w); w.z = cvt_pk_bf16(kb[ps][ks].x, kb[ps][ks].y); w.w = cvt_pk_bf16(kb[ps][ks].z, kb[ps][ks].w);
                sc = MFMA16(__builtin_bit_cast(bf16x8, w), qf[ks], sc); }
            if (l15 < 8) *(LAS f32x4*)(lds + AS_S + (l15 * 256 + m0 + quad * 4) * 4) = sc; }
    }
    const float* vp = CV + (size_t)(wid * 32) * 1024 + lane * 4;
    f32x4 vA[8], vB[8];
#pragma unroll
    for (int i = 0; i < 8; ++i) vA[i] = *(const f32x4*)(vp + (size_t)i * 1024);
    LBAR();
    {
        const f32x4 s4 = *(const LAS f32x4*)(lds + AS_S + (wid * 256 + lane * 4) * 4);
        const float mx = wave_max(fmaxf(fmaxf(s4.x, s4.y), fmaxf(s4.z, s4.w)));
        const float e0 = __expf(s4.x - mx), e1 = __expf(s4.y - mx), e2 = __expf(s4.z - mx), e3 = __expf(s4.w - mx);
        const float inv = 1.f / wave_sum(e0 + e1 + e2 + e3);
        LDSF(AS_P + ((lane * 4 + 0) * 8 + wid) * 4) = e0 * inv; LDSF(AS_P + ((lane * 4 + 1) * 8 + wid) * 4) = e1 * inv;
        LDSF(AS_P + ((lane * 4 + 2) * 8 + wid) * 4) = e2 * inv; LDSF(AS_P + ((lane * 4 + 3) * 8 + wid) * 4) = e3 * inv;
    }
    LBAR();
    {
        f32x4 acc[8];
#pragma unroll
        for (int t = 0; t < 8; ++t) acc[t] = (f32x4){0.f, 0.f, 0.f, 0.f};
#define AS_PV(vv, mb) do { _Pragma("unroll") for (int i = 0; i < 8; ++i) { const int m = wid * 32 + (mb) + i; const f32x4 pa = *(const LAS f32x4*)(lds + AS_P + m * 32), pb = *(const LAS f32x4*)(lds + AS_P + m * 32 + 16); \
                acc[0] = acc[0] + vv[i] * pa.x; acc[1] = acc[1] + vv[i] * pa.y; acc[2] = acc[2] + vv[i] * pa.z; acc[3] = acc[3] + vv[i] * pa.w; \
                acc[4] = acc[4] + vv[i] * pb.x; acc[5] = acc[5] + vv[i] * pb.y; acc[6] = acc[6] + vv[i] * pb.z; acc[7] = acc[7] + vv[i] * pb.w; } } while (0)
#define AS_LD(vv, mb) do { _Pragma("unroll") for (int i = 0; i < 8; ++i) vv[i] = *(const f32x4*)(vp + (size_t)((mb) + i) * 1024); } while (0)
        AS_LD(vB, 8);  AS_PV(vA, 0);
        AS_LD(vA, 16); AS_PV(vB, 8);
        AS_LD(vB, 24); AS_PV(vA, 16);
        AS_PV(vB, 24);
#undef AS_PV
#undef AS_LD
#pragma unroll
        for (int t = 0; t < 8; ++t) *(LAS f32x4*)(lds + AS_O + ((wid * 8 + t) * 256 + lane * 4) * 4) = acc[t];
    }
    __syncthreads();
    { const int t = tid >> 6, d4 = (tid & 63) * 4; f32x4 a = (f32x4){0.f, 0.f, 0.f, 0.f};
#pragma unroll
        for (int w = 0; w < 8; ++w) a = a + *(const LAS f32x4*)(lds + AS_O + ((w * 8 + t) * 256 + d4) * 4);
        u32x2 o; o.x = cvt_pk_bf16(a.x, a.y); o.y = cvt_pk_bf16(a.z, a.w); *(u32x2*)(O + (r0 + t) * DM + head * 256 + d4) = o; }
}


#ifndef DUMP_AT
#define DUMP_AT -1
#define DUMP_OFF 0
#define DUMP_LD 1024
#define DUMP_COL0 0
#endif
#ifndef DUMP_COL1
#define DUMP_COL1 -1
#endif
__device__ __forceinline__ void dump_phase(KPtr p, int G) {
    const bf16_t* B = (const bf16_t*)(p->ws + (size_t)DUMP_OFF);
    for (size_t i = (size_t)blockIdx.x * 512 + threadIdx.x; i < (size_t)MT * 1024; i += (size_t)G * 512) { const size_t r = i >> 10, c = i & 1023; float v = bf2f(B[r * DUMP_LD + DUMP_COL0 + c]); if (DUMP_COL1 >= 0) v += 1.7f * bf2f(B[r * DUMP_LD + DUMP_COL1 + c]); p->out[i] = v; }
}
#define DUMP(n) do { if (DUMP_AT == (n)) { dump_phase(kparams(), G); return; } } while (0)

__global__ void __launch_bounds__(512, 2) hymba_fwd(Params pv) {
    extern __shared__ __attribute__((aligned(16))) unsigned char lds_raw[];
    ldsp lds = (ldsp)lds_raw;
    cg::grid_group grid = cg::this_grid();
    const int G = gridDim.x;
    volatile LAS unsigned* bst = (volatile LAS unsigned*)(lds + LDS_BYTES - 64);
    { unsigned* bar0 = (unsigned*)kparams()->ws; if (threadIdx.x == 0) { bst[0] = 0u; bst[1] = 0u; xb_add(bar0 + XB_XCNT(xb_xcc_id()), 1u); } }
    __syncthreads();
#define GSYNC() xcd_barrier((unsigned*)kparams()->ws, bst)
#ifndef PHMASK
#define PHMASK 0xffffffffu
#endif
#define PH(n) ((PHMASK >> (n)) & 1u)
    if (PH(0)) { KPtr p = kparams(); p0_prologue(p, lds, G); }
    if (kparams()->ws == nullptr) grid.sync();
    GSYNC();
    DUMP(0);
    if (PH(1)) {
        KPtr p = kparams(); unsigned char* ws = p->ws;
        pg8::Gemm g0{(const bf16_t*)(ws + WS_UM), (const bf16_t*)(ws + WS_WKVT), NMEMROWS, 2048, 1024}; pg8::StaticOrder S0; S0.init(NMEMROWS, 2048, G, G - 1 - (int)blockIdx.x);
        EpiKV E0{p->out + O_MK, p->out + O_MV, (bf16_t*)(ws + WS_KM), (bf16_t*)(ws + WS_VMT)};
        pg8::gemm_phase<EpiKV, pg8::StaticOrder, true, true>(lds, g0, S0, E0);
        __syncthreads();
        pg8::Gemm g1{(const bf16_t*)(ws + WS_U), (const bf16_t*)(ws + WS_W1T), MT, N1PAD, 1024}; pg8::StaticOrder S1; S1.init(MT, N1PAD, G, (int)blockIdx.x);
        EpiG1 E1{(bf16_t*)(ws + WS_BIG), (float*)(ws + WS_GATES)};
        pg8::gemm_phase<EpiG1, pg8::StaticOrder, true, true>(lds, g1, S1, E1);
    }
    GSYNC();
    DUMP(1);
    if (PH(2)) { KPtr p = kparams(); conv_phase(p, G); }
    GSYNC();
    DUMP(2);
    if (PH(3)) { KPtr p = kparams(); for (int u = blockIdx.x; u < 128; u += G) ssd_prompt_unit(p, lds, u >> 4, u & 15); }
    if (PH(4)) { KPtr p = kparams(); for (int u = blockIdx.x; u < 256; u += G) { if (u >= 128) { const int v = u - 128; mlstm_prompt_unit(p, lds, v >> 4, (v >> 2) & 3, v & 3); } } }
    if (PH(6)) { KPtr p = kparams(); unsigned* q = (unsigned*)p->ws + 8256; volatile LAS unsigned* slot = (volatile LAS unsigned*)(lds + LDS_BYTES - 32);
        for (;;) { if (threadIdx.x == 0) slot[0] = atomicAdd(q, 1u); __syncthreads(); const unsigned v = slot[0]; __syncthreads(); if (v >= 1024u) break; mlstm_sample_unit(p, lds, (int)(v >> 3), (int)((v >> 1) & 3), (int)(v & 1)); } }
    if (PH(5)) { KPtr p = kparams(); unsigned* q = (unsigned*)p->ws + 8192; volatile LAS unsigned* slot = (volatile LAS unsigned*)(lds + LDS_BYTES - 32);
        for (;;) { if (threadIdx.x == 0) slot[0] = atomicAdd(q, 1u); __syncthreads(); const unsigned v = slot[0]; __syncthreads(); if (v >= 2048u) break; ssd_sample_unit(p, lds, (int)(v >> 4), (int)(v & 15)); } }
    GSYNC();
    DUMP(3);
    if (PH(7)) { KPtr p = kparams(); norm_phase(p, G); }
    GSYNC();
    DUMP(4);
    if (PH(8)) { KPtr p = kparams(); unsigned char* ws = p->ws;
        pg8::Gemm g{(const bf16_t*)(ws + WS_A2), (const bf16_t*)(ws + WS_W2T), MP, 1024, 2048}; pg8::StaticOrder S; S.init(MP, 1024, G, (int)blockIdx.x);
        EpiB E{(bf16_t*)(ws + WS_R1), 1024, 1.f};
        pg8::gemm_phase<EpiB, pg8::StaticOrder, true, true>(lds, g, S, E);
    }
    GSYNC();
    {
        KPtr p = kparams(); unsigned char* ws = p->ws;
        if (blockIdx.x < 16) { if (PH(8)) {
            pg8::Gemm g{(const bf16_t*)(ws + WS_A2) + (size_t)MP * 2048, (const bf16_t*)(ws + WS_W2T), MS, 1024, 2048}; pg8::StaticOrder S; S.init(MS, 1024, 16, (int)blockIdx.x);
            EpiB E{(bf16_t*)(ws + WS_R1) + (size_t)MP * 1024, 1024, 1.f};
            pg8::gemm_phase<EpiB, pg8::StaticOrder, true, true>(lds, g, S, E); }
            asm volatile("s_waitcnt vmcnt(0)" ::: "memory"); __syncthreads();
            if (threadIdx.x == 0) { __builtin_amdgcn_fence(__ATOMIC_RELEASE, "agent"); asm volatile("s_waitcnt vmcnt(0)" ::: "memory"); (void)xb_add((unsigned*)ws + 8320, 1u); } }
        else if (PH(9)) {
            row_phase<true, false>(p, 16, G - 16, 0, MP, p->in[22], p->in[26]);
            if (threadIdx.x == 0) { unsigned* cw = (unsigned*)ws + 8320; while (xb_ld(cw) < 16u) __builtin_amdgcn_s_sleep(1);
                __builtin_amdgcn_fence(__ATOMIC_ACQUIRE, "agent"); asm volatile("s_waitcnt vmcnt(0)" ::: "memory"); }
            __syncthreads();
            row_phase<true, false>(p, 16, G - 16, MP, MT, p->in[22], p->in[26]); }
    }
    GSYNC();
    DUMP(6);
    if (PH(8)) { KPtr p = kparams(); unsigned char* ws = p->ws;
        pg8::Gemm g{(const bf16_t*)(ws + WS_U), (const bf16_t*)(ws + WS_WXQT), MT, 1024, 1024}; pg8::StaticOrder S; S.init(MT, 1024, G, (int)blockIdx.x);
        EpiB E{(bf16_t*)(ws + WS_QX), 1024, 0.0625f};
        pg8::gemm_phase<EpiB, pg8::StaticOrder, true, true>(lds, g, S, E);
    }
    GSYNC();
    DUMP(7);
    if ((blockIdx.x & 1) && PH(11)) { KPtr p = kparams(); for (int u = blockIdx.x; u < 512; u += G) { attn_sample_unit(p, lds, u); __syncthreads(); } }
    if (PH(10)) { KPtr p = kparams(); for (int u = blockIdx.x; u < 512; u += G) { attn_prompt_unit(p, lds, u); __syncthreads(); } }
    if (!(blockIdx.x & 1) && PH(11)) { KPtr p = kparams(); for (int u = blockIdx.x; u < 512; u += G) { attn_sample_unit(p, lds, u); __syncthreads(); } }
    GSYNC();
    DUMP(8);
    if (PH(8)) { KPtr p = kparams(); unsigned char* ws = p->ws;
        pg8::Gemm g{(const bf16_t*)(ws + WS_O), (const bf16_t*)(ws + WS_WXOT), MP, 1024, 1024}; pg8::StaticOrder S; S.init(MP, 1024, G, (int)blockIdx.x);
        EpiB E{(bf16_t*)(ws + WS_R1), 1024, 1.f};
        pg8::gemm_phase<EpiB, pg8::StaticOrder, true, true>(lds, g, S, E);
    }
    GSYNC();
    {
        KPtr p = kparams(); unsigned char* ws = p->ws;
        if (blockIdx.x < 16) { if (PH(8)) {
            pg8::Gemm g{(const bf16_t*)(ws + WS_O) + (size_t)MP * 1024, (const bf16_t*)(ws + WS_WXOT), MS, 1024, 1024}; pg8::StaticOrder S; S.init(MS, 1024, 16, (int)blockIdx.x);
            EpiB E{(bf16_t*)(ws + WS_R1) + (size_t)MP * 1024, 1024, 1.f};
            pg8::gemm_phase<EpiB, pg8::StaticOrder, true, true>(lds, g, S, E); }
            asm volatile("s_waitcnt vmcnt(0)" ::: "memory"); __syncthreads();
            if (threadIdx.x == 0) { __builtin_amdgcn_fence(__ATOMIC_RELEASE, "agent"); asm volatile("s_waitcnt vmcnt(0)" ::: "memory"); (void)xb_add((unsigned*)ws + 8384, 1u); } }
        else if (PH(9)) {
            row_phase<false, false>(p, 16, G - 16, 0, MP, p->in[29], p->in[30]);
            if (threadIdx.x == 0) { unsigned* cw = (unsigned*)ws + 8384; while (xb_ld(cw) < 16u) __builtin_amdgcn_s_sleep(1);
                __builtin_amdgcn_fence(__ATOMIC_ACQUIRE, "agent"); asm volatile("s_waitcnt vmcnt(0)" ::: "memory"); }
            __syncthreads();
            row_phase<false, false>(p, 16, G - 16, MP, MT, p->in[29], p->in[30]); }
    }
    GSYNC();
    DUMP(10);
    if (PH(12)) { KPtr p = kparams(); unsigned char* ws = p->ws;
        pg8::Gemm g{(const bf16_t*)(ws + WS_U), (const bf16_t*)(ws + WS_WGUT), MT, 5632, 1024}; pg8::StaticOrder S; S.init(MT, 5632, G, (int)blockIdx.x);
        EpiSwi E{(bf16_t*)(ws + WS_HID)};
        pg8::gemm_phase<EpiSwi, pg8::StaticOrder, true, true>(lds, g, S, E);
    }
    GSYNC();
    DUMP(11);
    if (PH(8)) { KPtr p = kparams(); unsigned char* ws = p->ws;
        pg8::Gemm g{(const bf16_t*)(ws + WS_HID), (const bf16_t*)(ws + WS_WDT), MP, 1024, 2816}; pg8::StaticOrder S; S.init(MP, 1024, G, (int)blockIdx.x);
        EpiB E{(bf16_t*)(ws + WS_R1), 1024, 1.f};
        pg8::gemm_phase<EpiB, pg8::StaticOrder, true, true>(lds, g, S, E);
    }
    GSYNC();
    {
        KPtr p = kparams(); unsigned char* ws = p->ws;
        if (blockIdx.x < 32) { if (PH(8)) { const int kh = (int)blockIdx.x >> 4;
            pg8::Gemm g{(const bf16_t*)(ws + WS_HID) + (size_t)MP * 2816 + kh * 1408, (const bf16_t*)(ws + WS_WDT) + kh * 1408, MS, 1024, 1408, 2816}; pg8::StaticOrder S; S.init(MS, 1024, 16, (int)blockIdx.x & 15);
            EpiP32 E{(float*)(ws + WS_A2) + (size_t)kh * MS * 1024, 1024};
            pg8::gemm_phase<EpiP32, pg8::StaticOrder, true, true>(lds, g, S, E); }
            asm volatile("s_waitcnt vmcnt(0)" ::: "memory"); __syncthreads();
            if (threadIdx.x == 0) { __builtin_amdgcn_fence(__ATOMIC_RELEASE, "agent"); asm volatile("s_waitcnt vmcnt(0)" ::: "memory"); (void)xb_add((unsigned*)ws + 8448, 1u); } }
        else if (PH(9)) {
            row_phase<false, true>(p, 32, G - 32, 0, MP, p->in[34], p->in[34]);
            if (threadIdx.x == 0) { unsigned* cw = (unsigned*)ws + 8448; while (xb_ld(cw) < 32u) __builtin_amdgcn_s_sleep(1);
                __builtin_amdgcn_fence(__ATOMIC_ACQUIRE, "agent"); asm volatile("s_waitcnt vmcnt(0)" ::: "memory"); }
            __syncthreads();
            row_phase<false, true, true>(p, 32, G - 32, MP, MT, p->in[34], p->in[34]); }
    }
}

extern "C" void kernel_launch(void* const* d_in, const int* in_sizes, int n_in, void* d_out, int out_size, void* d_ws, size_t ws_size, hipStream_t stream) {
    static int grid = 0;
    if (grid == 0) {
        if (n_in != 35 || ws_size < WS_END) { fprintf(stderr, "kernel_launch: unexpected n_in %d / ws %zu\n", n_in, ws_size); grid = -1; return; }
        int dev = 0, cus = 0, per_cu = 0;
        (void)hipGetDevice(&dev); (void)hipDeviceGetAttribute(&cus, hipDeviceAttributeMultiprocessorCount, dev);
        if (hipFuncSetAttribute((const void*)hymba_fwd, hipFuncAttributeMaxDynamicSharedMemorySize, LDS_BYTES) != hipSuccess) { fprintf(stderr, "kernel_launch: hipFuncSetAttribute failed\n"); grid = -1; return; }
        if (hipOccupancyMaxActiveBlocksPerMultiprocessor(&per_cu, (const void*)hymba_fwd, 512, LDS_BYTES) != hipSuccess || per_cu < 1) { fprintf(stderr, "kernel_launch: occupancy query says %d\n", per_cu); per_cu = 1; }
        (void)hipGetLastError();
        grid = cus * 1;
    }
    if (grid < 0) return;
    if (hipMemsetAsync(d_ws, 0, 65536, stream) != hipSuccess) { fprintf(stderr, "kernel_launch: memset failed\n"); return; }
    Params p{};
    for (int i = 0; i < 35; ++i) p.in[i] = (const float*)d_in[i];
    p.out = (float*)d_out; p.ws = (unsigned char*)d_ws;
    void* args[] = {&p};
    hipError_t e = hipLaunchCooperativeKernel((const void*)hymba_fwd, dim3(grid), dim3(512), args, LDS_BYTES, stream);
    if (e != hipSuccess) fprintf(stderr, "cooperative launch failed: %s (grid %d)\n", hipGetErrorString(e), grid);
}
```
